# Optimizing an MI355X kernel written in HIP

```python
import jax, jax.numpy as jnp
from jax import lax
import numpy as np

D_MODEL = 1024
BATCH = 4
SEQ = 8192
DEPTH = 2

CHUNK = 64
N_MOD = 6
EPS = 1e-6

M_HEADS = 4
M_QK_DIM = 128
M_V_DIM = 256
M_QK_WIDTH = M_HEADS * M_QK_DIM
M_V_WIDTH = M_HEADS * M_V_DIM
CONV_WIDTH = 4

A_HEADS = 8
Q_LORA = 384
KV_LORA = 256
QK_NOPE = 128
QK_ROPE = 64
V_HEAD = 128
A_V_WIDTH = A_HEADS * V_HEAD
ROPE_THETA = 10000.0
Q_BLOCK = 128

N_BRANCHES = 2
IN_SIZES = (M_QK_WIDTH, M_QK_WIDTH, M_V_WIDTH, M_V_WIDTH, M_HEADS, M_HEADS,
            Q_LORA, KV_LORA, QK_ROPE, N_BRANCHES * D_MODEL)
D_IN = sum(IN_SIZES)
IN_SPLIT_POINTS = tuple(sum(IN_SIZES[:i + 1]) for i in range(len(IN_SIZES) - 1))

N_GROUPS = 4
EXPERTS_PER_GROUP = 8
N_EXPERTS = N_GROUPS * EXPERTS_PER_GROUP
TOP_K = 2
D_EXPERT = 256
MOE_BLOCK = 128

kernel_name = "hybrid_mlstm_mla_hmoe_adaln"


def rms_norm(x, g):
    xf = x.astype(jnp.float32)
    y = xf * lax.rsqrt(jnp.mean(xf * xf, axis=-1, keepdims=True) + EPS)
    return (y * g.astype(jnp.float32)).astype(x.dtype)


def modulate(h, shift, scale):
    return h * (1.0 + scale[:, None, :]) + shift[:, None, :]


def apply_rope(x, cos, sin):
    x1, x2 = jnp.split(x, 2, axis=-1)
    return jnp.concatenate([x1 * cos - x2 * sin, x1 * sin + x2 * cos], axis=-1)


def causal_depthwise_conv(x, w, b):
    C = x.shape[-1]
    y = lax.conv_general_dilated(x, w[:, None, :], window_strides=(1,),
                                 padding=((CONV_WIDTH - 1, 0),),
                                 dimension_numbers=('NWC', 'WIO', 'NWC'),
                                 feature_group_count=C)
    return y + b


def mlstm_chunkwise(q, k, v, log_i, log_f):
    B, S, NH, DQK = q.shape
    DV = v.shape[-1]
    nc = S // CHUNK

    def to_chunks(t):
        t = t.reshape(B, nc, CHUNK, NH, *t.shape[3:])
        return jnp.moveaxis(t, (1, 3), (0, 2))

    causal = jnp.tril(jnp.ones((CHUNK, CHUNK), dtype=bool))

    def step(carry, xs):
        C, n, m = carry
        qc, kc, vc, lic, lfc = xs
        b = jnp.cumsum(lfc, axis=-1)
        dmat = b[..., :, None] - b[..., None, :] + lic[..., None, :]
        dmat = jnp.where(causal, dmat, -jnp.inf)
        m_inter = b + m[..., None]
        m_t = jnp.maximum(jnp.max(dmat, axis=-1), m_inter)
        s = jnp.einsum('bhtd,bhsd->bhts', qc, kc) * jnp.exp(dmat - m_t[..., None])
        w_inter = jnp.exp(m_inter - m_t)
        num = (jnp.einsum('bhts,bhsv->bhtv', s, vc)
               + w_inter[..., None] * jnp.einsum('bhtd,bhvd->bhtv', qc, C))
        den = jnp.sum(s, axis=-1) + w_inter * jnp.einsum('bhtd,bhd->bht', qc, n)
        h = num / jnp.maximum(jnp.abs(den), jnp.exp(-m_t))[..., None]
        b_last = b[..., -1]
        a = b_last[..., None] - b + lic
        m_new = jnp.maximum(b_last + m, jnp.max(a, axis=-1))
        decay = jnp.exp(b_last + m - m_new)
        wk = jnp.exp(a - m_new[..., None])
        C_new = decay[..., None, None] * C + jnp.einsum('bhs,bhsv,bhsd->bhvd', wk, vc, kc)
        n_new = decay[..., None] * n + jnp.einsum('bhs,bhsd->bhd', wk, kc)
        return (C_new, n_new, m_new), h

    init = (jnp.zeros((B, NH, DV, DQK), jnp.float32),
            jnp.zeros((B, NH, DQK), jnp.float32),
            jnp.zeros((B, NH), jnp.float32))
    _, h = lax.scan(step, init, (to_chunks(q), to_chunks(k), to_chunks(v),
                                 to_chunks(log_i), to_chunks(log_f)))
    return jnp.moveaxis(h, (0, 2), (1, 3)).reshape(B, S, NH, DV)


def chunk_causal_mla_attention(q_nope, q_rope, k_nope, k_rope, v):
    B, S, H, _ = q_nope.shape
    nqb = S // Q_BLOCK
    key_chunk = jnp.arange(S) // CHUNK
    scale = (QK_NOPE + QK_ROPE) ** -0.5

    def to_blocks(t):
        return t.reshape(B, nqb, Q_BLOCK, *t.shape[2:]).swapaxes(0, 1)

    def one_block(args):
        qn, qr, blk = args
        s = (jnp.einsum('bqhd,bkhd->bhqk', qn, k_nope)
             + jnp.einsum('bqhr,bkr->bhqk', qr, k_rope)).astype(jnp.float32) * scale
        q_chunk = (blk * Q_BLOCK + jnp.arange(Q_BLOCK)) // CHUNK
        mask = key_chunk[None, :] <= q_chunk[:, None]
        s = jnp.where(mask, s, -jnp.inf)
        p = jax.nn.softmax(s, axis=-1).astype(v.dtype)
        return jnp.einsum('bhqk,bkhd->bqhd', p, v)

    out = lax.map(one_block, (to_blocks(q_nope), to_blocks(q_rope), jnp.arange(nqb)))
    return out.swapaxes(0, 1).reshape(B, S, H * V_HEAD)


def mixer_sublayer(h, cos, sin, w_in, conv_w, conv_b, igate_b, fgate_b, q_norm_g,
                   kv_norm_g, w_uq, w_ukv, w_branch_m, w_branch_a, w_out):
    B, S, _ = h.shape
    proj = h @ w_in
    (q_m, k_m, v_m, o_m, i_m, f_m, c_q, c_kv, k_r, gate_pre) = jnp.split(
        proj, IN_SPLIT_POINTS, axis=-1)

    qk = jax.nn.silu(causal_depthwise_conv(jnp.concatenate([q_m, k_m], axis=-1), conv_w, conv_b))
    q_m, k_m = jnp.split(qk.astype(jnp.float32), 2, axis=-1)
    q_m = q_m.reshape(B, S, M_HEADS, M_QK_DIM) * (M_QK_DIM ** -0.5)
    k_m = k_m.reshape(B, S, M_HEADS, M_QK_DIM)
    v_m = v_m.astype(jnp.float32).reshape(B, S, M_HEADS, M_V_DIM)
    log_i = (i_m + igate_b).astype(jnp.float32)
    log_f = jax.nn.log_sigmoid((f_m + fgate_b).astype(jnp.float32))
    y_m = mlstm_chunkwise(q_m, k_m, v_m, log_i, log_f).reshape(B, S, M_V_WIDTH).astype(h.dtype)
    y_m = jax.nn.sigmoid(o_m) * y_m

    q_a = (rms_norm(c_q, q_norm_g) @ w_uq).reshape(B, S, A_HEADS, QK_NOPE + QK_ROPE)
    q_nope = q_a[..., :QK_NOPE]
    q_rope = apply_rope(q_a[..., QK_NOPE:], cos[:, None, :], sin[:, None, :])
    kv = (rms_norm(c_kv, kv_norm_g) @ w_ukv).reshape(B, S, A_HEADS, QK_NOPE + V_HEAD)
    k_nope, v_a = kv[..., :QK_NOPE], kv[..., QK_NOPE:]
    k_rope = apply_rope(k_r, cos, sin)
    y_a = chunk_causal_mla_attention(q_nope, q_rope, k_nope, k_rope, v_a)

    g_m, g_a = jnp.split(jax.nn.sigmoid(gate_pre), 2, axis=-1)
    merged = g_m * (y_m @ w_branch_m) + g_a * (y_a @ w_branch_a)
    return merged @ w_out


def hierarchical_moe(h, w_group, b_group, w_router, b_router, w_gate, w_up, w_down):
    B, S, D = h.shape
    T = B * S
    ht = h.reshape(T, D)
    hf = ht.astype(jnp.float32)
    grp_probs = jax.nn.softmax(hf @ w_group.astype(jnp.float32) + b_group.astype(jnp.float32), axis=-1)
    grp = jnp.argmax(grp_probs, axis=-1)
    p_grp = jnp.take_along_axis(grp_probs, grp[:, None], axis=-1)[:, 0]
    e_logits = (hf @ w_router.astype(jnp.float32) + b_router.astype(jnp.float32)).reshape(
        T, N_GROUPS, EXPERTS_PER_GROUP)
    in_grp = jnp.take_along_axis(e_logits, grp[:, None, None], axis=1)[:, 0]
    top_p, top_e = lax.top_k(jax.nn.softmax(in_grp, axis=-1), TOP_K)
    weights = p_grp[:, None] * top_p / jnp.sum(top_p, axis=-1, keepdims=True)
    expert_id = grp[:, None] * EXPERTS_PER_GROUP + top_e

    n_assign = T * TOP_K
    flat_e = expert_id.reshape(-1).astype(jnp.int32)
    flat_t = jnp.repeat(jnp.arange(T, dtype=jnp.int32), TOP_K)
    flat_w = weights.reshape(-1)
    order = jnp.argsort(flat_e)
    se, st, sw = flat_e[order], flat_t[order], flat_w[order]
    counts = jnp.bincount(flat_e, length=N_EXPERTS)
    padded = (counts + MOE_BLOCK - 1) // MOE_BLOCK * MOE_BLOCK
    starts = jnp.cumsum(counts) - counts
    p_ends = jnp.cumsum(padded)
    p_starts = p_ends - padded
    dest = p_starts[se] + jnp.arange(n_assign, dtype=jnp.int32) - starts[se]
    cap = n_assign + N_EXPERTS * MOE_BLOCK
    n_blocks = cap // MOE_BLOCK
    slot_tok = jnp.zeros((cap,), jnp.int32).at[dest].set(st)
    slot_w = jnp.zeros((cap,), jnp.float32).at[dest].set(sw)
    blk_start = jnp.arange(n_blocks) * MOE_BLOCK
    blk_expert = jnp.minimum(jnp.sum(p_ends[None, :] <= blk_start[:, None], axis=1), N_EXPERTS - 1)
    xg = ht[slot_tok].reshape(n_blocks, MOE_BLOCK, D)

    def run_block(args):
        xb, e, wb = args
        a = jax.nn.silu(xb @ w_gate[e]) * (xb @ w_up[e])
        return (a @ w_down[e]) * wb[:, None].astype(xb.dtype)

    out = lax.map(run_block, (xg, blk_expert, slot_w.reshape(n_blocks, MOE_BLOCK)))
    y = jnp.zeros((T, D), h.dtype).at[slot_tok].add(out.reshape(cap, D))
    return y.reshape(B, S, D)


def setup_inputs(seed: int = 0) -> dict:
    key = jax.random.key(seed)
    ks = jax.random.split(key, 26)
    f32 = jnp.float32

    def nrm(k, shape, scale):
        return jax.random.normal(k, shape, f32) * scale

    def gain(k, shape):
        return 1.0 + 0.02 * jax.random.normal(k, shape, f32)

    L, D = DEPTH, D_MODEL
    return {
        "x": nrm(ks[0], (BATCH, SEQ, D), 1.0),
        "c": nrm(ks[1], (BATCH, D), 1.0),
        "mod_w": nrm(ks[2], (L, D, N_MOD * D), 0.5 * D ** -0.5),
        "mod_b": nrm(ks[3], (L, N_MOD * D), 0.02),
        "norm1_g": gain(ks[4], (L, D)),
        "w_in": nrm(ks[5], (L, D, D_IN), D ** -0.5),
        "conv_w": nrm(ks[6], (L, CONV_WIDTH, 2 * M_QK_WIDTH), CONV_WIDTH ** -0.5),
        "conv_b": nrm(ks[7], (L, 2 * M_QK_WIDTH), 0.02),
        "igate_b": nrm(ks[8], (L, M_HEADS), 0.1),
        "fgate_b": 3.0 + nrm(ks[9], (L, M_HEADS), 0.5),
        "q_norm_g": gain(ks[10], (L, Q_LORA)),
        "kv_norm_g": gain(ks[11], (L, KV_LORA)),
        "w_uq": nrm(ks[12], (L, Q_LORA, A_HEADS * (QK_NOPE + QK_ROPE)), Q_LORA ** -0.5),
        "w_ukv": nrm(ks[13], (L, KV_LORA, A_HEADS * (QK_NOPE + V_HEAD)), KV_LORA ** -0.5),
        "w_branch_m": nrm(ks[14], (L, M_V_WIDTH, D), M_V_WIDTH ** -0.5),
        "w_branch_a": nrm(ks[15], (L, A_V_WIDTH, D), A_V_WIDTH ** -0.5),
        "w_out": nrm(ks[16], (L, D, D), D ** -0.5),
        "norm2_g": gain(ks[17], (L, D)),
        "w_group": nrm(ks[18], (L, D, N_GROUPS), D ** -0.5),
        "b_group": nrm(ks[19], (L, N_GROUPS), 0.01),
        "w_router": nrm(ks[20], (L, D, N_EXPERTS), D ** -0.5),
        "b_router": nrm(ks[21], (L, N_EXPERTS), 0.01),
        "w_expert_gate": nrm(ks[22], (L, N_EXPERTS, D, D_EXPERT), D ** -0.5),
        "w_expert_up": nrm(ks[23], (L, N_EXPERTS, D, D_EXPERT), D ** -0.5),
        "w_expert_down": nrm(ks[24], (L, N_EXPERTS, D_EXPERT, D), D_EXPERT ** -0.5),
        "final_norm_g": gain(ks[25], (D,)),
    }


def reference(x, c, mod_w, mod_b, norm1_g, w_in, conv_w, conv_b, igate_b, fgate_b,
              q_norm_g, kv_norm_g, w_uq, w_ukv, w_branch_m, w_branch_a, w_out, norm2_g,
              w_group, b_group, w_router, b_router, w_expert_gate, w_expert_up,
              w_expert_down, final_norm_g):
    B, S, D = x.shape
    pos = jnp.arange(S, dtype=jnp.float32)
    inv_freq = 1.0 / (ROPE_THETA ** (jnp.arange(0, QK_ROPE, 2, dtype=jnp.float32) / QK_ROPE))
    ang = pos[:, None] * inv_freq[None, :]
    cos = jnp.cos(ang).astype(x.dtype)
    sin = jnp.sin(ang).astype(x.dtype)
    cond = jax.nn.silu(c)
    for l in range(DEPTH):
        mod = cond @ mod_w[l] + mod_b[l]
        shift1, scale1, gate1, shift2, scale2, gate2 = jnp.split(mod, N_MOD, axis=-1)
        h = modulate(rms_norm(x, norm1_g[l]), shift1, scale1)
        x = x + gate1[:, None, :] * mixer_sublayer(
            h, cos, sin, w_in[l], conv_w[l], conv_b[l], igate_b[l], fgate_b[l],
            q_norm_g[l], kv_norm_g[l], w_uq[l], w_ukv[l], w_branch_m[l], w_branch_a[l], w_out[l])
        h = modulate(rms_norm(x, norm2_g[l]), shift2, scale2)
        x = x + gate2[:, None, :] * hierarchical_moe(
            h, w_group[l], b_group[l], w_router[l], b_router[l],
            w_expert_gate[l], w_expert_up[l], w_expert_down[l])
    return rms_norm(x, final_norm_g)
```

```cpp
#include <hip/hip_runtime.h>
#include <cstdio>
#include <cstdint>

#ifndef PHASE_MASK
#define PHASE_MASK 0xFFFFFFFFu
#endif

#define LAS __attribute__((address_space(3)))
#define GAS __attribute__((address_space(1)))
typedef unsigned short bf16_t;
typedef short bf16x8 __attribute__((ext_vector_type(8)));
typedef short s16x4 __attribute__((ext_vector_type(4)));
typedef float f32x2 __attribute__((ext_vector_type(2)));
typedef float f32x4 __attribute__((ext_vector_type(4)));
typedef float f32x16 __attribute__((ext_vector_type(16)));
typedef unsigned u32x2 __attribute__((ext_vector_type(2)));
typedef unsigned u32x4 __attribute__((ext_vector_type(4)));
typedef int i32x8 __attribute__((ext_vector_type(8)));

constexpr int T = 32768, D = 1024, NBATCH = 4, SEQ = 8192, DEPTH = 2;
constexpr int D_IN = 5832, NIN = 3840;
constexpr int NWAVES = 8, NTHREADS = 512;
constexpr float EPS = 1e-6f;

constexpr size_t MiB = 1u << 20;
constexpr size_t WS_CTL = 0, CTL_ZERO_BYTES = 128 * 1024;
constexpr size_t WS_MODP = 1 * MiB;
constexpr size_t WS_MODF = 3 * MiB;
constexpr size_t WS_ROPE = 4 * MiB;
constexpr size_t WS_GATE = 6 * MiB;
constexpr size_t WS_CHK = 9 * MiB;
constexpr size_t WS_IFG = 11 * MiB;
constexpr size_t WS_RSTD = 12 * MiB;
constexpr size_t WS_W = 13 * MiB;
constexpr size_t W_IN = 0, W_GM = W_IN + (size_t)NIN * 1024 * 2, W_GA = W_GM + 2 * MiB, W_M = W_GA + 2 * MiB, W_A = W_M + 2 * MiB, W_OUT = W_A + 2 * MiB,
                 W_UQ = W_OUT + 2 * MiB, W_UKV = W_UQ + (size_t)1536 * 384 * 2, W_GU = W_UKV + (size_t)2048 * 256 * 2, W_DN = W_GU + 32 * MiB, W_END = W_DN + 16 * MiB;
static_assert(WS_W + W_END <= 84 * MiB, "weights region");
constexpr size_t WS_SMALL = 84 * MiB;
constexpr size_t WS_CQ = WS_SMALL, WS_CKV = WS_CQ + 24 * MiB, WS_KR = WS_CKV + 16 * MiB;
constexpr size_t WS_LDEST = WS_SMALL, WS_LW = WS_SMALL + 4 * MiB;
constexpr size_t WS_S0 = 128 * MiB, SLOT = 64 * MiB;
constexpr size_t WS_END = WS_S0 + 6 * SLOT;
#define WS_S(i) (WS_S0 + (size_t)(i) * SLOT)

constexpr int CW_BAR = 4096;
constexpr int CW_CNT = 16384;

constexpr int RING_BYTES = 131072;
constexpr int LDSX_OFF = RING_BYTES;
constexpr int LDSCTL_OFF = 163840 - 512;
constexpr int LDS_BYTES = 163840;

typedef __bf16 bf16x2_t __attribute__((ext_vector_type(2)));
__device__ __forceinline__ unsigned cvt_pk_bf16(float lo, float hi) { const f32x2 v = {lo, hi}; return __builtin_bit_cast(unsigned, __builtin_convertvector(v, bf16x2_t)); }
__device__ __forceinline__ unsigned pk4_fp8(float a, float b, float c, float d) { int w = 0; w = __builtin_amdgcn_cvt_pk_fp8_f32(a, b, w, false); w = __builtin_amdgcn_cvt_pk_fp8_f32(c, d, w, true); return (unsigned)w; }
constexpr float W8_SCALE = 64.f; constexpr int W8_E8M0 = 127 - 6;
__device__ __forceinline__ float bf_lo(unsigned w) { return __uint_as_float(w << 16); }
__device__ __forceinline__ float bf_hi(unsigned w) { return __uint_as_float(w & 0xffff0000u); }
__device__ __forceinline__ float bf1(bf16_t h) { return __uint_as_float(((unsigned)h) << 16); }
template <int CTRL> __device__ __forceinline__ float dpp_f(float v) { return __int_as_float(__builtin_amdgcn_update_dpp(0, __float_as_int(v), CTRL, 0xF, 0xF, false)); }
__device__ __forceinline__ float rdlane(float v, int l) { return __int_as_float(__builtin_amdgcn_readlane(__float_as_int(v), l)); }
__device__ __forceinline__ float wave_sum(float v) {
    v += dpp_f<0xB1>(v); v += dpp_f<0x4E>(v); v += dpp_f<0x141>(v); v += dpp_f<0x140>(v);
    return (__int_as_float(__builtin_amdgcn_readlane(__float_as_int(v), 0)) + __int_as_float(__builtin_amdgcn_readlane(__float_as_int(v), 16)))
         + (__int_as_float(__builtin_amdgcn_readlane(__float_as_int(v), 32)) + __int_as_float(__builtin_amdgcn_readlane(__float_as_int(v), 48)));
}
__device__ __forceinline__ float wave_max(float v) {
    v = fmaxf(v, dpp_f<0xB1>(v)); v = fmaxf(v, dpp_f<0x4E>(v)); v = fmaxf(v, dpp_f<0x141>(v)); v = fmaxf(v, dpp_f<0x140>(v));
    return fmaxf(fmaxf(__int_as_float(__builtin_amdgcn_readlane(__float_as_int(v), 0)), __int_as_float(__builtin_amdgcn_readlane(__float_as_int(v), 16))),
                 fmaxf(__int_as_float(__builtin_amdgcn_readlane(__float_as_int(v), 32)), __int_as_float(__builtin_amdgcn_readlane(__float_as_int(v), 48))));
}
__device__ __forceinline__ float sigmoidf_(float x) { return __builtin_amdgcn_rcpf(1.f + __builtin_amdgcn_exp2f(-1.4426950408889634f * x)); }
__device__ __forceinline__ float siluf_(float x) { return x * __builtin_amdgcn_rcpf(1.f + __builtin_amdgcn_exp2f(-1.4426950408889634f * x)); }
#define LDS_WAIT() asm volatile("s_waitcnt lgkmcnt(0)" ::: "memory")
#define VM_WAIT() asm volatile("s_waitcnt vmcnt(0)" ::: "memory")
__device__ __forceinline__ int lane_opaque() { int z = 0; asm volatile("" : "+v"(z)); return __builtin_amdgcn_mbcnt_hi(~0u, __builtin_amdgcn_mbcnt_lo(~0u, z)); }
__device__ __forceinline__ int wave_sgpr() { return __builtin_amdgcn_readfirstlane((int)threadIdx.x >> 6); }
__device__ __forceinline__ int tid_opaque(int wave) { return wave * 64 + lane_opaque(); }

#define XB_TMO      128
#define XB_XCNT(j)  (256  + 64 * (j))
#define XB_XSUB(j)  (1280 + 64 * (j))
#define XB_XGEN(j)  (2304 + 64 * (j))
#define XB_TOP      3328
#define XB_TOPGEN   3392
#define XCD_BAR_WORDS 3456
#define XB_SPIN_CAP (1u << 18)
__device__ __forceinline__ unsigned xb_ld(unsigned* p)              { return __hip_atomic_load(p, __ATOMIC_RELAXED, __HIP_MEMORY_SCOPE_AGENT); }
__device__ __forceinline__ unsigned xb_add(unsigned* p, unsigned v) { return __hip_atomic_fetch_add(p, v, __ATOMIC_RELAXED, __HIP_MEMORY_SCOPE_AGENT); }
__device__ __forceinline__ unsigned xb_xcc_id() { return (unsigned)__builtin_amdgcn_s_getreg((3 << 11) | 20) & 0xFu; }
#define XB_SPIN(cond, bar) do { unsigned _sp = 0; while (cond) { __builtin_amdgcn_s_sleep(1); \
    if ((++_sp & 255u) == 0u) { if (xb_ld(&(bar)[XB_TMO])) break; if (_sp > XB_SPIN_CAP) { atomicAdd(&(bar)[XB_TMO], 1u); break; } } } } while (0)
struct XcdBarrier { unsigned* bar; unsigned x; volatile LAS unsigned* st; };
__device__ __forceinline__ XcdBarrier xcd_barrier_post(unsigned* bar, volatile LAS unsigned* st) {
    XcdBarrier b; b.bar = bar; b.x = xb_xcc_id(); b.st = st;
    if (threadIdx.x == 0) (void)xb_add(&bar[XB_XCNT(b.x)], 1u);
    return b;
}
__device__ __forceinline__ void xcd_barrier_complete(unsigned* bar, unsigned x, unsigned& nloc, unsigned& nx) {
    const unsigned G = gridDim.x * gridDim.y * gridDim.z;
    unsigned sum, cnt, mine, sp = 0u;
    for (;;) {
        sum = 0u; cnt = 0u; mine = 0u;
#pragma unroll 1
        for (unsigned j = 0; j < 16; ++j) { const unsigned c = xb_ld(&bar[XB_XCNT(j)]); sum += c; cnt += (c > 0u) ? 1u : 0u; mine = (j == x) ? c : mine; }
        if (sum == G) break;
        __builtin_amdgcn_s_sleep(1);
        if ((++sp & 255u) == 0u) { if (xb_ld(&bar[XB_TMO])) break; if (sp > XB_SPIN_CAP) { atomicAdd(&bar[XB_TMO], 1u); break; } }
    }
    nloc = mine > 0u ? mine : 1u; nx = cnt > 0u ? cnt : 1u;
}
__device__ __forceinline__ void xcd_barrier(const XcdBarrier& b) {
    asm volatile("s_waitcnt vmcnt(0)" ::: "memory");
    __syncthreads();
    if (threadIdx.x == 0) {
        unsigned* bar = b.bar;
        __builtin_amdgcn_s_waitcnt(0);
        unsigned nloc = b.st[0], nx = b.st[1];
        if (nloc == 0u) { xcd_barrier_complete(bar, b.x, nloc, nx); b.st[0] = nloc; b.st[1] = nx; }
        const unsigned old = xb_add(&bar[XB_XSUB(b.x)], 1u);
        const unsigned gen = old / nloc;
        if (old + 1u == (gen + 1u) * nloc) {
            __builtin_amdgcn_fence(__ATOMIC_RELEASE, "agent");
            asm volatile("s_waitcnt vmcnt(0)" ::: "memory");
            const unsigned og = xb_add(&bar[XB_TOP], 1u);
            const unsigned tg = og / nx;
            if (og + 1u == (tg + 1u) * nx) xb_add(&bar[XB_TOPGEN], 1u);
            else XB_SPIN(xb_ld(&bar[XB_TOPGEN]) == tg, bar);
            __builtin_amdgcn_fence(__ATOMIC_ACQUIRE, "agent");
            asm volatile("s_waitcnt vmcnt(0)" ::: "memory");
        } else {
            XB_SPIN(xb_ld(&bar[XB_TOPGEN]) == gen, bar);
            __builtin_amdgcn_fence(__ATOMIC_ACQUIRE, "agent");
            asm volatile("s_waitcnt vmcnt(0)" ::: "memory");
        }
    }
    __syncthreads();
}

namespace pg8 {
constexpr int BM = 256, BK = 64, HALF = 128, HTB = HALF * BK * 2, STAGE_BYTES = 8 * HTB, NXCD = 8, WGM = 8;
__host__ __device__ __forceinline__ int lds_byte(int r, int c) { const int st = (r >> 4) * 2 + (c >> 5), rr = r & 15, cc = c & 31, ob = rr * 64 + cc * 2; return st * 1024 + (ob ^ (((ob >> 9) & 1) << 5)); }
__host__ __device__ __forceinline__ void stage_rc(int b, int& R, int& C) { const int st = b / 1024, sb = b % 1024, swz = sb ^ (((sb >> 9) & 1) << 5); R = (st >> 1) * 16 + swz / 64; C = (st & 1) * 32 + (swz % 64) / 2; }
__host__ __device__ __forceinline__ int perm32(int rho) { const int n = rho >> 4, i = rho & 15; return 8 * (i >> 2) + 4 * n + (i & 3); }

struct Unit { int pm, pn, aux, e, r0, nv; };

__device__ __forceinline__ void tile_of(int L, int nM, int nN, int& pm, int& pn) {
    const int nwg = nM * nN; int wgid = L;
    { const int q = nwg / NXCD, r = nwg % NXCD, xcd = wgid % NXCD, off = wgid / NXCD; wgid = (xcd < r ? xcd * (q + 1) : r * (q + 1) + (xcd - r) * q) + off; }
    const int nig = WGM * nN, gid = wgid / nig, fm = gid * WGM, gsz = (nM - fm) < WGM ? (nM - fm) : WGM;
    pm = fm + ((wgid % nig) % gsz); pn = (wgid % nig) / gsz;
}

template <bool F8_>
struct DenseOrderT {
    static constexpr bool GATHER = false, F8 = F8_; static constexpr int EB = F8_ ? 1 : 2;
    const char* A; const char* B; int nM, nN, G, c, K, lda, ldb, scaleA, scaleB;
    __device__ __forceinline__ void init(const void* A_, const void* B_, int M, int N, int K_, int lda_, int ldb_, int G_, int c_, int sB = 127) { A = (const char*)A_; B = (const char*)B_; nM = M / BM; nN = N / BM; G = G_; c = c_; K = K_; lda = lda_; ldb = ldb_; scaleA = 127; scaleB = sB; }
    __device__ __forceinline__ bool next(int i, Unit& u) const { const long L = (long)i * G + c; if (L >= (long)nM * nN) return false; tile_of((int)L, nM, nN, u.pm, u.pn); u.aux = 0; return true; }
    __device__ __forceinline__ const char* abase(const Unit& u) const { return A + (size_t)u.pm * BM * lda * EB; }
    __device__ __forceinline__ const char* bbase(const Unit& u) const { return B + (size_t)u.pn * BM * ldb * EB; }
    __device__ __forceinline__ unsigned arow(const Unit&, int r) const { return (unsigned)r; }
};
typedef DenseOrderT<false> DenseOrder;
typedef DenseOrderT<true> DenseOrder8;

template <class Epi, class Sched>
__device__ __forceinline__ void gemm_phase(LAS unsigned char* lds, const Sched& S, const Epi& E, int wave0) {
    const int tid = tid_opaque(wave0), wid = wave0, lane = tid & 63, wr = wid >> 2, wc = wid & 3, fr = lane & 15, fq = lane >> 4;
    constexpr bool F8 = Sched::F8; constexpr int EB = F8 ? 1 : 2;
    const int K = S.K, nt = K / (F8 ? 128 : BK), lda = S.lda, ldb = S.ldb;
    unsigned voffB0; { int R_, C_; stage_rc(tid * 16, R_, C_); const int Rb = Epi::PERM ? ((R_ & ~31) + perm32(R_ & 31)) : R_; voffB0 = (unsigned)(Rb * ldb * EB + C_ * 2); }
    const size_t pstepA = (size_t)64 * lda * EB, pstepB = (size_t)64 * ldb * EB, hstepA = (size_t)HALF * lda * EB;
    const size_t kstep = (size_t)(BK * 2);
    const size_t hstepB = (size_t)HALF * ldb * EB;
    const unsigned ldsw = (unsigned)wid * 1024u;
    const int aoff = lds_byte(wr * 64 + fr, fq * 8), boff = lds_byte(wc * 32 + fr, fq * 8);
    const int aoff0 = aoff, aoff1 = aoff + 1024, boff0 = boff, boff1 = boff + 1024;
#define PG8_SA(b, h) (((b) * 2 + (h)) * HTB)
#define PG8_SB(b, h) ((4 + (b) * 2 + (h)) * HTB)
#define PG8_STAGE2(bufoff, gbase, v0, pstep) do { \
        __builtin_amdgcn_global_load_lds((const unsigned*)((const char*)(gbase) + (v0)), (LAS unsigned*)(lds + (bufoff) + ldsw), 16, 0, 0); \
        __builtin_amdgcn_global_load_lds((const unsigned*)((const char*)(gbase) + (pstep) + (v0)), (LAS unsigned*)(lds + (bufoff) + ldsw + 8192), 16, 0, 0); } while (0)
#define PG8_STAGE(bufoff, gbase, v0, v1) do { \
        __builtin_amdgcn_global_load_lds((const unsigned*)((const char*)(gbase) + (v0)), (LAS unsigned*)(lds + (bufoff) + ldsw), 16, 0, 0); \
        __builtin_amdgcn_global_load_lds((const unsigned*)((const char*)(gbase) + (v1)), (LAS unsigned*)(lds + (bufoff) + ldsw + 8192), 16, 0, 0); } while (0)
#define PG8_LDA(dst, b, h) do { if constexpr (F8) { _Pragma("unroll") for (int m = 0; m < 4; ++m) { const u32x4 x0_ = *(const LAS u32x4*)(lds + PG8_SA(b, h) + aoff0 + m * 2048), x1_ = *(const LAS u32x4*)(lds + PG8_SA(b, h) + aoff1 + m * 2048); \
            dst##8[m] = (i32x8){(int)x0_.x, (int)x0_.y, (int)x0_.z, (int)x0_.w, (int)x1_.x, (int)x1_.y, (int)x1_.z, (int)x1_.w}; } } \
        else { _Pragma("unroll") for (int m = 0; m < 4; ++m) _Pragma("unroll") for (int k = 0; k < 2; ++k) dst[m][k] = *(const LAS bf16x8*)(lds + PG8_SA(b, h) + aoff + m * 2048 + k * 1024); } } while (0)
#define PG8_LDB(dst, b, h) do { if constexpr (F8) { _Pragma("unroll") for (int n = 0; n < 2; ++n) { const u32x4 x0_ = *(const LAS u32x4*)(lds + PG8_SB(b, h) + boff0 + n * 2048), x1_ = *(const LAS u32x4*)(lds + PG8_SB(b, h) + boff1 + n * 2048); \
            dst##8[n] = (i32x8){(int)x0_.x, (int)x0_.y, (int)x0_.z, (int)x0_.w, (int)x1_.x, (int)x1_.y, (int)x1_.z, (int)x1_.w}; } } \
        else { _Pragma("unroll") for (int n = 0; n < 2; ++n) _Pragma("unroll") for (int k = 0; k < 2; ++k) dst[n][k] = *(const LAS bf16x8*)(lds + PG8_SB(b, h) + boff + n * 2048 + k * 1024); } } while (0)
#define PG8_MMA(ai, bj, At, Bt) do { __builtin_amdgcn_s_setprio(1); if constexpr (F8) { _Pragma("unroll") for (int m = 0; m < 4; ++m) _Pragma("unroll") for (int n = 0; n < 2; ++n) \
            asm volatile("v_mfma_scale_f32_16x16x128_f8f6f4 %0, %1, %2, %0, %3, %4 op_sel_hi:[0,0,0]" : "+v"(acc[ai][bj][m][n]) : "v"(Bt##8[n]), "v"(At##8[m]), "v"(scB), "v"(scA)); } \
        else { _Pragma("unroll") for (int m = 0; m < 4; ++m) _Pragma("unroll") for (int n = 0; n < 2; ++n) _Pragma("unroll") for (int k = 0; k < 2; ++k) \
            acc[ai][bj][m][n] = __builtin_amdgcn_mfma_f32_16x16x32_bf16(Bt[n][k], At[m][k], acc[ai][bj][m][n], 0, 0, 0); } __builtin_amdgcn_s_setprio(0); } while (0)
#define PG8_WAIT_V(n) asm volatile("s_waitcnt vmcnt(" #n ")" ::: "memory")
#define PG8_WAIT_L(n) asm volatile("s_waitcnt lgkmcnt(" #n ")" ::: "memory")
#define PG8_BAR __builtin_amdgcn_s_barrier()
#define PG8_SCHED __builtin_amdgcn_sched_barrier(0)
    LAS unsigned* const rowtab = (LAS unsigned*)(lds + STAGE_BYTES);
    int gR0, gC0; stage_rc(tid * 16, gR0, gC0); const unsigned gcol2 = (unsigned)gC0 * 2u;
#define PG8_FILL(u, par) do { if (tid < 256) rowtab[(par) * 256 + tid] = S.arow(u, tid) * (unsigned)(lda * EB); } while (0)
#define PG8_STAGE_AG(bufoff, gbase, par, h) do { const unsigned o0_ = rowtab[(par) * 256 + (h) * 128 + gR0] + gcol2, o1_ = rowtab[(par) * 256 + (h) * 128 + 64 + gR0] + gcol2; PG8_STAGE(bufoff, gbase, o0_, o1_); } while (0)
#define PG8_VOFFA(u, vo) do { int R_, C_; stage_rc(tid * 16, R_, C_); vo = (unsigned)R_ * (unsigned)(lda * EB) + (unsigned)C_ * 2u; } while (0)
    Unit cur, nxt; int ui = 0;
    if (!S.next(0, cur)) return;
    f32x4 acc[2][2][4][2];
#pragma unroll
    for (int a = 0; a < 2; ++a)
#pragma unroll
        for (int b = 0; b < 2; ++b)
#pragma unroll
            for (int m = 0; m < 4; ++m)
#pragma unroll
                for (int n = 0; n < 2; ++n) acc[a][b][m][n] = (f32x4){0.f, 0.f, 0.f, 0.f};
    bf16x8 At[4][2], B0[2][2], B1[2][2]; i32x8 At8[4], B08[2], B18[2]; (void)At; (void)B0; (void)B1; (void)At8; (void)B08; (void)B18;
    unsigned est[Epi::STATE ? 32 : 1]; (void)est;
    int scA = S.scaleA, scB = S.scaleB; asm volatile("" : "+v"(scA), "+v"(scB));
    unsigned vc0 = 0u;
    int par = 0;
    if constexpr (Sched::GATHER) { PG8_FILL(cur, 0); __syncthreads(); } else { PG8_VOFFA(cur, vc0); }
#define PG8_STAGE_A(bufoff, gbase, nextu, h) do { if constexpr (Sched::GATHER) { PG8_STAGE_AG(bufoff, gbase, (nextu) ? (par ^ 1) : par, h); } else { PG8_STAGE2(bufoff, (gbase) + (h) * hstepA, vc0, pstepA); } } while (0)
    const char* cA = S.abase(cur); const char* cB = S.bbase(cur);
    PG8_STAGE2(PG8_SB(0, 0), cB, voffB0, pstepB); PG8_STAGE2(PG8_SB(0, 1), cB + hstepB, voffB0, pstepB); PG8_STAGE_A(PG8_SA(0, 0), cA, false, 0); PG8_STAGE_A(PG8_SA(0, 1), cA, false, 1);
    if (wr == 1) PG8_BAR;
    PG8_WAIT_V(2); PG8_BAR;
    PG8_STAGE2(PG8_SB(1, 0), cB + kstep, voffB0, pstepB); PG8_STAGE_A(PG8_SA(1, 0), cA + kstep, false, 0); PG8_STAGE2(PG8_SB(1, 1), cB + hstepB + kstep, voffB0, pstepB);
    PG8_WAIT_V(6); PG8_BAR;
    for (;;) {
        const bool has_next = S.next(ui + 1, nxt);
        const char* nA = has_next ? S.abase(nxt) : cA; const char* nB = has_next ? S.bbase(nxt) : cB;
        for (int t = 0; t < nt; t += 2) {
            const bool last = (t == nt - 2);
            const bool nx = last && has_next;
            if constexpr (Sched::GATHER) { if (nx) PG8_FILL(nxt, par ^ 1); }
            const char* a1 = cA + (size_t)(t + 1) * kstep;
            const char* a2 = last ? nA : cA + (size_t)(t + 2) * kstep; const char* b2 = last ? nB : cB + (size_t)(t + 2) * kstep;
            const char* a3 = a2 + kstep; const char* b3 = b2 + kstep;
            PG8_LDB(B0, 0, 0); PG8_LDB(B1, 0, 1); PG8_SCHED; PG8_LDA(At, 0, 0); PG8_STAGE_A(PG8_SA(1, 1), a1, false, 1);
            PG8_WAIT_V(8); PG8_WAIT_L(0); PG8_BAR; PG8_MMA(0, 0, At, B0); PG8_MMA(0, 1, At, B1); PG8_BAR; PG8_SCHED;
            PG8_LDA(At, 0, 1); PG8_STAGE2(PG8_SB(0, 0), b2, voffB0, pstepB); PG8_STAGE2(PG8_SB(0, 1), b2 + hstepB, voffB0, pstepB); PG8_STAGE_A(PG8_SA(0, 0), a2, nx, 0);
            PG8_WAIT_V(8); PG8_WAIT_L(0); PG8_BAR; PG8_MMA(1, 0, At, B0); PG8_MMA(1, 1, At, B1); PG8_BAR; PG8_SCHED;
            PG8_LDB(B0, 1, 0); PG8_LDB(B1, 1, 1); PG8_SCHED; PG8_LDA(At, 1, 0); PG8_STAGE_A(PG8_SA(0, 1), a2, nx, 1);
            PG8_WAIT_V(8); PG8_WAIT_L(0); PG8_BAR; PG8_MMA(0, 0, At, B0); PG8_MMA(0, 1, At, B1); PG8_BAR; PG8_SCHED;
            PG8_LDA(At, 1, 1); PG8_STAGE2(PG8_SB(1, 0), b3, voffB0, pstepB); PG8_STAGE2(PG8_SB(1, 1), b3 + hstepB, voffB0, pstepB); PG8_STAGE_A(PG8_SA(1, 0), a3, nx, 0);
            PG8_WAIT_V(8); PG8_WAIT_L(0); PG8_BAR; PG8_MMA(1, 0, At, B0); PG8_MMA(1, 1, At, B1); PG8_BAR; PG8_SCHED;
        }
        if (wr == 0) PG8_BAR;
        if constexpr (F8) asm volatile("s_nop 15\n\ts_nop 15" ::: "memory");
        { const int ln_ = lane_opaque(); const int fr_ = ln_ & 15, fq_ = ln_ >> 4;
          if constexpr (Epi::STATE) E(acc, cur, wr, wc, fr_, fq_, est); else E(acc, cur, wr, wc, fr_, fq_); }
        if (!has_next) break;
#pragma unroll
        for (int a = 0; a < 2; ++a)
#pragma unroll
            for (int b = 0; b < 2; ++b)
#pragma unroll
                for (int m = 0; m < 4; ++m)
#pragma unroll
                    for (int n = 0; n < 2; ++n) acc[a][b][m][n] = (f32x4){0.f, 0.f, 0.f, 0.f};
        cur = nxt; cA = nA; cB = nB; ++ui; par ^= 1;
        if (wr == 1) PG8_BAR;
    }
    PG8_WAIT_V(0);
    PG8_BAR;
#undef PG8_SA
#undef PG8_SB
#undef PG8_STAGE
#undef PG8_STAGE2
#undef PG8_LDA
#undef PG8_LDB
#undef PG8_MMA
#undef PG8_WAIT_V
#undef PG8_WAIT_L
#undef PG8_BAR
#undef PG8_SCHED
#undef PG8_VOFFA
#undef PG8_FILL
#undef PG8_STAGE_AG
#undef PG8_STAGE_A
}
}

#define EPI8_LOOP(...) \
    _Pragma("unroll") for (int ai = 0; ai < 2; ++ai) _Pragma("unroll") for (int m = 0; m < 4; ++m) { asm volatile("" ::: "memory"); const int rl = ai * 128 + wr * 64 + m * 16 + fr; const int row = u.pm * 256 + rl; (void)row; \
    _Pragma("unroll") for (int bj = 0; bj < 2; ++bj) { const int cl = bj * 128 + wc * 32 + 8 * fq; const int col = u.pn * 256 + cl; (void)col; const f32x4 v0 = acc[ai][bj][m][0], v1 = acc[ai][bj][m][1]; __VA_ARGS__ } }

struct Args { const float* in[26]; float* out; unsigned char* ws; };
#define CAS __attribute__((address_space(4)))
typedef const CAS Args* ArgP;
#define GAS __attribute__((address_space(1)))
#define GIN(a, i) ((const float*)(const GAS float*)(a)->in[i])
#define GOUT(a) ((float*)(GAS float*)(a)->out)
__device__ __forceinline__ ArgP argp() { unsigned long long p = (unsigned long long)(const CAS void*)__builtin_amdgcn_kernarg_segment_ptr(); asm volatile("" : "+s"(p)); return (ArgP)p; }
enum { I_X = 0, I_C, I_MODW, I_MODB, I_N1G, I_WIN, I_CONVW, I_CONVB, I_IGB, I_FGB, I_QNG, I_KVNG, I_WUQ, I_WUKV, I_WBM, I_WBA, I_WOUT, I_N2G, I_WGRP, I_BGRP, I_WRT, I_BRT, I_WEG, I_WEU, I_WED, I_FNG };

struct Frame {
    LAS unsigned char* lds;
    unsigned char* ws;
    int tid, lane, wave, wave0, bid, G;
    __device__ __forceinline__ void refresh() { { int w_ = wave0, b_ = blockIdx.x, g_ = gridDim.x; asm volatile("" : "+s"(w_), "+s"(b_), "+s"(g_)); wave = w_; bid = b_; G = g_; }
        tid = wave * 64 + lane_opaque(); lane = tid & 63;
        unsigned long long w = (unsigned long long)ws; asm volatile("" : "+s"(w)); ws = (unsigned char*)(GAS unsigned char*)w; }
};

template <class ColMap>
__device__ __forceinline__ void cvt_load(const ColMap& cm, int K, int item, int lane, f32x4 (&v)[8]) {
    const int nkb = K / 64, rb = item / nkb, kb = item % nkb, k0 = 64 * kb, r0 = 32 * rb;
    const int rq = r0 + 4 * (lane & 7);
    const float* src; int ld; const float* s1; int l1;
    const int c0 = cm.col(rq, src, ld), c1 = cm.col(rq + 1, s1, l1), c2 = cm.col(rq + 2, s1, l1), c3 = cm.col(rq + 3, s1, l1);
    const bool vec = (c0 >= 0) && (c1 == c0 + 1) && (c2 == c0 + 2) && (c3 == c0 + 3) && ((c0 & 3) == 0) && (s1 == src);
#pragma unroll
    for (int i = 0; i < 8; ++i) { const int kk = (lane >> 3) + 8 * i; v[i] = (f32x4){0.f, 0.f, 0.f, 0.f};
        if (vec) v[i] = *(const f32x4*)(src + (size_t)(k0 + kk) * ld + c0);
        else { const float* sa; int la; int c;
            c = cm.col(rq, sa, la); if (c >= 0) v[i].x = sa[(size_t)(k0 + kk) * la + c];
            c = cm.col(rq + 1, sa, la); if (c >= 0) v[i].y = sa[(size_t)(k0 + kk) * la + c];
            c = cm.col(rq + 2, sa, la); if (c >= 0) v[i].z = sa[(size_t)(k0 + kk) * la + c];
            c = cm.col(rq + 3, sa, la); if (c >= 0) v[i].w = sa[(size_t)(k0 + kk) * la + c]; } }
}
template <bool F8, class ColMap>
__device__ __forceinline__ void cvt_store(const ColMap& cm, int K, void* dstv, LAS float* scr, int item, int lane, const f32x4 (&v)[8]) {
    const int nkb = K / 64, rb = item / nkb, kb = item % nkb, k0 = 64 * kb, r0 = 32 * rb;
#pragma unroll
    for (int i = 0; i < 8; ++i) { const int kk = (lane >> 3) + 8 * i; *(LAS f32x4*)(scr + kk * 36 + 4 * (lane & 7)) = v[i] * cm.kscale(k0 + kk); }
    LDS_WAIT(); asm volatile("" ::: "memory");
    const int c = lane & 7;
#pragma unroll
    for (int j = 0; j < 4; ++j) { const int n = (lane >> 3) + 8 * j; const LAS float* s = scr + (8 * c) * 36 + n;
        if constexpr (F8) { u32x2 o; o.x = pk4_fp8(s[0 * 36] * W8_SCALE, s[1 * 36] * W8_SCALE, s[2 * 36] * W8_SCALE, s[3 * 36] * W8_SCALE); o.y = pk4_fp8(s[4 * 36] * W8_SCALE, s[5 * 36] * W8_SCALE, s[6 * 36] * W8_SCALE, s[7 * 36] * W8_SCALE);
            *(u32x2*)((unsigned char*)dstv + (size_t)(r0 + n) * K + k0 + 8 * c) = o; }
        else { u32x4 o; o.x = cvt_pk_bf16(s[0 * 36], s[1 * 36]); o.y = cvt_pk_bf16(s[2 * 36], s[3 * 36]); o.z = cvt_pk_bf16(s[4 * 36], s[5 * 36]); o.w = cvt_pk_bf16(s[6 * 36], s[7 * 36]);
            *(u32x4*)((bf16_t*)dstv + (size_t)(r0 + n) * K + k0 + 8 * c) = o; } }
    LDS_WAIT(); asm volatile("" ::: "memory");
}
struct CmOffset { const float* W; int ld, off; __device__ __forceinline__ int col(int r, const float*& s, int& l) const { s = W; l = ld; return off + r; } __device__ __forceinline__ float kscale(int) const { return 1.f; } };
struct CmIn { const float* W; __device__ __forceinline__ int col(int r, const float*& s, int& l) const { s = W; l = D_IN;
        if (r < 3072) return r; if (r < 3456) return 3080 + (r - 3072); if (r < 3712) return 3464 + (r - 3456);
        if (r < 3776) { const int i = r - 3712, j = i >> 1; return 3720 + ((i & 1) ? 32 + j : j); }
        if (r < 3784) return 3072 + (r - 3776); return -1; }
    __device__ __forceinline__ float kscale(int) const { return 1.f; } };
struct CmUq { const float* W; const float* g; __device__ __forceinline__ int col(int r, const float*& s, int& l) const { s = W; l = 1536;
        if (r < 1024) return (r >> 7) * 192 + (r & 127); const int i = r - 1024, h = i >> 6, p = i & 63, jj = p >> 1; return h * 192 + 128 + ((p & 1) ? 32 + jj : jj); }
    __device__ __forceinline__ float kscale(int k) const { return g[k]; } };
struct CmUkv { const float* W; const float* g; __device__ __forceinline__ int col(int r, const float*& s, int& l) const { s = W; l = 2048;
        if (r < 1024) return (r >> 7) * 256 + (r & 127); const int i = r - 1024; return (i >> 7) * 256 + 128 + (i & 127); }
    __device__ __forceinline__ float kscale(int k) const { return g[k]; } };
struct CmGu { const float* Wg; const float* Wu; __device__ __forceinline__ int col(int r, const float*& s, int& l) const { const int e = r >> 9, w = r & 511, pn = w >> 8, x = w & 255; l = 256;
        if (x < 128) { s = Wg + (size_t)e * 1024 * 256; return pn * 128 + x; } s = Wu + (size_t)e * 1024 * 256; return pn * 128 + x - 128; }
    __device__ __forceinline__ float kscale(int) const { return 1.f; } };
struct CmDn { const float* W; __device__ __forceinline__ int col(int r, const float*& s, int& l) const { const int e = r >> 10; s = W + (size_t)e * 256 * 1024; l = 1024; return r & 1023; }
    __device__ __forceinline__ float kscale(int) const { return 1.f; } };

template <int N> struct IC { static constexpr int value = N; };
template <class Fn>
__device__ __forceinline__ void cvt_dispatch(ArgP a, unsigned char* W, int l, int it, Fn&& fn) {
    const float* w_in = GIN(a, I_WIN) + (size_t)l * 1024 * D_IN;
    constexpr int N_IN = (NIN / 32) * 16, N_SQ = 32 * 16, N_UQ = 48 * 6, N_UKV = 64 * 4, N_GU = (32 * 512 / 32) * 16;
    int r = it;
    if (r < N_IN) { CmIn cm{w_in}; fn(cm, 1024, (void*)(W + W_IN), IC<1>{}, r); return; } r -= N_IN;
    if (r < N_SQ) { CmOffset cm{w_in, D_IN, 3784}; fn(cm, 1024, (void*)(W + W_GM), IC<1>{}, r); return; } r -= N_SQ;
    if (r < N_SQ) { CmOffset cm{w_in, D_IN, 3784 + 1024}; fn(cm, 1024, (void*)(W + W_GA), IC<1>{}, r); return; } r -= N_SQ;
    if (r < N_SQ) { CmOffset cm{GIN(a, I_WBM) + (size_t)l * 1024 * 1024, 1024, 0}; fn(cm, 1024, (void*)(W + W_M), IC<1>{}, r); return; } r -= N_SQ;
    if (r < N_SQ) { CmOffset cm{GIN(a, I_WBA) + (size_t)l * 1024 * 1024, 1024, 0}; fn(cm, 1024, (void*)(W + W_A), IC<1>{}, r); return; } r -= N_SQ;
    if (r < N_SQ) { CmOffset cm{GIN(a, I_WOUT) + (size_t)l * 1024 * 1024, 1024, 0}; fn(cm, 1024, (void*)(W + W_OUT), IC<1>{}, r); return; } r -= N_SQ;
    if (r < N_UQ) { CmUq cm{GIN(a, I_WUQ) + (size_t)l * 384 * 1536, GIN(a, I_QNG) + l * 384}; fn(cm, 384, (void*)(W + W_UQ), IC<0>{}, r); return; } r -= N_UQ;
    if (r < N_UKV) { CmUkv cm{GIN(a, I_WUKV) + (size_t)l * 256 * 2048, GIN(a, I_KVNG) + l * 256}; fn(cm, 256, (void*)(W + W_UKV), IC<1>{}, r); return; } r -= N_UKV;
    if (r < N_GU) { CmGu cm{GIN(a, I_WEG) + (size_t)l * 32 * 1024 * 256, GIN(a, I_WEU) + (size_t)l * 32 * 1024 * 256}; fn(cm, 1024, (void*)(W + W_GU), IC<1>{}, r); return; } r -= N_GU;
    { CmDn cm{GIN(a, I_WED) + (size_t)l * 32 * 256 * 1024}; fn(cm, 256, (void*)(W + W_DN), IC<1>{}, r); }
}
__device__ __forceinline__ void convert_weights(Frame& F, int l) {
    F.refresh();
    ArgP a = argp();
    LAS float* scr = (LAS float*)(F.lds + F.wave * 16384);
    unsigned char* W = F.ws + WS_W;
    const int gw = F.bid * NWAVES + F.wave, NGW = F.G * NWAVES;
    constexpr int N_IN = (NIN / 32) * 16, N_SQ = 32 * 16, N_UQ = 48 * 6, N_UKV = 64 * 4, N_GU = (32 * 512 / 32) * 16, N_DN = (32 * 1024 / 32) * 4;
    constexpr int NITEMS = N_IN + 5 * N_SQ + N_UQ + N_UKV + N_GU + N_DN;
    f32x4 va[8], vb[8];
    const int lane = F.lane;
    auto load_a = [&](int it) __attribute__((always_inline)) { cvt_dispatch(a, W, l, it, [&](auto cm, int K, void*, auto, int r) __attribute__((always_inline)) { cvt_load(cm, K, r, lane, va); }); };
    auto load_b = [&](int it) __attribute__((always_inline)) { cvt_dispatch(a, W, l, it, [&](auto cm, int K, void*, auto, int r) __attribute__((always_inline)) { cvt_load(cm, K, r, lane, vb); }); };
    auto store_a = [&](int it) __attribute__((always_inline)) { cvt_dispatch(a, W, l, it, [&](auto cm, int K, void* dst, auto f8, int r) __attribute__((always_inline)) { cvt_store<(decltype(f8)::value != 0)>(cm, K, dst, scr, r, lane, va); }); };
    auto store_b = [&](int it) __attribute__((always_inline)) { cvt_dispatch(a, W, l, it, [&](auto cm, int K, void* dst, auto f8, int r) __attribute__((always_inline)) { cvt_store<(decltype(f8)::value != 0)>(cm, K, dst, scr, r, lane, vb); }); };
    if (gw < NITEMS) load_a(gw);
    for (int it = gw; it < NITEMS; it += 2 * NGW) {
        if (it + NGW < NITEMS) load_b(it + NGW);
        store_a(it);
        if (it + 2 * NGW < NITEMS) load_a(it + 2 * NGW);
        if (it + NGW < NITEMS) store_b(it + NGW);
    }
}

__constant__ float kInvFreq[32] = {1.000000000e+00f, 7.498942018e-01f, 5.623413324e-01f, 4.216965139e-01f, 3.162277639e-01f, 2.371373922e-01f, 1.778279394e-01f, 1.333521456e-01f, 1.000000015e-01f, 7.498941571e-02f, 5.623412877e-02f, 4.216964915e-02f, 3.162277862e-02f, 2.371373586e-02f, 1.778279431e-02f, 1.333521493e-02f, 9.999999776e-03f, 7.498942316e-03f, 5.623413250e-03f, 4.216964822e-03f, 3.162277862e-03f, 2.371373819e-03f, 1.778279431e-03f, 1.333521446e-03f, 1.000000047e-03f, 7.498941850e-04f, 5.623413017e-04f, 4.216965463e-04f, 3.162277862e-04f, 2.371373848e-04f, 1.778279402e-04f, 1.333521504e-04f};
__device__ __forceinline__ void p0_prologue(Frame& F) {
    F.refresh();
    ArgP a = argp();
    LAS float* cond = (LAS float*)(F.lds);
    for (int i = F.tid; i < 4096; i += NTHREADS) cond[i] = siluf_(GIN(a, I_C)[i]);
    __syncthreads();
    float* modp = (float*)(F.ws + WS_MODP);
    const int gw = F.bid * NWAVES + F.wave, NGW = F.G * NWAVES;
    for (int it = gw; it < 2 * 96 * 8; it += NGW) {
        const int l = it / 768, r = it % 768, g = r >> 3, p = r & 7, col = g * 64 + F.lane;
        const float* w = GIN(a, I_MODW) + (size_t)l * 1024 * 6144 + (size_t)(p * 128) * 6144 + col;
        float s0 = 0.f, s1 = 0.f, s2 = 0.f, s3 = 0.f;
#pragma unroll 32
        for (int k = 0; k < 128; ++k) { const float wv = w[(size_t)k * 6144]; const int kk = p * 128 + k; s0 += cond[kk] * wv; s1 += cond[1024 + kk] * wv; s2 += cond[2048 + kk] * wv; s3 += cond[3072 + kk] * wv; }
        float* o = modp + ((size_t)(l * 8 + p) * 4) * 6144 + col;
        o[0] = s0; o[6144] = s1; o[2 * 6144] = s2; o[3 * 6144] = s3;
    }
    float* rc = (float*)(F.ws + WS_ROPE); float* rs = rc + 8192 * 32;
    for (int i = F.bid * NTHREADS + F.tid; i < 8192 * 32; i += F.G * NTHREADS) {
        const int pos = i >> 5, j = i & 31;
        const float invf = kInvFreq[j];
        const float angf = (float)pos * invf;
        const double x = (double)angf;
        const double kq = rint(x * 0.63661977236758134308);
        const double r = (x - kq * 1.57079632679489655800e+00) - kq * 6.12323399573676603587e-17;
        const double r2 = r * r;
        double sp = r * (1.0 + r2 * (-1.0 / 6 + r2 * (1.0 / 120 + r2 * (-1.0 / 5040 + r2 * (1.0 / 362880 + r2 * (-1.0 / 39916800 + r2 * (1.0 / 6227020800.0)))))));
        double cp = 1.0 + r2 * (-0.5 + r2 * (1.0 / 24 + r2 * (-1.0 / 720 + r2 * (1.0 / 40320 + r2 * (-1.0 / 3628800 + r2 * (1.0 / 479001600.0 + r2 * (-1.0 / 87178291200.0)))))));
        const int q = ((int)kq) & 3;
        const double sn = (q == 0) ? sp : (q == 1) ? cp : (q == 2) ? -sp : -cp;
        const double cs = (q == 0) ? cp : (q == 1) ? -sp : (q == 2) ? -cp : sp;
        rc[i] = (float)cs; rs[i] = (float)sn;
    }
}
__device__ __forceinline__ float mod_from_partials(ArgP a, const unsigned char* ws, int l, int b, int idx) {
    const float* modp = (const float*)(ws + WS_MODP);
    float s = GIN(a, I_MODB)[l * 6144 + idx];
#pragma unroll
    for (int p = 0; p < 8; ++p) s += modp[((size_t)(l * 8 + p) * 4 + b) * 6144 + idx];
    return s;
}

__device__ __forceinline__ bf16_t* xres(ArgP a, unsigned char* ws, int l) { return (l == DEPTH - 1) ? (bf16_t*)(ws + WS_S(4)) : (bf16_t*)GOUT(a); }
template <int MODE>
__device__ __forceinline__ void row_phase_norm1(Frame& F, int l) {
    F.refresh();
    ArgP a = argp();
    LAS float* tab = (LAS float*)(F.lds + LDSX_OFF);
    const int row0 = F.bid * 128, b = row0 / SEQ;
    for (int i = F.tid; i < 1024; i += NTHREADS) {
        const int p = ((((i >> 9) * 2 + ((i >> 2) & 1)) * 64 + ((i >> 3) & 63)) << 2) + (i & 3);
        const float* mf = (const float*)(F.ws + WS_MODF);
        if (MODE == 2) { tab[p] = GIN(a, I_FNG)[i]; }
        else if (MODE == 0) { tab[p] = GIN(a, I_N1G)[l * 1024 + i]; tab[1024 + p] = 1.f + mod_from_partials(a, F.ws, l, b, 1024 + i); tab[2048 + p] = mod_from_partials(a, F.ws, l, b, i); }
        else { tab[p] = GIN(a, I_N1G)[l * 1024 + i]; tab[1024 + p] = 1.f + mf[((size_t)l * 4 + b) * 6144 + 1024 + i]; tab[2048 + p] = mf[((size_t)l * 4 + b) * 6144 + i]; }
        if (MODE >= 1) tab[3072 + p] = mf[((size_t)((MODE == 2) ? DEPTH - 1 : l - 1) * 4 + b) * 6144 + 5 * 1024 + i];
    }
    __syncthreads();
    const float* xin32 = GIN(a, I_X);
    bf16_t* xb = (MODE == 2) ? xres(a, F.ws, DEPTH - 1) : xres(a, F.ws, l - 1);
    unsigned char* h1 = F.ws + WS_S(0);
    const unsigned char* oa = F.ws + WS_S(2);
    f32x4 xn[2][4]; u32x4 xq[2][2]; u32x2 pn0[2][2], pn1[2][2];
#define ROW_LOAD(S, rrow) do { _Pragma("unroll") for (int j = 0; j < 2; ++j) { \
            if (MODE == 0) { const f32x4* xr_ = (const f32x4*)(xin32 + (size_t)(rrow) * D) + 2 * F.lane + 128 * j; xn[S][2 * j] = xr_[0]; xn[S][2 * j + 1] = xr_[1]; } \
            else { xq[S][j] = *((const u32x4*)(xb + (size_t)(rrow) * D) + F.lane + 64 * j); pn0[S][j] = *((const u32x2*)(oa + (size_t)(2 * (rrow)) * D) + F.lane + 64 * j); pn1[S][j] = *((const u32x2*)(oa + (size_t)(2 * (rrow) + 1) * D) + F.lane + 64 * j); } } } while (0)
    ROW_LOAD(0, row0 + F.wave); ROW_LOAD(1, row0 + F.wave + NWAVES);
    auto body = [&](auto sl, int rr) __attribute__((always_inline)) {
        constexpr int S = decltype(sl)::value;
        const int row = row0 + rr;
        f32x4 v[4]; float ss = 0.f;
        if (MODE == 0) {
#pragma unroll
            for (int q = 0; q < 4; ++q) v[q] = xn[S][q];
        } else {
#pragma unroll
            for (int j = 0; j < 2; ++j) {
                const u32x4 xw = xq[S][j]; const u32x2 p0 = pn0[S][j], p1 = pn1[S][j];
                const f32x4 g0 = *(const LAS f32x4*)(tab + 3072 + (((j * 2 + 0) * 64 + F.lane) << 2)), g1 = *(const LAS f32x4*)(tab + 3072 + (((j * 2 + 1) * 64 + F.lane) << 2));
                const f32x2 a0 = __builtin_amdgcn_cvt_pk_f32_fp8(p0.x, false), a1 = __builtin_amdgcn_cvt_pk_f32_fp8(p0.x, true), a2 = __builtin_amdgcn_cvt_pk_f32_fp8(p0.y, false), a3 = __builtin_amdgcn_cvt_pk_f32_fp8(p0.y, true);
                const f32x2 b0 = __builtin_amdgcn_cvt_pk_f32_fp8(p1.x, false), b1 = __builtin_amdgcn_cvt_pk_f32_fp8(p1.x, true), b2 = __builtin_amdgcn_cvt_pk_f32_fp8(p1.y, false), b3 = __builtin_amdgcn_cvt_pk_f32_fp8(p1.y, true);
                v[2 * j].x = bf_lo(xw.x) + g0.x * (a0.x + b0.x); v[2 * j].y = bf_hi(xw.x) + g0.y * (a0.y + b0.y); v[2 * j].z = bf_lo(xw.y) + g0.z * (a1.x + b1.x); v[2 * j].w = bf_hi(xw.y) + g0.w * (a1.y + b1.y);
                v[2 * j + 1].x = bf_lo(xw.z) + g1.x * (a2.x + b2.x); v[2 * j + 1].y = bf_hi(xw.z) + g1.y * (a2.y + b2.y); v[2 * j + 1].z = bf_lo(xw.w) + g1.z * (a3.x + b3.x); v[2 * j + 1].w = bf_hi(xw.w) + g1.w * (a3.y + b3.y);
            }
        }
        if (rr + 2 * NWAVES < 128) ROW_LOAD(S, row + 2 * NWAVES);
#pragma unroll
        for (int q = 0; q < 4; ++q) ss += (v[q].x * v[q].x + v[q].y * v[q].y) + (v[q].z * v[q].z + v[q].w * v[q].w);
        const float rstd = rsqrtf(wave_sum(ss) * (1.f / D) + EPS);
#pragma unroll
        for (int j = 0; j < 2; ++j) {
            const f32x4 ga = *(const LAS f32x4*)(tab + (((j * 2 + 0) * 64 + F.lane) << 2)), gb = *(const LAS f32x4*)(tab + (((j * 2 + 1) * 64 + F.lane) << 2));
            const f32x4 va = v[2 * j], vb = v[2 * j + 1];
            if (MODE == 2) {
                f32x4 o0, o1; o0.x = va.x * rstd * ga.x; o0.y = va.y * rstd * ga.y; o0.z = va.z * rstd * ga.z; o0.w = va.w * rstd * ga.w; o1.x = vb.x * rstd * gb.x; o1.y = vb.y * rstd * gb.y; o1.z = vb.z * rstd * gb.z; o1.w = vb.w * rstd * gb.w;
                f32x4* op = (f32x4*)(GOUT(a) + (size_t)row * D) + 2 * F.lane + 128 * j; op[0] = o0; op[1] = o1;
            } else {
                if (MODE == 1) { u32x4 w; w.x = cvt_pk_bf16(va.x, va.y); w.y = cvt_pk_bf16(va.z, va.w); w.z = cvt_pk_bf16(vb.x, vb.y); w.w = cvt_pk_bf16(vb.z, vb.w); *((u32x4*)(xb + (size_t)row * D) + F.lane + 64 * j) = w; }
                const f32x4 sca = *(const LAS f32x4*)(tab + 1024 + (((j * 2 + 0) * 64 + F.lane) << 2)), scb = *(const LAS f32x4*)(tab + 1024 + (((j * 2 + 1) * 64 + F.lane) << 2));
                const f32x4 sha = *(const LAS f32x4*)(tab + 2048 + (((j * 2 + 0) * 64 + F.lane) << 2)), shb = *(const LAS f32x4*)(tab + 2048 + (((j * 2 + 1) * 64 + F.lane) << 2));
                u32x2 w8; w8.x = pk4_fp8(va.x * rstd * ga.x * sca.x + sha.x, va.y * rstd * ga.y * sca.y + sha.y, va.z * rstd * ga.z * sca.z + sha.z, va.w * rstd * ga.w * sca.w + sha.w);
                w8.y = pk4_fp8(vb.x * rstd * gb.x * scb.x + shb.x, vb.y * rstd * gb.y * scb.y + shb.y, vb.z * rstd * gb.z * scb.z + shb.z, vb.w * rstd * gb.w * scb.w + shb.w);
                *((u32x2*)(h1 + (size_t)row * D) + F.lane + 64 * j) = w8;
            }
        }
    };
    for (int rr = F.wave; rr < 128; rr += 2 * NWAVES) { body(IC<0>{}, rr); body(IC<1>{}, rr + NWAVES); }
#undef ROW_LOAD
}

__device__ __forceinline__ void row_phase_norm2_route(Frame& F, int l, bool do_append) {
    F.refresh();
    ArgP a = argp();
    LAS bf16_t* wtr16 = (LAS bf16_t*)(F.lds);
    LAS bf16_t* wtg16 = (LAS bf16_t*)(F.lds + 131072);
    LAS float* tab = (LAS float*)(F.lds + 147456);
    LAS float* cstW = (LAS float*)(F.lds + 155648);
    LAS float* cst = cstW + 8 * 48;
    LAS unsigned* cntL = (LAS unsigned*)(cst + 48);
    LAS unsigned* baseL = cntL + 32;
    LAS float* rstdL = (LAS float*)(baseL + 32);
    LAS unsigned* rsel = (LAS unsigned*)(rstdL + 128);
    LAS float* rw = (LAS float*)(rsel + 128);
    LAS float* lg = (LAS float*)(F.lds);
    const int row0 = F.bid * 128, b = row0 / SEQ;
    const float* modf = (const float*)(F.ws + WS_MODF) + ((size_t)l * 4 + b) * 6144;
    for (int i = F.tid; i < 1024; i += NTHREADS) { tab[i] = GIN(a, I_N2G)[l * 1024 + i] * (1.f + modf[4 * 1024 + i]); tab[1024 + i] = modf[3 * 1024 + i]; }
    if (F.tid < 32) cntL[F.tid] = 0u;
    __syncthreads();
    {
        float cj = 0.f, cg = 0.f;
        const float* wrt = GIN(a, I_WRT) + (size_t)l * 32768; const float* wgp = GIN(a, I_WGRP) + (size_t)l * 4096;
#pragma unroll 1
        for (int i0 = F.tid; i0 < 32 * 1024; i0 += NTHREADS * 16) {
            float wv[16];
#pragma unroll
            for (int q = 0; q < 16; ++q) wv[q] = wrt[i0 + NTHREADS * q];
#pragma unroll
            for (int q = 0; q < 16; ++q) { const int i = i0 + NTHREADS * q, k = i >> 5, j = i & 31; const float w = wv[q];
                cj += tab[1024 + k] * w;
                const float wp = w * tab[k]; const unsigned hb = cvt_pk_bf16(wp, 0.f) & 0xffffu, lb = cvt_pk_bf16(wp - __uint_as_float(hb << 16), 0.f) & 0xffffu;
                const int p = ((((((j >> 4) * 32 + (k >> 5)) * 2) * 4 + ((k >> 3) & 3)) * 16 + (j & 15)) << 3) + (k & 7);
                wtr16[p] = (bf16_t)hb; wtr16[p + 512] = (bf16_t)lb; }
        }
        { float wv[8];
#pragma unroll
          for (int q = 0; q < 8; ++q) wv[q] = wgp[F.tid + NTHREADS * q];
#pragma unroll
          for (int q = 0; q < 8; ++q) { const int i = F.tid + NTHREADS * q, k = i >> 2, j = i & 3; const float w = wv[q];
              cg += tab[1024 + k] * w;
              const float wp = w * tab[k]; const unsigned hb = cvt_pk_bf16(wp, 0.f) & 0xffffu, lb = cvt_pk_bf16(wp - __uint_as_float(hb << 16), 0.f) & 0xffffu;
              const int p = (((((k >> 5) * 2) * 4 + ((k >> 3) & 3)) * 4 + j) << 3) + (k & 7);
              wtg16[p] = (bf16_t)hb; wtg16[p + 128] = (bf16_t)lb; } }
        cj += __int_as_float(__builtin_amdgcn_ds_bpermute((F.lane ^ 32) << 2, __float_as_int(cj)));
#pragma unroll
        for (int o = 4; o < 64; o <<= 1) cg += __int_as_float(__builtin_amdgcn_ds_bpermute((F.lane ^ o) << 2, __float_as_int(cg)));
        if (F.lane < 32) cstW[F.wave * 48 + F.lane] = cj;
        if (F.lane < 4) cstW[F.wave * 48 + 32 + F.lane] = cg;
    }
    __syncthreads();
    if (F.tid < 36) {
        float s = (F.tid < 32) ? GIN(a, I_BRT)[l * 32 + F.tid] : GIN(a, I_BGRP)[l * 4 + F.tid - 32];
#pragma unroll
        for (int w = 0; w < 8; ++w) s += cstW[w * 48 + F.tid];
        cst[F.tid] = s;
    }
    f32x4 acc0 = {0.f, 0.f, 0.f, 0.f}, acc1 = acc0, acc2 = acc0; float ss = 0.f;
    {
        const bf16_t* xrow = xres(a, F.ws, l) + (size_t)(row0 + 16 * F.wave + (F.lane & 15)) * D + 8 * (F.lane >> 4);
        LAS const unsigned char* br0 = F.lds + (((F.lane >> 4) * 16 + (F.lane & 15)) << 4);
        LAS const unsigned char* bg0 = F.lds + 131072 + (((F.lane >> 4) * 4 + (F.lane & 3)) << 4);
        u32x4 xw[8];
#pragma unroll
        for (int s = 0; s < 8; ++s) xw[s] = *(const u32x4*)(xrow + 32 * s);
#pragma unroll 1
        for (int o = 0; o < 4; ++o) {
#pragma unroll
            for (int s = 0; s < 8; ++s) {
                const u32x4 cw = xw[s];
                if (o < 3) xw[s] = *(const u32x4*)(xrow + 32 * (8 * o + 8 + s));
                const f32x4 ca = {bf_lo(cw.x), bf_hi(cw.x), bf_lo(cw.y), bf_hi(cw.y)}, cb = {bf_lo(cw.z), bf_hi(cw.z), bf_lo(cw.w), bf_hi(cw.w)};
                const int step = 8 * o + s;
                const bf16x8 r0h = *(const LAS bf16x8*)(br0 + (step * 2 + 0) * 1024), r0l = *(const LAS bf16x8*)(br0 + (step * 2 + 1) * 1024);
                const bf16x8 r1h = *(const LAS bf16x8*)(br0 + ((32 + step) * 2 + 0) * 1024), r1l = *(const LAS bf16x8*)(br0 + ((32 + step) * 2 + 1) * 1024);
                const bf16x8 gh = *(const LAS bf16x8*)(bg0 + (step * 2 + 0) * 256), gl = *(const LAS bf16x8*)(bg0 + (step * 2 + 1) * 256);
                ss += (ca.x * ca.x + ca.y * ca.y) + (ca.z * ca.z + ca.w * ca.w) + (cb.x * cb.x + cb.y * cb.y) + (cb.z * cb.z + cb.w * cb.w);
                const bf16x8 av = *reinterpret_cast<const bf16x8*>(&cw);
                acc0 = __builtin_amdgcn_mfma_f32_16x16x32_bf16(av, r0h, acc0, 0, 0, 0); acc1 = __builtin_amdgcn_mfma_f32_16x16x32_bf16(av, r1h, acc1, 0, 0, 0); acc2 = __builtin_amdgcn_mfma_f32_16x16x32_bf16(av, gh, acc2, 0, 0, 0);
                acc0 = __builtin_amdgcn_mfma_f32_16x16x32_bf16(av, r0l, acc0, 0, 0, 0); acc1 = __builtin_amdgcn_mfma_f32_16x16x32_bf16(av, r1l, acc1, 0, 0, 0); acc2 = __builtin_amdgcn_mfma_f32_16x16x32_bf16(av, gl, acc2, 0, 0, 0);
            }
        }
    }
    ss += __int_as_float(__builtin_amdgcn_ds_bpermute((F.lane ^ 16) << 2, __float_as_int(ss)));
    ss += __int_as_float(__builtin_amdgcn_ds_bpermute((F.lane ^ 32) << 2, __float_as_int(ss)));
    const float rstd = rsqrtf(ss * (1.f / D) + EPS);
    __syncthreads();
    {
        LAS float* lr = lg + (16 * F.wave + 4 * (F.lane >> 4)) * 49 + (F.lane & 15);
        lr[0] = acc0.x; lr[49] = acc0.y; lr[98] = acc0.z; lr[147] = acc0.w;
        lr[16] = acc1.x; lr[16 + 49] = acc1.y; lr[16 + 98] = acc1.z; lr[16 + 147] = acc1.w;
        if ((F.lane & 15) < 4) { lr[32] = acc2.x; lr[32 + 49] = acc2.y; lr[32 + 98] = acc2.z; lr[32 + 147] = acc2.w; }
    }
    if (F.lane < 16) {
        const int r = 16 * F.wave + F.lane;
        LAS const float* lr = lg + r * 49;
        const float g0 = rstd * lr[32] + cst[32], g1 = rstd * lr[33] + cst[33], g2 = rstd * lr[34] + cst[34], g3 = rstd * lr[35] + cst[35];
        int grp = 0; float gm = g0; if (g1 > gm) { gm = g1; grp = 1; } if (g2 > gm) { gm = g2; grp = 2; } if (g3 > gm) { gm = g3; grp = 3; }
        const float pg = 1.f / (__expf(g0 - gm) + __expf(g1 - gm) + __expf(g2 - gm) + __expf(g3 - gm));
        float el[8];
#pragma unroll
        for (int e = 0; e < 8; ++e) el[e] = rstd * lr[grp * 8 + e] + cst[grp * 8 + e];
        int e1 = 0; float m1 = el[0];
#pragma unroll
        for (int e = 1; e < 8; ++e) if (el[e] > m1) { m1 = el[e]; e1 = e; }
        int e2 = -1; float m2 = -3.0e38f;
#pragma unroll
        for (int e = 0; e < 8; ++e) if (e != e1 && el[e] > m2) { m2 = el[e]; e2 = e; }
        const float p2 = __expf(m2 - m1), w1 = pg / (1.f + p2), w2 = pg * p2 / (1.f + p2);
        const unsigned ex1 = (unsigned)(grp * 8 + e1), ex2 = (unsigned)(grp * 8 + e2);
        const unsigned q1 = __hip_atomic_fetch_add(cntL + ex1, 1u, __ATOMIC_RELAXED, __HIP_MEMORY_SCOPE_WORKGROUP);
        const unsigned q2 = __hip_atomic_fetch_add(cntL + ex2, 1u, __ATOMIC_RELAXED, __HIP_MEMORY_SCOPE_WORKGROUP);
        rsel[r] = ex1 | (ex2 << 8) | (q1 << 16) | (q2 << 24); rw[r] = w1; rw[128 + r] = w2; rstdL[r] = rstd;
    }
    __syncthreads();
    unsigned* cnt = ((unsigned*)F.ws) + CW_CNT + l * 32 * 64;
    if (F.tid < 32 && do_append) { const unsigned n = cntL[F.tid]; baseL[F.tid] = n ? atomicAdd(&cnt[F.tid * 64], n) : 0u; }
    __syncthreads();
    if (F.tid < 256 && do_append) {
        unsigned* ldest = (unsigned*)(F.ws + WS_LDEST); float* lw = (float*)(F.ws + WS_LW);
        const int r = F.tid >> 1, k = F.tid & 1; const unsigned sel = rsel[r];
        const unsigned ex = (sel >> (8 * k)) & 0xffu, pos = baseL[ex] + ((sel >> (16 + 8 * k)) & 0xffu);
        ldest[(size_t)ex * T + pos] = (unsigned)(2 * (row0 + r) + k); lw[(size_t)ex * T + pos] = rw[128 * k + r];
    }
    unsigned char* h2 = F.ws + WS_S(0);
    const bf16_t* xb = xres(a, F.ws, l);
    u32x4 xn[2][2];
#pragma unroll
    for (int j = 0; j < 2; ++j) { xn[0][j] = *((const u32x4*)(xb + (size_t)(row0 + F.wave) * D) + F.lane + 64 * j); xn[1][j] = *((const u32x4*)(xb + (size_t)(row0 + F.wave + NWAVES) * D) + F.lane + 64 * j); }
    auto body = [&](auto sl, int rr) __attribute__((always_inline)) {
        constexpr int S = decltype(sl)::value;
        const int row = row0 + rr;
        u32x4 v[2];
#pragma unroll
        for (int j = 0; j < 2; ++j) v[j] = xn[S][j];
        if (rr + 2 * NWAVES < 128) {
#pragma unroll
            for (int j = 0; j < 2; ++j) xn[S][j] = *((const u32x4*)(xb + (size_t)(row + 2 * NWAVES) * D) + F.lane + 64 * j); }
        const float rs = rstdL[rr];
#pragma unroll
        for (int j = 0; j < 2; ++j) {
            const f32x4 ga = *(const LAS f32x4*)(tab + 8 * F.lane + 512 * j), gb = *(const LAS f32x4*)(tab + 8 * F.lane + 512 * j + 4), sa = *(const LAS f32x4*)(tab + 1024 + 8 * F.lane + 512 * j), sb = *(const LAS f32x4*)(tab + 1024 + 8 * F.lane + 512 * j + 4);
            u32x2 o; o.x = pk4_fp8(bf_lo(v[j].x) * rs * ga.x + sa.x, bf_hi(v[j].x) * rs * ga.y + sa.y, bf_lo(v[j].y) * rs * ga.z + sa.z, bf_hi(v[j].y) * rs * ga.w + sa.w);
            o.y = pk4_fp8(bf_lo(v[j].z) * rs * gb.x + sb.x, bf_hi(v[j].z) * rs * gb.y + sb.y, bf_lo(v[j].w) * rs * gb.z + sb.z, bf_hi(v[j].w) * rs * gb.w + sb.w);
            *((u32x2*)(h2 + (size_t)row * D) + F.lane + 64 * j) = o;
        }
    };
    for (int rr = F.wave; rr < 128; rr += 2 * NWAVES) { body(IC<0>{}, rr); body(IC<1>{}, rr + NWAVES); }
}

struct MoeOrder {
    static constexpr bool F8 = false; static constexpr int scaleA = 127, scaleB = 127;
    const char* A; const char* B; int G, c, K, lda, ldb, npn; const LAS int* pfx;
    const unsigned* ldest;
    __device__ __forceinline__ bool next(int i, pg8::Unit& u) const {
        const int L = i * G + ((c & 7) * (G >> 3) + (c >> 3));
        const int ntl = __builtin_amdgcn_readfirstlane(pfx[32]); if (L >= ntl * npn) return false;
        const int tile = L / npn; u.pn = L % npn; u.pm = tile;
        int e = 0;
#pragma unroll
        for (int j = 1; j < 32; ++j) e += (tile >= __builtin_amdgcn_readfirstlane(pfx[j])) ? 1 : 0;
        u.e = e; u.r0 = (tile - __builtin_amdgcn_readfirstlane(pfx[e])) * 256; const int n = __builtin_amdgcn_readfirstlane(pfx[33 + e]) - u.r0; u.nv = n < 256 ? n : 256; u.aux = 0; return true;
    }
};
struct MoeOrderUp : MoeOrder {
    static constexpr bool GATHER = true, F8 = true; static constexpr int scaleA = 127, scaleB = W8_E8M0;
    __device__ __forceinline__ const char* abase(const pg8::Unit&) const { return A; }
    __device__ __forceinline__ const char* bbase(const pg8::Unit& u) const { return B + ((size_t)u.e * 512 + (size_t)u.pn * 256) * 1024; }
    __device__ __forceinline__ unsigned arow(const pg8::Unit& u, int r) const { const int rr = r < u.nv ? r : 0; return ldest[(size_t)u.e * T + u.r0 + rr] >> 1; }
};
struct MoeOrderDn : MoeOrder {
    static constexpr bool GATHER = false, F8 = true; static constexpr int scaleA = 127 - 4, scaleB = W8_E8M0;
    __device__ __forceinline__ const char* abase(const pg8::Unit& u) const { return A + (size_t)u.pm * 256 * 256; }
    __device__ __forceinline__ const char* bbase(const pg8::Unit& u) const { return B + ((size_t)u.e * 1024 + (size_t)u.pn * 256) * 256; }
    __device__ __forceinline__ unsigned arow(const pg8::Unit&, int r) const { return (unsigned)r; }
};
struct EpiMoeUp {
    static constexpr bool PERM = true, STATE = false;
    bf16_t* act;
    __device__ __forceinline__ void operator()(const f32x4 (&acc)[2][2][4][2], const pg8::Unit& u, int wr, int wc, int fr, int fq) const {
#pragma unroll
        for (int ai = 0; ai < 2; ++ai)
#pragma unroll
            for (int m = 0; m < 4; ++m) {
                const int rl = ai * 128 + wr * 64 + m * 16 + fr;
                const f32x4 g0 = acc[ai][0][m][0], g1 = acc[ai][0][m][1], u0 = acc[ai][1][m][0] * 16.f, u1 = acc[ai][1][m][1] * 16.f;
                u32x2 w; w.x = pk4_fp8(siluf_(g0.x) * u0.x, siluf_(g0.y) * u0.y, siluf_(g0.z) * u0.z, siluf_(g0.w) * u0.w);
                w.y = pk4_fp8(siluf_(g1.x) * u1.x, siluf_(g1.y) * u1.y, siluf_(g1.z) * u1.z, siluf_(g1.w) * u1.w);
                *(u32x2*)((unsigned char*)act + ((size_t)u.pm * 256 + rl) * 256 + u.pn * 128 + wc * 32 + 8 * fq) = w;
            }
    }
};
struct EpiMoeDn {
    static constexpr bool PERM = true, STATE = false;
    bf16_t* oa; const unsigned* ldest; const float* lw;
    __device__ __forceinline__ void operator()(const f32x4 (&acc)[2][2][4][2], const pg8::Unit& u, int wr, int wc, int fr, int fq) const {
        unsigned dv[8]; float wv[8];
#pragma unroll
        for (int k = 0; k < 8; ++k) { const int rl = (k >> 2) * 128 + wr * 64 + (k & 3) * 16 + fr; const int rc = rl < u.nv ? rl : 0; dv[k] = ldest[(size_t)u.e * T + u.r0 + rc]; wv[k] = lw[(size_t)u.e * T + u.r0 + rc]; }
#pragma unroll
        for (int ai = 0; ai < 2; ++ai)
#pragma unroll
            for (int m = 0; m < 4; ++m) {
                const int rl = ai * 128 + wr * 64 + m * 16 + fr;
                if (rl < u.nv) {
                    const unsigned dest = dv[ai * 4 + m]; const float w = wv[ai * 4 + m];
#pragma unroll
                    for (int bj = 0; bj < 2; ++bj) {
                        const f32x4 v0 = acc[ai][bj][m][0] * w, v1 = acc[ai][bj][m][1] * w;
                        u32x2 o; o.x = pk4_fp8(v0.x, v0.y, v0.z, v0.w); o.y = pk4_fp8(v1.x, v1.y, v1.z, v1.w);
                        *(u32x2*)((unsigned char*)oa + (size_t)dest * 1024 + u.pn * 256 + bj * 128 + wc * 32 + 8 * fq) = o;
                    }
                }
            }
    }
};
__device__ __forceinline__ void moe_prefix(Frame& F, int l) {
    F.refresh();
    LAS int* pfx = (LAS int*)(F.lds + LDSCTL_OFF + 64);
    if (F.wave == 0) {
        const int e = F.lane & 31;
        const int c = (int)__hip_atomic_load(((unsigned*)F.ws) + CW_CNT + (l * 32 + e) * 64, __ATOMIC_RELAXED, __HIP_MEMORY_SCOPE_AGENT);
        int incl = (F.lane < 32) ? ((c + 255) >> 8) : 0; const int mine = incl;
#pragma unroll
        for (int o = 1; o < 32; o <<= 1) { const int t = __builtin_amdgcn_ds_bpermute((F.lane - o) << 2, incl); if (F.lane >= o) incl += t; }
        if (F.lane < 32) { pfx[e] = incl - mine; pfx[33 + e] = c; if (F.lane == 31) pfx[32] = incl; }
    }
    __syncthreads();
}


template <bool ST, class V> __device__ __forceinline__ void st_or_keep(V* p, const V& w) { if (ST) *p = w; else asm volatile("" :: "v"(w)); }
template <bool ST>
struct EpiInProjT {
    static constexpr bool PERM = true, STATE = false;
    unsigned char* ws; const float* rope;
    __device__ __forceinline__ void operator()(const f32x4 (&acc)[2][2][4][2], const pg8::Unit& u, int wr, int wc, int fr, int fq) const {
        const unsigned r0 = (unsigned)(wr * 64 + fr);
        const size_t rowu = (size_t)u.pm * 256;
#pragma unroll
        for (int bj = 0; bj < 2; ++bj) {
            const int colw = u.pn * 256 + bj * 128 + wc * 32;
            if (colw < 2048) {
                unsigned char* base = ws + (colw < 1024 ? WS_S(1) : WS_S(2)) + (rowu * 1024 + (size_t)(colw & 1023)) * 2;
                const unsigned lo = (r0 * 1024u + 8u * fq) * 2u;
#pragma unroll
                for (int ai = 0; ai < 2; ++ai)
#pragma unroll
                    for (int m = 0; m < 4; ++m) { const f32x4 v0 = acc[ai][bj][m][0], v1 = acc[ai][bj][m][1];
                        u32x4 w; w.x = cvt_pk_bf16(v0.x, v0.y); w.y = cvt_pk_bf16(v0.z, v0.w); w.z = cvt_pk_bf16(v1.x, v1.y); w.w = cvt_pk_bf16(v1.z, v1.w);
                        st_or_keep<ST>((u32x4*)(base + (lo + (unsigned)(ai * 128 + m * 16) * 2048u)), w); }
            } else if (colw < 3072) {
                unsigned char* base = ws + WS_S(3) + (rowu * 1024 + (size_t)(colw - 2048)) * 2;
                const unsigned lo = (r0 * 1024u + 8u * fq) * 2u;
#pragma unroll
                for (int ai = 0; ai < 2; ++ai)
#pragma unroll
                    for (int m = 0; m < 4; ++m) { const f32x4 v0 = acc[ai][bj][m][0], v1 = acc[ai][bj][m][1];
                        u32x4 w; w.x = cvt_pk_bf16(sigmoidf_(v0.x), sigmoidf_(v0.y)); w.y = cvt_pk_bf16(sigmoidf_(v0.z), sigmoidf_(v0.w)); w.z = cvt_pk_bf16(sigmoidf_(v1.x), sigmoidf_(v1.y)); w.w = cvt_pk_bf16(sigmoidf_(v1.z), sigmoidf_(v1.w));
                        st_or_keep<ST>((u32x4*)(base + (lo + (unsigned)(ai * 128 + m * 16) * 2048u)), w); }
            } else if (colw >= 3456 && colw < 3712) {
                unsigned char* base = ws + WS_CKV + rowu * 256 + (size_t)(colw - 3456);
                const unsigned lo = r0 * 256u + 8u * fq;
#pragma unroll
                for (int ai = 0; ai < 2; ++ai)
#pragma unroll
                    for (int m = 0; m < 4; ++m) { const f32x4 v0 = acc[ai][bj][m][0], v1 = acc[ai][bj][m][1];
                        u32x2 w; w.x = pk4_fp8(v0.x, v0.y, v0.z, v0.w); w.y = pk4_fp8(v1.x, v1.y, v1.z, v1.w);
                        st_or_keep<ST>((u32x2*)(base + (lo + (unsigned)(ai * 128 + m * 16) * 256u)), w); }
            } else if (colw < 3456) {
                const bool isq = true; const unsigned pitch = 768u;
                unsigned char* base = ws + WS_CQ + rowu * pitch + (size_t)(colw - 3072) * 2;
                const unsigned lo = r0 * pitch + 16u * fq;
#pragma unroll
                for (int ai = 0; ai < 2; ++ai)
#pragma unroll
                    for (int m = 0; m < 4; ++m) { const f32x4 v0 = acc[ai][bj][m][0], v1 = acc[ai][bj][m][1];
                        u32x4 w; w.x = cvt_pk_bf16(v0.x, v0.y); w.y = cvt_pk_bf16(v0.z, v0.w); w.z = cvt_pk_bf16(v1.x, v1.y); w.w = cvt_pk_bf16(v1.z, v1.w);
                        st_or_keep<ST>((u32x4*)(base + (lo + (unsigned)(ai * 128 + m * 16) * pitch)), w); }
            } else if (colw < 3776) {
                const int c = colw - 3712 + 8 * fq;
#pragma unroll
                for (int ai = 0; ai < 2; ++ai) {
                    f32x4 csv[4], snv[4];
#pragma unroll
                    for (int m = 0; m < 4; ++m) { const int pos = (u.pm * 256 + ai * 128 + m * 16 + (int)r0) & (SEQ - 1); csv[m] = *(const f32x4*)(rope + pos * 32 + (c >> 1)); snv[m] = *(const f32x4*)(rope + 8192 * 32 + pos * 32 + (c >> 1)); }
#pragma unroll
                    for (int m = 0; m < 4; ++m) { const f32x4 v0 = acc[ai][bj][m][0], v1 = acc[ai][bj][m][1];
                        const int row = u.pm * 256 + ai * 128 + m * 16 + (int)r0;
                        const f32x4 cs = csv[m], sn = snv[m];
                        u32x2 w; w.x = pk4_fp8(v0.x * cs.x - v0.y * sn.x, v0.x * sn.x + v0.y * cs.x, v0.z * cs.y - v0.w * sn.y, v0.z * sn.y + v0.w * cs.y);
                        w.y = pk4_fp8(v1.x * cs.z - v1.y * sn.z, v1.x * sn.z + v1.y * cs.z, v1.z * cs.w - v1.w * sn.w, v1.z * sn.w + v1.w * cs.w);
                        st_or_keep<ST>((u32x2*)(ws + WS_KR + (size_t)row * 64 + c), w); }
                }
            } else if (colw == 3776) {
                if (fq == 0) {
#pragma unroll
                    for (int ai = 0; ai < 2; ++ai)
#pragma unroll
                        for (int m = 0; m < 4; ++m) { const int row = u.pm * 256 + ai * 128 + m * 16 + (int)r0; float* ifg = (float*)(ws + WS_IFG) + (size_t)row * 8;
                            st_or_keep<ST>((f32x4*)ifg, acc[ai][bj][m][0]); st_or_keep<ST>((f32x4*)(ifg + 4), acc[ai][bj][m][1]); }
                }
            }
        }
    }
};
using EpiInProj = EpiInProjT<true>;
struct EpiNull { static constexpr bool PERM = true, STATE = false;
    __device__ __forceinline__ void operator()(const f32x4 (&acc)[2][2][4][2], const pg8::Unit& u, int wr, int wc, int fr, int fq) const {
#pragma unroll
        for (int ai = 0; ai < 2; ++ai)
#pragma unroll
            for (int bj = 0; bj < 2; ++bj)
#pragma unroll
                for (int m = 0; m < 4; ++m)
#pragma unroll
                    for (int n = 0; n < 2; ++n) asm volatile("" :: "v"(acc[ai][bj][m][n])); } };
struct EpiUq {
    static constexpr bool PERM = true, STATE = false;
    unsigned char* ws; const float* rope;
    __device__ __forceinline__ void operator()(const f32x4 (&acc)[2][2][4][2], const pg8::Unit& u, int wr, int wc, int fr, int fq) const {
        unsigned char* qn = ws + WS_S(1); unsigned char* qr = ws + WS_S(2); const float* rstd = (const float*)(ws + WS_RSTD);
        float rsv[8];
#pragma unroll
        for (int k = 0; k < 8; ++k) rsv[k] = rstd[u.pm * 256 + (k >> 2) * 128 + wr * 64 + (k & 3) * 16 + fr];
        if (u.pn < 4) {
            EPI8_LOOP({
                const float rs = rsv[ai * 4 + m];
                u32x2 w; w.x = pk4_fp8(v0.x * rs, v0.y * rs, v0.z * rs, v0.w * rs); w.y = pk4_fp8(v1.x * rs, v1.y * rs, v1.z * rs, v1.w * rs);
                *(u32x2*)(qn + (size_t)row * 1024 + col) = w;
            })
        } else {
#pragma unroll
            for (int ai = 0; ai < 2; ++ai) {
                f32x4 csv[4][2], snv[4][2];
#pragma unroll
                for (int m = 0; m < 4; ++m)
#pragma unroll
                    for (int bj = 0; bj < 2; ++bj) { const int row = u.pm * 256 + ai * 128 + wr * 64 + m * 16 + fr, p = (bj * 128 + wc * 32 + 8 * fq) & 63, pos = row & (SEQ - 1);
                        csv[m][bj] = *(const f32x4*)(rope + pos * 32 + (p >> 1)); snv[m][bj] = *(const f32x4*)(rope + 8192 * 32 + pos * 32 + (p >> 1)); }
#pragma unroll
                for (int m = 0; m < 4; ++m)
#pragma unroll
                    for (int bj = 0; bj < 2; ++bj) { const int row = u.pm * 256 + ai * 128 + wr * 64 + m * 16 + fr, c = (u.pn - 4) * 256 + bj * 128 + wc * 32 + 8 * fq; const float rs = rsv[ai * 4 + m];
                        const f32x4 v0 = acc[ai][bj][m][0], v1 = acc[ai][bj][m][1], cs = csv[m][bj] * rs, sn = snv[m][bj] * rs;
                        u32x2 w; w.x = pk4_fp8(v0.x * cs.x - v0.y * sn.x, v0.x * sn.x + v0.y * cs.x, v0.z * cs.y - v0.w * sn.y, v0.z * sn.y + v0.w * cs.y);
                        w.y = pk4_fp8(v1.x * cs.z - v1.y * sn.z, v1.x * sn.z + v1.y * cs.z, v1.z * cs.w - v1.w * sn.w, v1.z * sn.w + v1.w * cs.w);
                        *(u32x2*)(qr + (size_t)row * 512 + c) = w; }
            }
        }
    }
};
struct EpiUkv {
    static constexpr bool PERM = true, STATE = false;
    unsigned char* ws;
    __device__ __forceinline__ void operator()(const f32x4 (&acc)[2][2][4][2], const pg8::Unit& u, int wr, int wc, int fr, int fq) const {
        unsigned char* kn = ws + WS_S(4); unsigned char* va = ws + WS_S(5); const float* rstd = (const float*)(ws + WS_RSTD) + T;
        float rsv[8];
#pragma unroll
        for (int k = 0; k < 8; ++k) rsv[k] = rstd[u.pm * 256 + (k >> 2) * 128 + wr * 64 + (k & 3) * 16 + fr];
        EPI8_LOOP({
            const float rs = rsv[ai * 4 + m];
            if (col < 1024) { u32x2 w; w.x = pk4_fp8(v0.x * rs, v0.y * rs, v0.z * rs, v0.w * rs); w.y = pk4_fp8(v1.x * rs, v1.y * rs, v1.z * rs, v1.w * rs); *(u32x2*)(kn + (size_t)row * 1024 + col) = w; }
            else { u32x2 w; w.x = pk4_fp8(v0.x * rs, v0.y * rs, v0.z * rs, v0.w * rs); w.y = pk4_fp8(v1.x * rs, v1.y * rs, v1.z * rs, v1.w * rs); *(u32x2*)(va + (size_t)row * 1024 + (col - 1024)) = w; }
        })
    }
};
__device__ __forceinline__ void row_phase_stats(Frame& F) {
    F.refresh();
    const bf16_t* cq = (const bf16_t*)(F.ws + WS_CQ); const unsigned char* ckv = F.ws + WS_CKV; float* rstd = (float*)(F.ws + WS_RSTD);
    const int row0 = F.bid * 128;
#pragma unroll 1
    for (int hb = 0; hb < 2; ++hb) {
        unsigned wq[8][3]; unsigned wk2[8];
#pragma unroll
        for (int i = 0; i < 8; ++i) { const int row = row0 + F.wave + NWAVES * (hb * 8 + i); const unsigned* p = (const unsigned*)(cq + (size_t)row * 384) + F.lane;
#pragma unroll
            for (int j = 0; j < 3; ++j) wq[i][j] = p[64 * j];
            wk2[i] = *((const unsigned*)(ckv + (size_t)row * 256) + F.lane); }
#pragma unroll
        for (int i = 0; i < 8; ++i) { const int row = row0 + F.wave + NWAVES * (hb * 8 + i);
            float s = 0.f;
#pragma unroll
            for (int j = 0; j < 3; ++j) { const float a = bf_lo(wq[i][j]), b = bf_hi(wq[i][j]); s += a * a + b * b; }
            const f32x2 k0 = __builtin_amdgcn_cvt_pk_f32_fp8(wk2[i], false), k1 = __builtin_amdgcn_cvt_pk_f32_fp8(wk2[i], true);
            float s2 = (k0.x * k0.x + k0.y * k0.y) + (k1.x * k1.x + k1.y * k1.y);
            s = wave_sum(s); s2 = wave_sum(s2);
            if (F.lane == 0) { rstd[row] = rsqrtf(s * (1.f / 384.f) + EPS); rstd[T + row] = rsqrtf(s2 * (1.f / 256.f) + EPS); } }
    }
}
struct MergeOrder {
    static constexpr bool GATHER = false, F8 = true; static constexpr int scaleA = 127, scaleB = W8_E8M0;
    const unsigned char* ws; int G, c, K, lda, ldb, pass0;
    __device__ __forceinline__ bool next(int i, pg8::Unit& u) const { const int npass = 4 - pass0, j = i / npass, L = j * G + c; if (L >= 512) return false; pg8::tile_of(L, 128, 4, u.pm, u.pn); u.aux = pass0 + i % npass; return true; }
    __device__ __forceinline__ const char* abase(const pg8::Unit& u) const { const size_t off = (u.aux == 1) ? WS_S(0) + 32 * MiB : (u.aux == 3) ? WS_S(3) : WS_S(0); return (const char*)ws + off + (size_t)u.pm * 256 * 1024; }
    __device__ __forceinline__ const char* bbase(const pg8::Unit& u) const { const size_t off = (u.aux == 0) ? W_GM : (u.aux == 1) ? W_M : (u.aux == 2) ? W_GA : W_A; return (const char*)ws + WS_W + off + (size_t)u.pn * 256 * 1024; }
    __device__ __forceinline__ unsigned arow(const pg8::Unit&, int r) const { return (unsigned)r; }
};
struct EpiMerge {
    static constexpr bool PERM = true, STATE = true;
    unsigned char* ws; int has_t;
    __device__ __forceinline__ void operator()(const f32x4 (&acc)[2][2][4][2], const pg8::Unit& u, int wr, int wc, int fr, int fq, unsigned (&st)[32]) const {
        bf16_t* t2 = (bf16_t*)(ws + WS_S(2));
        const int pass = u.aux;
#pragma unroll
        for (int ah = 0; ah < 4; ++ah) { const int ai = ah >> 1;
            u32x4 tv[4][2];
            if (pass == 3 && has_t) {
#pragma unroll
                for (int m = 2 * (ah & 1); m < 2 * (ah & 1) + 2; ++m)
#pragma unroll
                    for (int bj = 0; bj < 2; ++bj) tv[m][bj] = *(const u32x4*)(t2 + (size_t)(u.pm * 256 + ai * 128 + wr * 64 + m * 16 + fr) * 1024 + u.pn * 256 + bj * 128 + wc * 32 + 8 * fq);
            }
#pragma unroll
            for (int m = 2 * (ah & 1); m < 2 * (ah & 1) + 2; ++m) { asm volatile("" ::: "memory"); const int row = u.pm * 256 + ai * 128 + wr * 64 + m * 16 + fr;
#pragma unroll
                for (int bj = 0; bj < 2; ++bj) { const int col = u.pn * 256 + bj * 128 + wc * 32 + 8 * fq; const size_t o = (size_t)row * 1024 + col; const int si = ((ai * 4 + m) * 2 + bj) * 2;
                    f32x4 a0 = acc[ai][bj][m][0], a1 = acc[ai][bj][m][1];
                    if (pass == 0 || pass == 2) {
                        st[si] = pk4_fp8(sigmoidf_(a0.x), sigmoidf_(a0.y), sigmoidf_(a0.z), sigmoidf_(a0.w)); st[si + 1] = pk4_fp8(sigmoidf_(a1.x), sigmoidf_(a1.y), sigmoidf_(a1.z), sigmoidf_(a1.w));
                    } else {
                        const f32x2 g0 = __builtin_amdgcn_cvt_pk_f32_fp8(st[si], false), g1 = __builtin_amdgcn_cvt_pk_f32_fp8(st[si], true), g2 = __builtin_amdgcn_cvt_pk_f32_fp8(st[si + 1], false), g3 = __builtin_amdgcn_cvt_pk_f32_fp8(st[si + 1], true);
                        a0.x *= g0.x; a0.y *= g0.y; a0.z *= g1.x; a0.w *= g1.y; a1.x *= g2.x; a1.y *= g2.y; a1.z *= g3.x; a1.w *= g3.y;
                        if (pass == 1) { u32x4 w; w.x = cvt_pk_bf16(a0.x, a0.y); w.y = cvt_pk_bf16(a0.z, a0.w); w.z = cvt_pk_bf16(a1.x, a1.y); w.w = cvt_pk_bf16(a1.z, a1.w); *(u32x4*)(t2 + o) = w; }
                        else { if (has_t) { const u32x4 tt = tv[m][bj];
                                a0.x += bf_lo(tt.x); a0.y += bf_hi(tt.x); a0.z += bf_lo(tt.y); a0.w += bf_hi(tt.y); a1.x += bf_lo(tt.z); a1.y += bf_hi(tt.z); a1.z += bf_lo(tt.w); a1.w += bf_hi(tt.w); }
                            u32x2 w8; w8.x = pk4_fp8(a0.x, a0.y, a0.z, a0.w); w8.y = pk4_fp8(a1.x, a1.y, a1.z, a1.w); *(u32x2*)(ws + WS_S(5) + o) = w8; }
                    }
                } }
        }
    }
};
struct EpiOut {
    static constexpr bool PERM = true, STATE = false;
    const float* xin32; const bf16_t* xin16; bf16_t* xo; const float* gate; bool do_store;
    __device__ __forceinline__ void operator()(const f32x4 (&acc)[2][2][4][2], const pg8::Unit& u, int wr, int wc, int fr, int fq) const {
        const float* g = gate + (size_t)((u.pm * 256) / SEQ) * 6144;
        f32x4 gv[2][2];
#pragma unroll
        for (int bj = 0; bj < 2; ++bj) { const int col = u.pn * 256 + bj * 128 + wc * 32 + 8 * fq; gv[bj][0] = *(const f32x4*)(g + col); gv[bj][1] = *(const f32x4*)(g + col + 4); }
#pragma unroll
        for (int ai = 0; ai < 2; ++ai) {
            asm volatile("" ::: "memory");
            if (xin32) {
#pragma unroll
                for (int mp = 0; mp < 2; ++mp) {
                    f32x4 xr[2][2][2];
#pragma unroll
                    for (int mm = 0; mm < 2; ++mm)
#pragma unroll
                        for (int bj = 0; bj < 2; ++bj) { const int row = u.pm * 256 + ai * 128 + wr * 64 + (mp * 2 + mm) * 16 + fr, col = u.pn * 256 + bj * 128 + wc * 32 + 8 * fq; const size_t o = (size_t)row * 1024 + col;
                            xr[mm][bj][0] = *(const f32x4*)(xin32 + o); xr[mm][bj][1] = *(const f32x4*)(xin32 + o + 4); }
#pragma unroll
                    for (int mm = 0; mm < 2; ++mm)
#pragma unroll
                        for (int bj = 0; bj < 2; ++bj) { const int m = mp * 2 + mm; const int row = u.pm * 256 + ai * 128 + wr * 64 + m * 16 + fr, col = u.pn * 256 + bj * 128 + wc * 32 + 8 * fq; const size_t o = (size_t)row * 1024 + col;
                            const f32x4 x0 = xr[mm][bj][0] + gv[bj][0] * acc[ai][bj][m][0], x1 = xr[mm][bj][1] + gv[bj][1] * acc[ai][bj][m][1];
                            u32x4 w; w.x = cvt_pk_bf16(x0.x, x0.y); w.y = cvt_pk_bf16(x0.z, x0.w); w.z = cvt_pk_bf16(x1.x, x1.y); w.w = cvt_pk_bf16(x1.z, x1.w);
                            if (do_store) *(u32x4*)(xo + o) = w; else asm volatile("" :: "v"(w)); }
                    asm volatile("" ::: "memory");
                }
            } else {
                u32x4 xr[4][2];
#pragma unroll
                for (int m = 0; m < 4; ++m)
#pragma unroll
                    for (int bj = 0; bj < 2; ++bj) { const int row = u.pm * 256 + ai * 128 + wr * 64 + m * 16 + fr, col = u.pn * 256 + bj * 128 + wc * 32 + 8 * fq; xr[m][bj] = *(const u32x4*)(xin16 + (size_t)row * 1024 + col); }
#pragma unroll
                for (int m = 0; m < 4; ++m)
#pragma unroll
                    for (int bj = 0; bj < 2; ++bj) { const int row = u.pm * 256 + ai * 128 + wr * 64 + m * 16 + fr, col = u.pn * 256 + bj * 128 + wc * 32 + 8 * fq; const size_t o = (size_t)row * 1024 + col; const u32x4 t = xr[m][bj];
                        f32x4 x0 = {bf_lo(t.x), bf_hi(t.x), bf_lo(t.y), bf_hi(t.y)}, x1 = {bf_lo(t.z), bf_hi(t.z), bf_lo(t.w), bf_hi(t.w)};
                        x0 = x0 + gv[bj][0] * acc[ai][bj][m][0]; x1 = x1 + gv[bj][1] * acc[ai][bj][m][1];
                        u32x4 w; w.x = cvt_pk_bf16(x0.x, x0.y); w.y = cvt_pk_bf16(x0.z, x0.w); w.z = cvt_pk_bf16(x1.x, x1.y); w.w = cvt_pk_bf16(x1.z, x1.w);
                        if (do_store) *(u32x4*)(xo + o) = w; else asm volatile("" :: "v"(w)); }
            }
        }
    }
};


namespace att {
constexpr int KVBLK = 64;
constexpr float SCALE = 0.07216878364870322f;
constexpr float THR = 2.5f;
constexpr int P8_E8M0 = 127 - 5;
constexpr int SHM_V = 64 * 128, SHM_K = 64 * 192, OFF_K = 3 * SHM_V, OFF_WS = OFF_K + 3 * SHM_K;
static_assert(OFF_WS + 2048 <= 90112, "attention LDS layout");
#define KSWZ(row, colB) ((row) * 384 + ((colB) ^ (((row) & 7) << 4)))
#define SBAR() __builtin_amdgcn_sched_barrier(0)
__device__ __forceinline__ int crow(int r, int hi) { return (r & 3) + 8 * (r >> 2) + 4 * hi; }
__device__ __forceinline__ void partialSM(f32x16& p0, f32x16& p1, float& m_reg, float& mn, float& alpha, bool vis) {
  constexpr float C = SCALE * 1.4426950408889634f;
  float pmax = p0[0];
#pragma unroll
  for (int r = 1; r < 16; ++r) pmax = fmaxf(pmax, p0[r]);
#pragma unroll
  for (int r = 0; r < 16; ++r) pmax = fmaxf(pmax, p1[r]);
  { auto rr = __builtin_amdgcn_permlane32_swap(__float_as_uint(pmax), __float_as_uint(pmax), false, false);
    pmax = fmaxf(__uint_as_float(rr[0]), __uint_as_float(rr[1])); }
  pmax = vis ? pmax : -1e30f;
  if (__builtin_expect(__all(pmax - m_reg <= THR / SCALE), 1)) { mn = m_reg; alpha = 1.f; }
  else { mn = fmaxf(m_reg, pmax); alpha = __builtin_amdgcn_exp2f((m_reg - mn) * C); m_reg = mn; }
  const float mnC = vis ? 5.f - mn * C : -1e30f;
#pragma unroll
  for (int r = 0; r < 16; ++r) p0[r] = fmaf(p0[r], C, mnC);
#pragma unroll
  for (int r = 0; r < 16; ++r) p1[r] = fmaf(p1[r], C, mnC);
#pragma unroll
  for (int r = 0; r < 16; ++r) p0[r] = __builtin_amdgcn_exp2f(p0[r]);
}
__device__ __forceinline__ void finishSM(f32x16& p0, f32x16& p1, float alpha, float& l_reg, i32x8& P8) {
#pragma unroll
  for (int r = 0; r < 16; ++r) p1[r] = __builtin_amdgcn_exp2f(p1[r]);
  float ps = 0;
#pragma unroll
  for (int r = 0; r < 16; ++r) ps += p0[r];
#pragma unroll
  for (int r = 0; r < 16; ++r) ps += p1[r];
  { auto rr = __builtin_amdgcn_permlane32_swap(__float_as_uint(ps), __float_as_uint(ps), false, false);
    ps = __uint_as_float(rr[0]) + __uint_as_float(rr[1]); }
  l_reg = l_reg * alpha + ps * 0.03125f;
#pragma unroll
  for (int w = 0; w < 4; ++w) { P8[w] = (int)pk4_fp8(p0[4 * w], p0[4 * w + 1], p0[4 * w + 2], p0[4 * w + 3]); P8[4 + w] = (int)pk4_fp8(p1[4 * w], p1[4 * w + 1], p1[4 * w + 2], p1[4 * w + 3]); }
}
__device__ __forceinline__ void qkt(f32x16& p0, f32x16& p1, const char* Ks, const i32x8* qf, int kb0, int kb1) {
#pragma unroll
  for (int r = 0; r < 16; ++r) { p0[r] = 0.f; p1[r] = 0.f; }
#pragma unroll
  for (int st = 0; st < 3; ++st) {
    const u32x4 a0 = *reinterpret_cast<const u32x4*>(Ks + kb0 + st * 64), a1 = *reinterpret_cast<const u32x4*>(Ks + kb1 + st * 64);
    const u32x4 b0 = *reinterpret_cast<const u32x4*>(Ks + 6144 + kb0 + st * 64), b1 = *reinterpret_cast<const u32x4*>(Ks + 6144 + kb1 + st * 64);
    const i32x8 ka = {(int)a0.x, (int)a0.y, (int)a0.z, (int)a0.w, (int)a1.x, (int)a1.y, (int)a1.z, (int)a1.w}, kb = {(int)b0.x, (int)b0.y, (int)b0.z, (int)b0.w, (int)b1.x, (int)b1.y, (int)b1.z, (int)b1.w};
    p0 = __builtin_amdgcn_mfma_scale_f32_32x32x64_f8f6f4(ka, qf[st], p0, 0, 0, 0, 127, 0, 127);
    p1 = __builtin_amdgcn_mfma_scale_f32_32x32x64_f8f6f4(kb, qf[st], p1, 0, 0, 0, 127, 0, 127); }
}
__device__ __forceinline__ int v_st(int k, int c) { const int kk = (k & ~0xC) | ((k & 4) << 1) | ((k & 8) >> 1); return ((kk >> 3) * 4 + (c >> 5)) * 512 + ((kk & 7) * 32 + (c & 31)) * 2; }
__device__ __forceinline__ int v_rd_base(int lane) { return ((lane & 3) << 3) | (((lane >> 2) & 3) << 6) | (((lane >> 4) & 1) << 5) | (((lane >> 5) & 1) << 8); }
constexpr int v_rd_off(int d0, int ks, int half) { return d0 * 512 + ks * 4096 + half * 2048; }
template <int OFF> __device__ __forceinline__ s16x4 tr_read(int vb) {
  s16x4 r; asm volatile("ds_read_b64_tr_b16 %0, %1 offset:%2" : "=&v"(r) : "v"(vb), "i"(OFF) : "memory"); return r;
}
template <int D0> __device__ __forceinline__ void pv_one(f32x16& od, int vb, bf16x8 pa0, bf16x8 pa1, bf16x8 pa2, bf16x8 pa3) {
  const s16x4 l0 = tr_read<v_rd_off(D0, 0, 0)>(vb), h0 = tr_read<v_rd_off(D0, 0, 1)>(vb), l1 = tr_read<v_rd_off(D0, 1, 0)>(vb), h1 = tr_read<v_rd_off(D0, 1, 1)>(vb);
  const s16x4 l2 = tr_read<v_rd_off(D0, 2, 0)>(vb), h2 = tr_read<v_rd_off(D0, 2, 1)>(vb), l3 = tr_read<v_rd_off(D0, 3, 0)>(vb), h3 = tr_read<v_rd_off(D0, 3, 1)>(vb);
  asm volatile("s_waitcnt lgkmcnt(0)" ::: "memory"); SBAR();
#define PK(L, H) (bf16x8){L[0], L[1], L[2], L[3], H[0], H[1], H[2], H[3]}
  od = __builtin_amdgcn_mfma_f32_32x32x16_bf16(pa0, PK(l0, h0), od, 0, 0, 0);
  od = __builtin_amdgcn_mfma_f32_32x32x16_bf16(pa1, PK(l1, h1), od, 0, 0, 0);
  od = __builtin_amdgcn_mfma_f32_32x32x16_bf16(pa2, PK(l2, h2), od, 0, 0, 0);
  od = __builtin_amdgcn_mfma_f32_32x32x16_bf16(pa3, PK(l3, h3), od, 0, 0, 0);
#undef PK
}
template <int OFF> __device__ __forceinline__ u32x2 tr8_read(int vb) {
  u32x2 r; asm volatile("ds_read_b64_tr_b8 %0, %1 offset:%2" : "=&v"(r) : "v"(vb), "i"(OFF) : "memory"); return r;
}
__device__ __forceinline__ void pv8_one(f32x16& od, int vb, const i32x8& P8) {
  const u32x2 r0 = tr8_read<0>(vb), r1 = tr8_read<2048>(vb), r2 = tr8_read<4096>(vb), r3 = tr8_read<6144>(vb);
  asm volatile("s_waitcnt lgkmcnt(0)" ::: "memory"); SBAR();
  const i32x8 vf = {(int)r0.x, (int)r0.y, (int)r1.x, (int)r1.y, (int)r2.x, (int)r2.y, (int)r3.x, (int)r3.y};
  od = __builtin_amdgcn_mfma_scale_f32_32x32x64_f8f6f4(P8, vf, od, 0, 0, 0, P8_E8M0, 0, 127);
}
__device__ __forceinline__ void pv8(f32x16* o, const int (&vbd)[4], int soff, const i32x8& P8) {
  u32x2 r[4][4];
#pragma unroll
  for (int d = 0; d < 4; ++d) { const int vb = vbd[d] + soff; r[d][0] = tr8_read<0>(vb); r[d][1] = tr8_read<2048>(vb); r[d][2] = tr8_read<4096>(vb); r[d][3] = tr8_read<6144>(vb); }
  asm volatile("s_waitcnt lgkmcnt(0)" ::: "memory"); SBAR();
#pragma unroll
  for (int d = 0; d < 4; ++d) { const i32x8 vf = {(int)r[d][0].x, (int)r[d][0].y, (int)r[d][1].x, (int)r[d][1].y, (int)r[d][2].x, (int)r[d][2].y, (int)r[d][3].x, (int)r[d][3].y};
    o[d] = __builtin_amdgcn_mfma_scale_f32_32x32x64_f8f6f4(P8, vf, o[d], 0, 0, 0, P8_E8M0, 0, 127); }
}
__device__ __forceinline__ void pv_d0(f32x16* o, int vb, bf16x8 pa0, bf16x8 pa1, bf16x8 pa2, bf16x8 pa3) {
  pv_one<0>(o[0], vb, pa0, pa1, pa2, pa3); pv_one<1>(o[1], vb, pa0, pa1, pa2, pa3); pv_one<2>(o[2], vb, pa0, pa1, pa2, pa3); pv_one<3>(o[3], vb, pa0, pa1, pa2, pa3);
}
__device__ __forceinline__ void attn_unit(const unsigned char* __restrict__ Qn, const unsigned char* __restrict__ Qr, const unsigned char* __restrict__ Kn, const unsigned char* __restrict__ Kr, const unsigned char* __restrict__ Vv,
                                          unsigned char* __restrict__ Ob, int qb, char* lds, bool do_store, int wave0) {
  const int tid = tid_opaque(wave0), wid = wave0, lane = tid & 63, r32 = lane & 31, hi = lane >> 5;
  char* V_lds = lds; char* K_lds = lds + OFF_K;
  float* wsf = (float*)(lds + OFF_WS) + wid * 64; float* li_l = wsf; float* al_l = wsf + 32;
  float m_reg = -1e30f, l_reg = 0; f32x16 o[4]; i32x8 qf[3];
#pragma unroll
  for (int d = 0; d < 4; ++d)
#pragma unroll
    for (int r = 0; r < 16; ++r) o[d][r] = 0.f;
  { const unsigned char* Qw = Qn + (size_t)(wid * 32 + r32) * 1024 + hi * 32; const unsigned char* Qw2 = Qr + (size_t)(wid * 32 + r32) * 512 + hi * 32;
#pragma unroll
    for (int st = 0; st < 3; ++st) { const unsigned char* p = (st < 2) ? Qw + st * 64 : Qw2; const u32x4 x0 = *reinterpret_cast<const u32x4*>(p), x1 = *reinterpret_cast<const u32x4*>(p + 16);
      qf[st] = (i32x8){(int)x0.x, (int)x0.y, (int)x0.z, (int)x0.w, (int)x1.x, (int)x1.y, (int)x1.z, (int)x1.w}; } }
  const int NT = 4 * qb + 4, myq = 4 * qb + (wid >> 1);
  const int krow = tid >> 3, kc = tid & 7, ksw = (krow >> 2) & 3;
  const int vst0 = krow * 128 + ((kc ^ (2 * (((krow >> 1) & 1) | (((krow >> 3) & 1) << 1)))) << 4);
  const int kst0 = krow * 192 + ((kc ^ ksw) * 16), kst2 = krow * 192 + ((8 + ((kc & 3) ^ ksw)) * 16);
  int vbd[4];
  { const int g = lane >> 4, ll = lane & 15, jj = ll >> 1, cc = ll & 1, kr_l = 4 * (g >> 1) + (jj < 4 ? jj : jj + 4), fl = ((kr_l >> 1) & 1) | (((kr_l >> 3) & 1) << 1);
#pragma unroll
    for (int d = 0; d < 4; ++d) vbd[d] = (int)(uintptr_t)V_lds + kr_l * 128 + ((2 * (d ^ fl) + (g & 1)) << 4) + 8 * cc; }
  const int qsw = (r32 >> 2) & 3, kb0 = r32 * 192 + (((2 * hi) ^ qsw) * 16), kb1 = r32 * 192 + (((2 * hi + 1) ^ qsw) * 16);
  u32x4 vs0, ks0, ks2;
  const unsigned voV = (unsigned)(krow * 1024 + kc * 16), voK = (unsigned)(krow * 1024 + kc * 16), voR = (unsigned)(krow * 64 + (kc & 3) * 16);
#define SLOAD(k0) do { const char* vb_ = (const char*)(Vv + (size_t)(k0) * 1024); const char* kb_ = (const char*)(Kn + (size_t)(k0) * 1024); const char* rb_ = (const char*)(Kr + (size_t)(k0) * 64); \
    vs0 = *reinterpret_cast<const u32x4*>(vb_ + voV); \
    ks0 = *reinterpret_cast<const u32x4*>(kb_ + voK); ks2 = *reinterpret_cast<const u32x4*>(rb_ + voR); } while (0)
#define SWRITE(b) do { *(u32x4*)(V_lds + (b) * SHM_V + vst0) = vs0; \
    *(u32x4*)(K_lds + (b) * SHM_K + kst0) = ks0; if (kc < 4) *(u32x4*)(K_lds + (b) * SHM_K + kst2) = ks2; } while (0)
#define RESC(a) do { if (__any((a) < 1.f)) { if (hi == 0) al_l[r32] = (a); asm volatile("s_waitcnt lgkmcnt(0)" ::: "memory"); \
    _Pragma("unroll") for (int d = 0; d < 4; ++d) _Pragma("unroll") for (int r = 0; r < 16; ++r) o[d][r] *= al_l[crow(r, hi)]; } } while (0)
  f32x16 pA0, pA1, pB0, pB1; float mnA, mnB, alA, alB; i32x8 P8;
  const int lastk = (NT - 1) * KVBLK;
#define TILE_K0(t) (((t) < NT ? (t) : NT - 1) * KVBLK)
  SLOAD(0); SWRITE(0); SLOAD(KVBLK); __syncthreads();
  qkt(pA0, pA1, K_lds, qf, kb0, kb1); partialSM(pA0, pA1, m_reg, mnA, alA, true);
  SWRITE(1); SLOAD(TILE_K0(2)); __syncthreads();
  int b0 = 0, b1 = 1, b2 = 2;
  for (int j = 1; j + 1 < NT; j += 2) {
    SBAR(); qkt(pB0, pB1, K_lds + b1 * SHM_K, qf, kb0, kb1);
    finishSM(pA0, pA1, alA, l_reg, P8); SBAR();
    pv8(o, vbd, b0 * SHM_V, P8);
    partialSM(pB0, pB1, m_reg, mnB, alB, j <= myq);
    SWRITE(b2); SLOAD(TILE_K0(j + 2));
    RESC(alB); __syncthreads();
    SBAR(); qkt(pA0, pA1, K_lds + b2 * SHM_K, qf, kb0, kb1);
    finishSM(pB0, pB1, alB, l_reg, P8); SBAR();
    pv8(o, vbd, b1 * SHM_V, P8);
    partialSM(pA0, pA1, m_reg, mnA, alA, j + 1 <= myq);
    SWRITE(b0); SLOAD(TILE_K0(j + 3));
    RESC(alA); __syncthreads();
    { const int t0 = b0; b0 = b2; b2 = b1; b1 = t0; }
  }
  (void)lastk;
  SBAR(); qkt(pB0, pB1, K_lds + b1 * SHM_K, qf, kb0, kb1);
  finishSM(pA0, pA1, alA, l_reg, P8); SBAR();
  pv8(o, vbd, b0 * SHM_V, P8);
  partialSM(pB0, pB1, m_reg, mnB, alB, NT - 1 <= myq);
  RESC(alB);
  finishSM(pB0, pB1, alB, l_reg, P8); SBAR();
  pv8(o, vbd, b1 * SHM_V, P8);
#undef TILE_K0
  if (hi == 0) li_l[r32] = l_reg; asm volatile("s_waitcnt lgkmcnt(0)" ::: "memory");
  { char* Os = lds + 90112 + wid * 4096;
#pragma unroll
    for (int r = 0; r < 16; ++r) { const int orow = crow(r, hi); const float rl = __builtin_amdgcn_rcpf(li_l[orow]);
#pragma unroll
      for (int d0 = 0; d0 < 4; ++d0) { const float x = o[d0][r] * rl; *(unsigned char*)(Os + orow * 128 + d0 * 32 + r32) = (unsigned char)(__builtin_amdgcn_cvt_pk_fp8_f32(x, x, 0, false) & 0xff); } }
    asm volatile("s_waitcnt lgkmcnt(0)" ::: "memory");
    unsigned char* Ow = Ob + (size_t)(wid * 32) * 1024;
#pragma unroll
    for (int k = 0; k < 4; ++k) { const int ch = lane + 64 * k, row = ch >> 3, c16 = ch & 7; const u32x4 v = *(const u32x4*)(Os + row * 128 + c16 * 16);
      if (do_store) *(u32x4*)(Ow + (size_t)row * 1024 + c16 * 16) = v; else asm volatile("" :: "v"(v)); } }
  __syncthreads();
#undef SLOAD
#undef SWRITE
#undef SWAIT
#undef RESC
}
}
constexpr int NBH = 16, NCH = 128;
__device__ __forceinline__ float wave_incl_sum(float v, int lane) {
#pragma unroll
    for (int o = 1; o < 64; o <<= 1) { const float t = __int_as_float(__builtin_amdgcn_ds_bpermute((lane - o) << 2, __float_as_int(v))); if (lane >= o) v += t; }
    return v;
}
__device__ __forceinline__ float wave_incl_max(float v, int lane) {
#pragma unroll
    for (int o = 1; o < 64; o <<= 1) { const float t = __int_as_float(__builtin_amdgcn_ds_bpermute((lane - o) << 2, __float_as_int(v))); if (lane >= o) v = fmaxf(v, t); }
    return v;
}
__device__ __forceinline__ void conv_table(LAS float* cwl, const float* cw, const float* cb, int tid) {
    float t[10];
#pragma unroll
    for (int q = 0; q < 8; ++q) t[q] = cw[tid + NTHREADS * q];
#pragma unroll
    for (int q = 0; q < 2; ++q) t[8 + q] = cb[tid + NTHREADS * q];
#pragma unroll
    for (int q = 0; q < 8; ++q) cwl[tid + NTHREADS * q] = t[q];
#pragma unroll
    for (int q = 0; q < 2; ++q) cwl[4096 + tid + NTHREADS * q] = t[8 + q];
}
__device__ __forceinline__ void conv8(const u32x4 (&x)[4], int s_abs, const LAS float* cwl, int ch, float scale, float (&out)[8]) {
    float acc[8];
    { const f32x4 b0 = *(const LAS f32x4*)(cwl + 4096 + ch), b1 = *(const LAS f32x4*)(cwl + 4096 + ch + 4); acc[0] = b0.x; acc[1] = b0.y; acc[2] = b0.z; acc[3] = b0.w; acc[4] = b1.x; acc[5] = b1.y; acc[6] = b1.z; acc[7] = b1.w; }
#pragma unroll
    for (int j = 0; j < 4; ++j) {
        const float m = (s_abs - 3 + j >= 0) ? 1.f : 0.f;
        const f32x4 w0 = *(const LAS f32x4*)(cwl + j * 1024 + ch) * m, w1 = *(const LAS f32x4*)(cwl + j * 1024 + ch + 4) * m;
        acc[0] += w0.x * bf_lo(x[j].x); acc[1] += w0.y * bf_hi(x[j].x); acc[2] += w0.z * bf_lo(x[j].y); acc[3] += w0.w * bf_hi(x[j].y);
        acc[4] += w1.x * bf_lo(x[j].z); acc[5] += w1.y * bf_hi(x[j].z); acc[6] += w1.z * bf_lo(x[j].w); acc[7] += w1.w * bf_hi(x[j].w);
    }
#pragma unroll
    for (int i = 0; i < 8; ++i) out[i] = siluf_(acc[i]) * scale;
}
__device__ __forceinline__ void conv_load(const bf16_t* raw, int s_abs, u32x4 (&x)[4]) {
#pragma unroll
    for (int j = 0; j < 4; ++j) x[j] = *(const u32x4*)(raw + (ptrdiff_t)((s_abs - 3 + j >= 0) ? (j - 3) : 0) * 1024);
}
#define KSW256(row, colB) ((row) * 256 + ((colB) ^ (((row) & 7) << 4)))
#define CSW256(row, colB) ((row) * 256 + ((colB) ^ (((row) & 15) << 4)))
__device__ __forceinline__ void attn_phase(Frame& F, bool do_store) {
    const unsigned char* qn = F.ws + WS_S(1); const unsigned char* qr = F.ws + WS_S(2); const unsigned char* kn = F.ws + WS_S(4); const unsigned char* va = F.ws + WS_S(5);
    const unsigned char* kr = F.ws + WS_KR;
    const int vcu = (F.G % 8 == 0) ? (F.bid % 8) * (F.G / 8) + F.bid / 8 : F.bid;
    for (int it = 0; it < 4; ++it) {
        const int P = vcu + (it >> 1) * F.G; if (P >= 512) break;
        const int bh = P >> 4, i = P & 15, qb = (it & 1) ? i : 31 - i, b = bh >> 3, h = bh & 7;
        const size_t row0 = (size_t)b * SEQ + (size_t)qb * 256, key0 = (size_t)b * SEQ;
        att::attn_unit(qn + row0 * 1024 + h * 128, qr + row0 * 512 + h * 64, kn + key0 * 1024 + h * 128, kr + key0 * 64, va + key0 * 1024 + h * 128, F.ws + WS_S(3) + row0 * 1024 + h * 128, qb, (char*)F.lds, do_store, F.wave);
    }
}


constexpr int NGRP = 16, GCH = 8;
__device__ __forceinline__ void mlstm_gates_local(Frame& F, int l) {
    F.refresh();
    ArgP a = argp();
    const float* ifg = (const float*)(F.ws + WS_IFG); float* GT = (float*)(F.ws + WS_GATE); float* CH = (float*)(F.ws + WS_CHK);
    for (int gw = F.bid * NWAVES + F.wave; gw < NBH * NCH; gw += F.G * NWAVES) {
        const int bh = gw >> 7, c = gw & 127, b = bh >> 2, h = bh & 3, s = c * 64 + F.lane; const size_t t = (size_t)b * SEQ + s;
        const float li = ifg[t * 8 + h] + GIN(a, I_IGB)[l * 4 + h], x = ifg[t * 8 + 4 + h] + GIN(a, I_FGB)[l * 4 + h];
        const float lf = fminf(x, 0.f) - log1pf(__expf(-fabsf(x)));
        const float bc = wave_incl_sum(lf, F.lane), ct = li - bc, pm = wave_incl_max(ct, F.lane);
        GT[(size_t)bh * SEQ + s] = bc; GT[(size_t)(NBH + bh) * SEQ + s] = ct; GT[(size_t)(2 * NBH + bh) * SEQ + s] = pm;
        if (F.lane == 63) { CH[bh * NCH + c] = bc; CH[2048 + bh * NCH + c] = bc + pm; }
    }
}
__device__ __forceinline__ void mlstm_mtab(LAS float* mt, const float* CH, int bh, int tid) {
    if (tid < 64) {
        const int lane = tid;
        const float a0 = CH[bh * NCH + 2 * lane], b0 = CH[2048 + bh * NCH + 2 * lane], a1 = CH[bh * NCH + 2 * lane + 1], b1 = CH[2048 + bh * NCH + 2 * lane + 1];
        float A = a0 + a1, B = fmaxf(b0 + a1, b1);
#pragma unroll
        for (int o = 1; o < 64; o <<= 1) {
            const float Ap = __int_as_float(__builtin_amdgcn_ds_bpermute((lane - o) << 2, __float_as_int(A))), Bp = __int_as_float(__builtin_amdgcn_ds_bpermute((lane - o) << 2, __float_as_int(B)));
            if (lane >= o) { B = fmaxf(Bp + A, B); A = Ap + A; }
        }
        const float Ae = __int_as_float(__builtin_amdgcn_ds_bpermute((lane - 1) << 2, __float_as_int(A))), Be = __int_as_float(__builtin_amdgcn_ds_bpermute((lane - 1) << 2, __float_as_int(B)));
        const float m0 = (lane == 0) ? 0.f : fmaxf(Ae, Be), m1 = fmaxf(a0 + m0, b0), m2 = fmaxf(a1 + m1, b1);
        mt[2 * lane] = m0; mt[128 + 2 * lane] = m1; mt[256 + 2 * lane] = __expf(a0 + m0 - m1);
        mt[2 * lane + 1] = m1; mt[128 + 2 * lane + 1] = m2; mt[256 + 2 * lane + 1] = __expf(a1 + m1 - m2);
    }
}
#define PK8(L, H) (bf16x8){L[0], L[1], L[2], L[3], H[0], H[1], H[2], H[3]}
__device__ __forceinline__ void mlstm_group_state(Frame& F, int l) {
    F.refresh();
    ArgP a = argp();
    char* lds = (char*)F.lds; char* Vimg = lds; char* KWimg = lds + 32768; char* Ut = lds + 49152;
    LAS float* gx = (LAS float*)(F.lds + LDSX_OFF); LAS float* mt = gx + 704; LAS float* cwl = (LAS float*)(F.lds + LDSX_OFF + 4608); LAS float* npart = (LAS float*)(F.lds + LDSX_OFF + 25088);
    const bf16_t* qk = (const bf16_t*)(F.ws + WS_S(1)); const bf16_t* vm = (const bf16_t*)(F.ws + WS_S(2)); bf16_t* Gs = (bf16_t*)(F.ws + WS_S(4));
    const float* GT = (const float*)(F.ws + WS_GATE); const float* CH = (const float*)(F.ws + WS_CHK); float* Dg = (float*)(F.ws + WS_CHK + 16384); float* gn = (float*)(F.ws + WS_CHK + 32768);
    const int tid = F.tid, lane = F.lane, wid = F.wave, r32 = lane & 31, hi = lane >> 5;
    bf16_t* kcv = (bf16_t*)GOUT(a) + (size_t)T * 1024;
    conv_table(cwl, GIN(a, I_CONVW) + (size_t)l * 4096, GIN(a, I_CONVB) + (size_t)l * 1024, tid);
    for (int u = F.bid; u < NBH * NGRP; u += F.G) {
        const int bh = u >> 4, g = u & 15, b = bh >> 2, h = bh & 3;
        bf16x8 xv[4]; u32x4 xk[2][4]; float gch, gct;
#define GA_LOADS(cidx) do { const int sr_ = tid >> 4, sc_ = (tid & 15) * 8, srow_ = tid >> 3; const size_t tk_ = (size_t)b * SEQ + (size_t)(cidx) * 64; \
            _Pragma("unroll") for (int img = 0; img < 2; ++img) _Pragma("unroll") for (int hf = 0; hf < 2; ++hf) xv[img * 2 + hf] = *(const bf16x8*)(vm + (tk_ + sr_ + 32 * hf) * 1024 + h * 256 + img * 128 + sc_); \
            _Pragma("unroll") for (int hf = 0; hf < 2; ++hf) conv_load(qk + (tk_ + srow_) * 1024 + 512 + h * 128 + (tid & 7) * 8 + 64 * hf, (cidx) * 64 + srow_, xk[hf]); \
            gch = CH[bh * NCH + (cidx)]; gct = GT[(size_t)(NBH + bh) * SEQ + (cidx) * 64 + srow_]; } while (0)
        GA_LOADS(g * GCH);
        __syncthreads();
        mlstm_mtab(mt, CH, bh, tid);
        __syncthreads();
        f32x16 acc[4]; float nacc = 0.f, dprod = 1.f;
#pragma unroll
        for (int j = 0; j < 4; ++j)
#pragma unroll
            for (int r = 0; r < 16; ++r) acc[j][r] = 0.f;
#pragma unroll 1
        for (int cc = 0; cc < GCH; ++cc) {
            const int c = g * GCH + cc;
            { const int sr = tid >> 4, sc = (tid & 15) * 8, srow = tid >> 3;
              const float wk = __expf(gch + gct - mt[128 + c]);
#pragma unroll
              for (int img = 0; img < 2; ++img)
#pragma unroll
                for (int hf = 0; hf < 2; ++hf) *(bf16x8*)(Vimg + img * 16384 + att::v_st(sr + 32 * hf, sc)) = xv[img * 2 + hf];
#pragma unroll
              for (int hf = 0; hf < 2; ++hf) { const int d = (tid & 7) * 8 + 64 * hf; float o[8];
                conv8(xk[hf], c * 64 + srow, cwl, 512 + h * 128 + d, 1.f, o);
                u32x4 w; w.x = cvt_pk_bf16(o[0], o[1]); w.y = cvt_pk_bf16(o[2], o[3]); w.z = cvt_pk_bf16(o[4], o[5]); w.w = cvt_pk_bf16(o[6], o[7]);
                *(u32x4*)(kcv + ((size_t)b * SEQ + (size_t)c * 64 + srow) * 512 + h * 128 + d) = w;
                w.x = cvt_pk_bf16(o[0] * wk, o[1] * wk); w.y = cvt_pk_bf16(o[2] * wk, o[3] * wk); w.z = cvt_pk_bf16(o[4] * wk, o[5] * wk); w.w = cvt_pk_bf16(o[6] * wk, o[7] * wk);
                *(u32x4*)(KWimg + att::v_st(srow, d)) = w; } }
            __syncthreads();
            { const int cn = (cc + 1 < GCH) ? c + 1 : c; GA_LOADS(cn); }
            const float dec = mt[256 + c];
#pragma unroll
            for (int j = 0; j < 4; ++j)
#pragma unroll
                for (int r = 0; r < 16; ++r) acc[j][r] *= dec;
            { const int vbV = (int)(uintptr_t)(Vimg + (wid >> 2) * 16384) + att::v_rd_base(lane) + (wid & 3) * 512, vbK = (int)(uintptr_t)KWimg + att::v_rd_base(lane);
#define GASTEP(KS) do { \
                const s16x4 al = att::tr_read<att::v_rd_off(0, KS, 0)>(vbV), ah = att::tr_read<att::v_rd_off(0, KS, 1)>(vbV); \
                const s16x4 l0 = att::tr_read<att::v_rd_off(0, KS, 0)>(vbK), h0 = att::tr_read<att::v_rd_off(0, KS, 1)>(vbK), l1 = att::tr_read<att::v_rd_off(1, KS, 0)>(vbK), h1 = att::tr_read<att::v_rd_off(1, KS, 1)>(vbK); \
                const s16x4 l2 = att::tr_read<att::v_rd_off(2, KS, 0)>(vbK), h2 = att::tr_read<att::v_rd_off(2, KS, 1)>(vbK), l3 = att::tr_read<att::v_rd_off(3, KS, 0)>(vbK), h3 = att::tr_read<att::v_rd_off(3, KS, 1)>(vbK); \
                asm volatile("s_waitcnt lgkmcnt(0)" ::: "memory"); SBAR(); \
                const bf16x8 af = PK8(al, ah); \
                acc[0] = __builtin_amdgcn_mfma_f32_32x32x16_bf16(af, PK8(l0, h0), acc[0], 0, 0, 0); acc[1] = __builtin_amdgcn_mfma_f32_32x32x16_bf16(af, PK8(l1, h1), acc[1], 0, 0, 0); \
                acc[2] = __builtin_amdgcn_mfma_f32_32x32x16_bf16(af, PK8(l2, h2), acc[2], 0, 0, 0); acc[3] = __builtin_amdgcn_mfma_f32_32x32x16_bf16(af, PK8(l3, h3), acc[3], 0, 0, 0); } while (0)
              GASTEP(0); GASTEP(1); GASTEP(2); GASTEP(3);
#undef GASTEP
            }
            { float sacc = 0.f; const int dq = tid & 127, kq = (tid >> 7) * 16;
#pragma unroll
              for (int k = 0; k < 16; ++k) sacc += bf1(*(const bf16_t*)(KWimg + att::v_st(kq + k, dq & ~7) + (dq & 7) * 2));
              npart[tid] = sacc; }
            dprod *= dec;
            __syncthreads();
            if (tid < 128) nacc = dec * nacc + ((npart[tid] + npart[128 + tid]) + (npart[256 + tid] + npart[384 + tid]));
        }
#pragma unroll
        for (int j = 0; j < 4; ++j)
#pragma unroll
            for (int r = 0; r < 16; ++r) *(bf16_t*)(Ut + (wid * 32 + att::crow(r, hi)) * 272 + (j * 32 + r32) * 2) = (bf16_t)(cvt_pk_bf16(acc[j][r], 0.f) & 0xffffu);
        if (tid < 128) gn[(size_t)(bh * NGRP + g) * 128 + tid] = nacc;
        if (tid == 0) Dg[bh * NGRP + g] = dprod;
        __syncthreads();
        { bf16_t* Go = Gs + (size_t)(bh * NGRP + g) * 32768;
#pragma unroll
          for (int k = 0; k < 8; ++k) { const int p = tid + 512 * k, row = p >> 4, ck = p & 15; *(u32x4*)(Go + (size_t)row * 128 + ck * 8) = *(const u32x4*)(Ut + row * 272 + ck * 16); } }
    }
}
__device__ __forceinline__ void mlstm_group_scan(Frame& F) {
    F.refresh();
    const float* Dg = (const float*)(F.ws + WS_CHK + 16384);
    for (int gid = F.bid * NTHREADS + F.tid; gid < NBH * 8192; gid += F.G * NTHREADS) {
        const int bh = gid >> 13, e4 = gid & 8191;
        bf16_t* Gs = (bf16_t*)(F.ws + WS_S(4)) + (size_t)bh * NGRP * 32768 + (size_t)e4 * 4;
        u32x2 uu[NGRP];
#pragma unroll
        for (int k = 0; k < NGRP; ++k) uu[k] = *(const u32x2*)(Gs + (size_t)k * 32768);
        float c0 = 0.f, c1 = 0.f, c2 = 0.f, c3 = 0.f; asm volatile("" : "+v"(c0), "+v"(c1), "+v"(c2), "+v"(c3));
#pragma unroll
        for (int k = 0; k < NGRP; ++k) { const float d = Dg[bh * NGRP + k];
            u32x2 o; o.x = cvt_pk_bf16(c0, c1); o.y = cvt_pk_bf16(c2, c3); *(u32x2*)(Gs + (size_t)k * 32768) = o;
            c0 = d * c0 + bf_lo(uu[k].x); c1 = d * c1 + bf_hi(uu[k].x); c2 = d * c2 + bf_lo(uu[k].y); c3 = d * c3 + bf_hi(uu[k].y); }
    }
    { const int gid = F.bid * NTHREADS + F.tid;
      if (gid < NBH * 128) { const int b2 = gid >> 7, d = gid & 127; float* gn = (float*)(F.ws + WS_CHK + 32768) + (size_t)b2 * NGRP * 128 + d;
        float n = 0.f; for (int k = 0; k < NGRP; ++k) { const float uv = gn[k * 128]; gn[k * 128] = n; n = Dg[b2 * NGRP + k] * n + uv; } } }
}
__device__ __forceinline__ void mlstm_group_output(Frame& F, int l) {
    F.refresh();
    ArgP a = argp();
    char* lds = (char*)F.lds; char* Qs = lds; char* Ks = lds + 16384; char* Vimg = lds + 32768; char* Cs = lds + 65536; char* Yt = lds;
    LAS float* gx = (LAS float*)(F.lds + LDSX_OFF);
    LAS float* mt = gx + 704; LAS float* cwl = (LAS float*)(F.lds + LDSX_OFF + 4608); LAS float* npart = (LAS float*)(F.lds + LDSX_OFF + 25088);
    const bf16_t* qk = (const bf16_t*)(F.ws + WS_S(1)); const bf16_t* vm = (const bf16_t*)(F.ws + WS_S(2)); const bf16_t* Gs = (const bf16_t*)(F.ws + WS_S(4)); const bf16_t* so = (const bf16_t*)(F.ws + WS_S(3)); unsigned char* ym8 = F.ws + WS_S(0) + 32 * MiB;
    const float* GT = (const float*)(F.ws + WS_GATE); const float* CH = (const float*)(F.ws + WS_CHK); const float* gn = (const float*)(F.ws + WS_CHK + 32768);
    const int tid0 = F.tid, wid = F.wave;
    const bf16_t* kcv = (const bf16_t*)GOUT(a) + (size_t)T * 1024;
    conv_table(cwl, GIN(a, I_CONVW) + (size_t)l * 4096, GIN(a, I_CONVB) + (size_t)l * 1024, tid0);
    for (int u = F.bid; u < NBH * NGRP; u += F.G) {
        const int bh = u >> 4, g = u & 15, b = bh >> 2, h = bh & 3;
        bf16x8 xv[4]; u32x4 xq[2][4], xk[2]; float gbc, gct, gpm, gch;
#define GB_LOAD_G(cidx) do { int tid_ = tid0; asm volatile("" : "+v"(tid_)); const int t64_ = tid_ & 63; gbc = GT[(size_t)bh * SEQ + (cidx) * 64 + t64_]; gct = GT[(size_t)(NBH + bh) * SEQ + (cidx) * 64 + t64_]; \
            gpm = GT[(size_t)(2 * NBH + bh) * SEQ + (cidx) * 64 + t64_]; gch = CH[bh * NCH + (cidx)]; } while (0)
#define GB_LOAD_V(cidx) do { int tid_ = tid0; asm volatile("" : "+v"(tid_)); const int sr_ = tid_ >> 4, sc_ = (tid_ & 15) * 8; const size_t tk_ = (size_t)b * SEQ + (size_t)(cidx) * 64; \
            _Pragma("unroll") for (int img = 0; img < 2; ++img) _Pragma("unroll") for (int hf = 0; hf < 2; ++hf) xv[img * 2 + hf] = *(const bf16x8*)(vm + (tk_ + sr_ + 32 * hf) * 1024 + h * 256 + img * 128 + sc_); } while (0)
#define GB_LOAD_QK(cidx, dst, off, hf) do { int tid_ = tid0; asm volatile("" : "+v"(tid_)); const int srow_ = tid_ >> 3; const size_t tk_ = (size_t)b * SEQ + (size_t)(cidx) * 64; \
            conv_load(qk + (tk_ + srow_) * 1024 + (off) + h * 128 + (tid_ & 7) * 8 + 64 * (hf), (cidx) * 64 + srow_, dst[hf]); } while (0)
#define GB_LOAD_K(cidx) do { int tid_ = tid0; asm volatile("" : "+v"(tid_)); const int srow_ = tid_ >> 3; const bf16_t* kp_ = kcv + ((size_t)b * SEQ + (size_t)(cidx) * 64 + srow_) * 512 + h * 128 + (tid_ & 7) * 8; \
            xk[0] = *(const u32x4*)kp_; xk[1] = *(const u32x4*)(kp_ + 64); } while (0)
#define GB_LOADS(cidx) do { GB_LOAD_G(cidx); GB_LOAD_V(cidx); GB_LOAD_QK(cidx, xq, 0, 0); GB_LOAD_QK(cidx, xq, 0, 1); GB_LOAD_K(cidx); } while (0)
        GB_LOADS(g * GCH);
        __syncthreads();
        { const int tid = tid0; const bf16_t* Gc = Gs + (size_t)(bh * NGRP + g) * 32768;
          u32x4 cv[8];
#pragma unroll
          for (int k = 0; k < 8; ++k) { const int p = tid + 512 * k; cv[k] = *(const u32x4*)(Gc + (size_t)(p >> 4) * 128 + (p & 15) * 8); }
          mlstm_mtab(mt, CH, bh, tid0);
#pragma unroll
          for (int k = 0; k < 8; ++k) { const int p = tid + 512 * k; *(u32x4*)(Cs + CSW256(p >> 4, (p & 15) * 16)) = cv[k]; }
          if (tid < 128) gx[256 + tid] = gn[(size_t)(bh * NGRP + g) * 128 + tid]; }
#pragma unroll 1
        for (int cc = 0; cc < GCH; ++cc) {
            const int c = g * GCH + cc; const size_t tok0 = (size_t)b * SEQ + c * 64;
            __syncthreads();
            { int tid = tid0; asm volatile("" : "+v"(tid));
              const int sr = tid >> 4, sc = (tid & 15) * 8, srow = tid >> 3;
              if (tid < 64) { const float bc = gbc, ct = gct, pm = gpm;
                  const float mc = mt[c], mm = fmaxf(pm, mc);
                  gx[tid] = ct; gx[64 + tid] = -mm; gx[128 + tid] = __expf(mc - mm); gx[192 + tid] = __expf(-(bc + mm)); gx[640 + tid] = __expf(gch + ct - mt[128 + c]); }
#pragma unroll
              for (int img = 0; img < 2; ++img)
#pragma unroll
                for (int hf = 0; hf < 2; ++hf) *(bf16x8*)(Vimg + img * 16384 + att::v_st(sr + 32 * hf, sc)) = xv[img * 2 + hf];
#pragma unroll
              for (int hf = 0; hf < 2; ++hf) { const int d = (tid & 7) * 8 + 64 * hf; float o[8]; u32x4 w;
                conv8(xq[hf], c * 64 + srow, cwl, h * 128 + d, 0.08838834764831845f, o);
                w.x = cvt_pk_bf16(o[0], o[1]); w.y = cvt_pk_bf16(o[2], o[3]); w.z = cvt_pk_bf16(o[4], o[5]); w.w = cvt_pk_bf16(o[6], o[7]); *(u32x4*)(Qs + KSW256(srow, d * 2)) = w;
                *(u32x4*)(Ks + KSW256(srow, d * 2)) = xk[hf]; } }
            __syncthreads();
            const float dec = mt[256 + c];
            float yv[2][16]; f32x16 ua[4];
            {
                int tid = tid0; asm volatile("" : "+v"(tid)); const int lane = tid & 63, r32 = lane & 31, hi = lane >> 5;
                const int rb = wid & 1, vq = wid >> 1, t = 32 * rb + r32;
                bf16x8 qr[8];
#pragma unroll
                for (int d0 = 0; d0 < 8; ++d0) qr[d0] = *(const bf16x8*)(Qs + KSW256(t, (d0 * 16 + hi * 8) * 2));
                f32x16 p0, p1;
#pragma unroll
                for (int r = 0; r < 16; ++r) { p0[r] = 0.f; p1[r] = 0.f; }
#pragma unroll
                for (int d0 = 0; d0 < 8; ++d0) { const int cbb = (d0 * 16 + hi * 8) * 2;
                    const bf16x8 k0 = *(const bf16x8*)(Ks + KSW256(r32, cbb));
                    p0 = __builtin_amdgcn_mfma_f32_32x32x16_bf16(k0, qr[d0], p0, 0, 0, 0);
                    if (rb) { const bf16x8 k1 = *(const bf16x8*)(Ks + KSW256(32 + r32, cbb)); p1 = __builtin_amdgcn_mfma_f32_32x32x16_bf16(k1, qr[d0], p1, 0, 0, 0); } }
                const float rowt = gx[64 + t];
                float ps = 0.f;
#pragma unroll
                for (int a4 = 0; a4 < 4; ++a4) { const f32x4 c0 = *(const LAS f32x4*)(gx + 8 * a4 + 4 * hi), c1 = *(const LAS f32x4*)(gx + 32 + 8 * a4 + 4 * hi);
#pragma unroll
                    for (int b4 = 0; b4 < 4; ++b4) { const int r = 4 * a4 + b4, s0 = att::crow(r, hi), s1 = 32 + s0;
                        p0[r] = (s0 <= t) ? p0[r] * __expf(rowt + c0[b4]) : 0.f; p1[r] = (s1 <= t) ? p1[r] * __expf(rowt + c1[b4]) : 0.f; ps += p0[r] + p1[r]; } }
                { auto rr = __builtin_amdgcn_permlane32_swap(__float_as_uint(ps), __float_as_uint(ps), false, false); ps = __uint_as_float(rr[0]) + __uint_as_float(rr[1]); }
                bf16x8 pa0, pa1, pa2, pa3;
#define PK4(P, BASE, OUT) do { unsigned a0_ = cvt_pk_bf16(P[BASE + 0], P[BASE + 1]), a1_ = cvt_pk_bf16(P[BASE + 2], P[BASE + 3]); unsigned b0_ = cvt_pk_bf16(P[BASE + 4], P[BASE + 5]), b1_ = cvt_pk_bf16(P[BASE + 6], P[BASE + 7]); \
    auto r0_ = __builtin_amdgcn_permlane32_swap(a0_, b0_, false, false); auto r1_ = __builtin_amdgcn_permlane32_swap(a1_, b1_, false, false); u32x4 w_ = {r0_[0], r1_[0], r0_[1], r1_[1]}; OUT = *reinterpret_cast<bf16x8*>(&w_); } while (0)
                PK4(p0, 0, pa0); PK4(p0, 8, pa1); PK4(p1, 0, pa2); PK4(p1, 8, pa3);
#undef PK4
                float qn = 0.f;
#pragma unroll
                for (int d0 = 0; d0 < 8; ++d0) { const u32x4 qq = *reinterpret_cast<const u32x4*>(&qr[d0]); const f32x4 n0 = *(const LAS f32x4*)(gx + 256 + d0 * 16 + hi * 8), n1 = *(const LAS f32x4*)(gx + 256 + d0 * 16 + hi * 8 + 4);
                    qn += bf_lo(qq.x) * n0.x + bf_hi(qq.x) * n0.y + bf_lo(qq.y) * n0.z + bf_hi(qq.y) * n0.w + bf_lo(qq.z) * n1.x + bf_hi(qq.z) * n1.y + bf_lo(qq.w) * n1.z + bf_hi(qq.w) * n1.w; }
                { auto rr = __builtin_amdgcn_permlane32_swap(__float_as_uint(qn), __float_as_uint(qn), false, false); qn = __uint_as_float(rr[0]) + __uint_as_float(rr[1]); }
                const float wint = gx[128 + t];
                const float den = ps + wint * qn;
                const float ivr = __builtin_amdgcn_rcpf(fmaxf(fabsf(den), gx[192 + t]));
                f32x16 o[2], oi[2];
#pragma unroll
                for (int j = 0; j < 2; ++j)
#pragma unroll
                    for (int r = 0; r < 16; ++r) { o[j][r] = 0.f; oi[j][r] = 0.f; }
                const int vb = (int)(uintptr_t)(Vimg + (vq >> 1) * 16384) + att::v_rd_base(lane) + (vq & 1) * 1024;
#define GB_PV(D0, OD) do { \
                    const s16x4 l0_ = att::tr_read<att::v_rd_off(D0, 0, 0)>(vb), h0_ = att::tr_read<att::v_rd_off(D0, 0, 1)>(vb), l1_ = att::tr_read<att::v_rd_off(D0, 1, 0)>(vb), h1_ = att::tr_read<att::v_rd_off(D0, 1, 1)>(vb); \
                    const s16x4 l2_ = att::tr_read<att::v_rd_off(D0, 2, 0)>(vb), h2_ = att::tr_read<att::v_rd_off(D0, 2, 1)>(vb), l3_ = att::tr_read<att::v_rd_off(D0, 3, 0)>(vb), h3_ = att::tr_read<att::v_rd_off(D0, 3, 1)>(vb); \
                    asm volatile("s_waitcnt lgkmcnt(0)" ::: "memory"); SBAR(); \
                    OD = __builtin_amdgcn_mfma_f32_32x32x16_bf16(PK8(l0_, h0_), pa0, OD, 0, 0, 0); OD = __builtin_amdgcn_mfma_f32_32x32x16_bf16(PK8(l1_, h1_), pa1, OD, 0, 0, 0); \
                    OD = __builtin_amdgcn_mfma_f32_32x32x16_bf16(PK8(l2_, h2_), pa2, OD, 0, 0, 0); OD = __builtin_amdgcn_mfma_f32_32x32x16_bf16(PK8(l3_, h3_), pa3, OD, 0, 0, 0); } while (0)
                GB_PV(0, o[0]); GB_PV(1, o[1]);
#undef GB_PV
#pragma unroll
                for (int j = 0; j < 2; ++j)
#pragma unroll
                    for (int d0 = 0; d0 < 8; ++d0) { const bf16x8 cf = *(const bf16x8*)(Cs + CSW256(vq * 64 + j * 32 + r32, (d0 * 16 + hi * 8) * 2)); oi[j] = __builtin_amdgcn_mfma_f32_32x32x16_bf16(cf, qr[d0], oi[j], 0, 0, 0); }
#pragma unroll
                for (int r = 0; r < 16; ++r)
#pragma unroll
                    for (int j = 0; j < 2; ++j) yv[j][r] = (o[j][r] + wint * oi[j][r]) * ivr;
            }
            __builtin_amdgcn_sched_barrier(0);
            {
                int tid = tid0; asm volatile("" : "+v"(tid)); const int lane = tid & 63, hi = lane >> 5;
#pragma unroll
                for (int j = 0; j < 4; ++j)
#pragma unroll
                    for (int r = 0; r < 16; ++r) ua[j][r] = 0.f;
                const int vbV = (int)(uintptr_t)(Vimg + (wid >> 2) * 16384) + att::v_rd_base(lane) + (wid & 3) * 512;
                const int q4 = (lane >> 2) & 3, p4 = lane & 3, g1 = (lane >> 4) & 1;
                int kb[2][4];
#pragma unroll
                for (int hf = 0; hf < 2; ++hf)
#pragma unroll
                    for (int j = 0; j < 4; ++j) kb[hf][j] = (int)(uintptr_t)Ks + (8 * hi + 4 * hf + q4) * 256 + ((64 * j + 32 * g1 + 8 * p4) ^ ((4 * hf + q4) << 4));
#define GBSTEP(KS) do { \
                    const s16x4 al = att::tr_read<att::v_rd_off(0, KS, 0)>(vbV), ah = att::tr_read<att::v_rd_off(0, KS, 1)>(vbV); \
                    const s16x4 l0 = att::tr_read<KS * 4096>(kb[0][0]), h0 = att::tr_read<KS * 4096>(kb[1][0]), l1 = att::tr_read<KS * 4096>(kb[0][1]), h1 = att::tr_read<KS * 4096>(kb[1][1]); \
                    const s16x4 l2 = att::tr_read<KS * 4096>(kb[0][2]), h2 = att::tr_read<KS * 4096>(kb[1][2]), l3 = att::tr_read<KS * 4096>(kb[0][3]), h3 = att::tr_read<KS * 4096>(kb[1][3]); \
                    const f32x4 w0 = *(const LAS f32x4*)(gx + 640 + 16 * KS + 8 * hi), w1 = *(const LAS f32x4*)(gx + 640 + 16 * KS + 8 * hi + 4); \
                    asm volatile("s_waitcnt lgkmcnt(0)" ::: "memory"); SBAR(); \
                    u32x4 af_; af_.x = cvt_pk_bf16(bf1((bf16_t)al[0]) * w0.x, bf1((bf16_t)al[1]) * w0.y); af_.y = cvt_pk_bf16(bf1((bf16_t)al[2]) * w0.z, bf1((bf16_t)al[3]) * w0.w); \
                    af_.z = cvt_pk_bf16(bf1((bf16_t)ah[0]) * w1.x, bf1((bf16_t)ah[1]) * w1.y); af_.w = cvt_pk_bf16(bf1((bf16_t)ah[2]) * w1.z, bf1((bf16_t)ah[3]) * w1.w); \
                    const bf16x8 af = *reinterpret_cast<const bf16x8*>(&af_); \
                    ua[0] = __builtin_amdgcn_mfma_f32_32x32x16_bf16(PK8(l0, h0), af, ua[0], 0, 0, 0); ua[1] = __builtin_amdgcn_mfma_f32_32x32x16_bf16(PK8(l1, h1), af, ua[1], 0, 0, 0); \
                    ua[2] = __builtin_amdgcn_mfma_f32_32x32x16_bf16(PK8(l2, h2), af, ua[2], 0, 0, 0); ua[3] = __builtin_amdgcn_mfma_f32_32x32x16_bf16(PK8(l3, h3), af, ua[3], 0, 0, 0); } while (0)
                GBSTEP(0); GBSTEP(1); GBSTEP(2); GBSTEP(3);
#undef GBSTEP
                { float sacc = 0.f; const int dq = tid & 127, kq = (tid >> 7) * 16;
#pragma unroll
                  for (int k = 0; k < 16; ++k) sacc += gx[640 + kq + k] * bf1(*(const bf16_t*)(Ks + KSW256(kq + k, (dq & ~7) * 2) + (dq & 7) * 2));
                  npart[tid] = sacc; }
            }
            __syncthreads();
            u32x4 sv[4];
            { int tid = tid0; asm volatile("" : "+v"(tid));
#pragma unroll
              for (int k = 0; k < 4; ++k) { const int p = tid + 512 * k, row = p >> 5, ck = p & 31; sv[k] = *(const u32x4*)(so + (tok0 + row) * 1024 + h * 256 + ck * 8); } }
            { int tid = tid0; asm volatile("" : "+v"(tid)); const int lane = tid & 63, r32 = lane & 31, hi = lane >> 5;
              const int rb = wid & 1, vq = wid >> 1;
#pragma unroll
              for (int j = 0; j < 2; ++j)
#pragma unroll
                for (int a4 = 0; a4 < 4; ++a4) { u32x2 w; w.x = cvt_pk_bf16(yv[j][4 * a4 + 0], yv[j][4 * a4 + 1]); w.y = cvt_pk_bf16(yv[j][4 * a4 + 2], yv[j][4 * a4 + 3]);
                  *(u32x2*)(Yt + (32 * rb + r32) * 528 + (vq * 64 + j * 32 + 8 * a4 + 4 * hi) * 2) = w; }
              const int cn = (cc + 1 < GCH) ? c + 1 : c;
              GB_LOAD_G(cn); GB_LOAD_V(cn);
              {
                u32x2 cv[4][4];
#pragma unroll
                for (int j = 0; j < 4; ++j)
#pragma unroll
                  for (int a4 = 0; a4 < 4; ++a4) cv[j][a4] = *(const u32x2*)(Cs + CSW256(wid * 32 + r32, (32 * j + 8 * a4 + 4 * hi) * 2));
#pragma unroll
                for (int j = 0; j < 4; ++j) {
#pragma unroll
                  for (int a4 = 0; a4 < 4; ++a4) { u32x2 nv;
                    nv.x = cvt_pk_bf16(dec * bf_lo(cv[j][a4].x) + ua[j][4 * a4 + 0], dec * bf_hi(cv[j][a4].x) + ua[j][4 * a4 + 1]); nv.y = cvt_pk_bf16(dec * bf_lo(cv[j][a4].y) + ua[j][4 * a4 + 2], dec * bf_hi(cv[j][a4].y) + ua[j][4 * a4 + 3]);
                    *(u32x2*)(Cs + CSW256(wid * 32 + r32, (32 * j + 8 * a4 + 4 * hi) * 2)) = nv; }
                  if (j == 0) GB_LOAD_QK(cn, xq, 0, 0); else if (j == 1) GB_LOAD_QK(cn, xq, 0, 1); else if (j == 2) GB_LOAD_K(cn);
                } }
              if (tid < 128) gx[256 + tid] = dec * gx[256 + tid] + ((npart[tid] + npart[128 + tid]) + (npart[256 + tid] + npart[384 + tid])); }
            __syncthreads();
            { int tid = tid0; asm volatile("" : "+v"(tid));
#pragma unroll
              for (int k = 0; k < 4; ++k) { const int p = tid + 512 * k, row = p >> 5, ck = p & 31; const u32x4 y = *(const u32x4*)(Yt + row * 528 + ck * 16); u32x2 w;
                w.x = pk4_fp8(bf_lo(y.x) * bf_lo(sv[k].x), bf_hi(y.x) * bf_hi(sv[k].x), bf_lo(y.y) * bf_lo(sv[k].y), bf_hi(y.y) * bf_hi(sv[k].y));
                w.y = pk4_fp8(bf_lo(y.z) * bf_lo(sv[k].z), bf_hi(y.z) * bf_hi(sv[k].z), bf_lo(y.w) * bf_lo(sv[k].w), bf_hi(y.w) * bf_hi(sv[k].w));
                *(u32x2*)(ym8 + (tok0 + row) * 1024 + h * 256 + ck * 8) = w; } }
        }
    }
}

__global__ void __launch_bounds__(NTHREADS, 2) fwd_kernel(Args args) {
    __shared__ __attribute__((aligned(16))) unsigned char lds_raw[LDS_BYTES];
    Frame F;
    F.lds = (LAS unsigned char*)lds_raw;
    F.wave0 = wave_sgpr(); F.tid = threadIdx.x; F.lane = F.tid & 63; F.wave = F.wave0;
    F.ws = (unsigned char*)(GAS unsigned char*)argp()->ws;
    for (int u = F.tid; u < (LDS_BYTES - LDSCTL_OFF) / 4; u += NTHREADS) ((LAS unsigned*)(F.lds + LDSCTL_OFF))[u] = 0u;
    __syncthreads();
    XcdBarrier bar = xcd_barrier_post(((unsigned*)F.ws) + CW_BAR, (volatile LAS unsigned*)(F.lds + LDSCTL_OFF));
#define GRID_BAR() xcd_barrier(bar)
#define PH(k) ((PHASE_MASK >> (k)) & 1u)
#ifndef PROBE
#define PROBE -1
#endif
#define REPS(k) for (int rep_ = 0; rep_ < ((PROBE == (k)) ? 2 : 1); ++rep_)

    p0_prologue(F);
    GRID_BAR();
    if (F.bid * NTHREADS + F.tid < 2 * 4 * 6144) {
        const int i = F.bid * NTHREADS + F.tid, l = i / (4 * 6144), r = i % (4 * 6144), b = r / 6144, idx = r % 6144;
        ((float*)(F.ws + WS_MODF))[i] = mod_from_partials(argp(), F.ws, l, b, idx);
    }
    for (int l = 0; l < DEPTH; ++l) {
        REPS(1) convert_weights(F, l);
        __syncthreads();
        if (l == 0) { REPS(11) { row_phase_norm1<0>(F, l); __syncthreads(); } } else row_phase_norm1<1>(F, l);
        GRID_BAR();
        F.refresh();
#if PROBE == 41
        { pg8::DenseOrder8 S; S.init(F.ws + WS_S(0), F.ws + WS_W + W_IN, T, NIN, 1024, 1024, 1024, F.G, F.bid, W8_E8M0); EpiInProjT<false> E{F.ws, (const float*)(F.ws + WS_ROPE)}; pg8::gemm_phase(F.lds, S, E, F.wave); }
#endif
#if PROBE == 30
        { pg8::DenseOrder8 S; S.init(F.ws + WS_S(0), F.ws + WS_W + W_IN, T, NIN, 1024, 1024, 1024, F.G, F.bid, W8_E8M0); EpiNull E; pg8::gemm_phase(F.lds, S, E, F.wave); }
#endif
        REPS(2) if (PH(2)) {
            pg8::DenseOrder8 S; S.init(F.ws + WS_S(0), F.ws + WS_W + W_IN, T, NIN, 1024, 1024, 1024, F.G, F.bid, W8_E8M0);
            EpiInProj E{F.ws, (const float*)(F.ws + WS_ROPE)};
            pg8::gemm_phase(F.lds, S, E, F.wave);
        }
        GRID_BAR();
        REPS(3) { if (PH(3)) row_phase_stats(F);
        if (PH(6)) mlstm_gates_local(F, l); __syncthreads(); }
        GRID_BAR();
        REPS(4) if (PH(6)) mlstm_group_state(F, l);
        GRID_BAR();
        if (PH(6)) mlstm_group_scan(F);
        GRID_BAR();
        REPS(6) if (PH(6)) mlstm_group_output(F, l);
        GRID_BAR();
        F.refresh();
        REPS(7) if (PH(7)) {
            { pg8::DenseOrder S; S.init(F.ws + WS_CQ, F.ws + WS_W + W_UQ, T, 1536, 384, 384, 384, F.G, F.bid); EpiUq E{F.ws, (const float*)(F.ws + WS_ROPE)}; pg8::gemm_phase(F.lds, S, E, F.wave); }
            { pg8::DenseOrder8 S; S.init(F.ws + WS_CKV, F.ws + WS_W + W_UKV, T, 2048, 256, 256, 256, F.G, F.bid, W8_E8M0); EpiUkv E{F.ws}; pg8::gemm_phase(F.lds, S, E, F.wave); }
        }
#if PROBE == 71
        { pg8::DenseOrder S; S.init(F.ws + WS_CQ, F.ws + WS_W + W_UQ, T, 1536, 384, 384, 384, F.G, F.bid); EpiUq E{F.ws, (const float*)(F.ws + WS_ROPE)}; pg8::gemm_phase(F.lds, S, E, F.wave); }
#endif
#if PROBE == 72
        { pg8::DenseOrder8 S; S.init(F.ws + WS_CKV, F.ws + WS_W + W_UKV, T, 2048, 256, 256, 256, F.G, F.bid, W8_E8M0); EpiUkv E{F.ws}; pg8::gemm_phase(F.lds, S, E, F.wave); }
#endif
#if PROBE == 73
        { pg8::DenseOrder S; S.init(F.ws + WS_CQ, F.ws + WS_W + W_UQ, T, 1536, 384, 384, 384, F.G, F.bid); EpiNull E; pg8::gemm_phase(F.lds, S, E, F.wave); }
        { pg8::DenseOrder8 S; S.init(F.ws + WS_CKV, F.ws + WS_W + W_UKV, T, 2048, 256, 256, 256, F.G, F.bid, W8_E8M0); EpiNull E; pg8::gemm_phase(F.lds, S, E, F.wave); }
#endif
        GRID_BAR();
        F.refresh();
        REPS(8) if (PH(8)) attn_phase(F, (PROBE != 8) || rep_ == 1);
        GRID_BAR();
        F.refresh();
        REPS(9) if (PH(9)) {
            MergeOrder S; S.ws = F.ws; S.G = F.G; S.c = F.bid; S.K = 1024; S.lda = 1024; S.ldb = 1024; S.pass0 = PH(6) ? 0 : 2;
            EpiMerge E{F.ws, PH(6) ? 1 : 0};
            pg8::gemm_phase(F.lds, S, E, F.wave);
        }
        GRID_BAR();
        F.refresh();
        REPS(10) if (PH(10)) {
            pg8::DenseOrder8 S; S.init(F.ws + WS_S(5), F.ws + WS_W + W_OUT, T, 1024, 1024, 1024, 1024, F.G, F.bid, W8_E8M0);
            EpiOut E{(l == 0) ? GIN(argp(), I_X) : (const float*)nullptr, (const bf16_t*)GOUT(argp()), xres(argp(), F.ws, l), (const float*)(F.ws + WS_MODF) + (size_t)l * 4 * 6144 + 2 * 1024, (PROBE != 10) || rep_ == 1};
            pg8::gemm_phase(F.lds, S, E, F.wave);
        }
        GRID_BAR();
#if PROBE == 20
        for (int xb = 0; xb < 10; ++xb) GRID_BAR();
#endif
        REPS(12) { if (PH(12)) row_phase_norm2_route(F, l, (PROBE != 12) || rep_ == 1); __syncthreads(); }
        GRID_BAR();
        moe_prefix(F, l);
        F.refresh();
        if (PH(13)) {
            MoeOrderUp S; S.A = (const char*)(F.ws + WS_S(0)); S.B = (const char*)(F.ws + WS_W + W_GU); S.G = F.G; S.c = F.bid; S.K = 1024; S.lda = 1024; S.ldb = 1024; S.npn = 2;
            S.pfx = (const LAS int*)(F.lds + LDSCTL_OFF + 64); S.ldest = (const unsigned*)(F.ws + WS_LDEST);
            EpiMoeUp E{(bf16_t*)(F.ws + WS_S(1))};
            pg8::gemm_phase(F.lds, S, E, F.wave);
        }
#if PROBE == 13
        if (PH(13)) {
            MoeOrderUp S; S.A = (const char*)(F.ws + WS_S(0)); S.B = (const char*)(F.ws + WS_W + W_GU); S.G = F.G; S.c = F.bid; S.K = 1024; S.lda = 1024; S.ldb = 1024; S.npn = 2;
            S.pfx = (const LAS int*)(F.lds + LDSCTL_OFF + 64); S.ldest = (const unsigned*)(F.ws + WS_LDEST);
            EpiMoeUp E{(bf16_t*)(F.ws + WS_S(1))};
            pg8::gemm_phase(F.lds, S, E, F.wave);
        }
#endif
        GRID_BAR();
        F.refresh();
        if (PH(14)) {
            MoeOrderDn S; S.A = (const char*)(F.ws + WS_S(1)); S.B = (const char*)(F.ws + WS_W + W_DN); S.G = F.G; S.c = F.bid; S.K = 256; S.lda = 256; S.ldb = 256; S.npn = 4;
            S.pfx = (const LAS int*)(F.lds + LDSCTL_OFF + 64); S.ldest = (const unsigned*)(F.ws + WS_LDEST);
            EpiMoeDn E{(bf16_t*)(F.ws + WS_S(2)), (const unsigned*)(F.ws + WS_LDEST), (const float*)(F.ws + WS_LW)};
            pg8::gemm_phase(F.lds, S, E, F.wave);
        }
#if PROBE == 14
        if (PH(14)) {
            MoeOrderDn S; S.A = (const char*)(F.ws + WS_S(1)); S.B = (const char*)(F.ws + WS_W + W_DN); S.G = F.G; S.c = F.bid; S.K = 256; S.lda = 256; S.ldb = 256; S.npn = 4;
            S.pfx = (const LAS int*)(F.lds + LDSCTL_OFF + 64); S.ldest = (const unsigned*)(F.ws + WS_LDEST);
            EpiMoeDn E{(bf16_t*)(F.ws + WS_S(2)), (const unsigned*)(F.ws + WS_LDEST), (const float*)(F.ws + WS_LW)};
            pg8::gemm_phase(F.lds, S, E, F.wave);
        }
#endif
        GRID_BAR();
    }
    row_phase_norm1<2>(F, 0);
}

extern "C" void kernel_launch(void* const* d_in, const int* in_sizes, int n_in, void* d_out, int out_size, void* d_ws, size_t ws_size, hipStream_t stream) {
    static int grid = 0;
    if (grid == 0) {
        if (n_in != 26 || out_size != T * D || ws_size < WS_END) { fprintf(stderr, "kernel_launch: unexpected shapes n_in %d out %d ws %zu (need %zu)\n", n_in, out_size, ws_size, (size_t)WS_END); grid = -1; return; }
        int dev = 0, cus = 0, per_cu = 0;
        if (hipGetDevice(&dev) != hipSuccess || hipDeviceGetAttribute(&cus, hipDeviceAttributeMultiprocessorCount, dev) != hipSuccess) { grid = -1; return; }
        if (hipOccupancyMaxActiveBlocksPerMultiprocessor(&per_cu, (const void*)fwd_kernel, NTHREADS, 0) != hipSuccess || per_cu < 1) fprintf(stderr, "kernel_launch: occupancy query says %d\n", per_cu);
        (void)hipGetLastError();
        if (cus < 256) { fprintf(stderr, "kernel_launch: built for a 256-CU device (one workgroup per CU), found %d CUs\n", cus); grid = -1; return; }
        grid = 256;
    }
    if (grid < 0) return;
    if (hipMemsetAsync((char*)d_ws + WS_CTL, 0, CTL_ZERO_BYTES, stream) != hipSuccess) return;
    Args a{};
    for (int i = 0; i < 26; ++i) a.in[i] = (const float*)d_in[i];
    a.out = (float*)d_out; a.ws = (unsigned char*)d_ws;
    hipLaunchKernelGGL(fwd_kernel, dim3(grid), dim3(NTHREADS), 0, stream, a);
}
```

```cpp
#include <hip/hip_runtime.h>
#include <cstdio>
#include <cstdint>

#ifndef PHASE_MASK
#define PHASE_MASK 0xFFFFFFFFu
#endif

#define LAS __attribute__((address_space(3)))
#define GAS __attribute__((address_space(1)))
typedef unsigned short bf16_t;
typedef short bf16x8 __attribute__((ext_vector_type(8)));
typedef short s16x4 __attribute__((ext_vector_type(4)));
typedef float f32x2 __attribute__((ext_vector_type(2)));
typedef float f32x4 __attribute__((ext_vector_type(4)));
typedef float f32x16 __attribute__((ext_vector_type(16)));
typedef unsigned u32x2 __attribute__((ext_vector_type(2)));
typedef unsigned u32x4 __attribute__((ext_vector_type(4)));
typedef int i32x8 __attribute__((ext_vector_type(8)));

constexpr int T = 32768, D = 1024, NBATCH = 4, SEQ = 8192, DEPTH = 2;
constexpr int D_IN = 5832, NIN = 3840;
constexpr int NWAVES = 8, NTHREADS = 512;
constexpr float EPS = 1e-6f;

constexpr size_t MiB = 1u << 20;
constexpr size_t WS_CTL = 0, CTL_ZERO_BYTES = 128 * 1024;
constexpr size_t WS_MODP = 1 * MiB;
constexpr size_t WS_MODF = 3 * MiB;
constexpr size_t WS_ROPE = 4 * MiB;
constexpr size_t WS_GATE = 6 * MiB;
constexpr size_t WS_CHK = 9 * MiB;
constexpr size_t WS_IFG = 11 * MiB;
constexpr size_t WS_RSTD = 12 * MiB;
constexpr size_t WS_W = 13 * MiB;
constexpr size_t W_IN = 0, W_GM = W_IN + (size_t)NIN * 1024 * 2, W_GA = W_GM + 2 * MiB, W_M = W_GA + 2 * MiB, W_A = W_M + 2 * MiB, W_OUT = W_A + 2 * MiB,
                 W_UQ = W_OUT + 2 * MiB, W_UKV = W_UQ + (size_t)1536 * 384 * 2, W_GU = W_UKV + (size_t)2048 * 256 * 2, W_DN = W_GU + 32 * MiB, W_END = W_DN + 16 * MiB;
static_assert(WS_W + W_END <= 84 * MiB, "weights region");
constexpr size_t WS_SMALL = 84 * MiB;
constexpr size_t WS_CQ = WS_SMALL, WS_CKV = WS_CQ + 24 * MiB, WS_KR = WS_CKV + 16 * MiB;
constexpr size_t WS_LDEST = WS_SMALL, WS_LW = WS_SMALL + 4 * MiB;
constexpr size_t WS_S0 = 128 * MiB, SLOT = 64 * MiB;
constexpr size_t WS_END = WS_S0 + 6 * SLOT;
#define WS_S(i) (WS_S0 + (size_t)(i) * SLOT)

constexpr int CW_BAR = 4096;
constexpr int CW_CNT = 16384;

constexpr int RING_BYTES = 131072;
constexpr int LDSX_OFF = RING_BYTES;
constexpr int LDSCTL_OFF = 163840 - 512;
constexpr int LDS_BYTES = 163840;

typedef __bf16 bf16x2_t __attribute__((ext_vector_type(2)));
__device__ __forceinline__ unsigned cvt_pk_bf16(float lo, float hi) { const f32x2 v = {lo, hi}; return __builtin_bit_cast(unsigned, __builtin_convertvector(v, bf16x2_t)); }
__device__ __forceinline__ unsigned pk4_fp8(float a, float b, float c, float d) { int w = 0; w = __builtin_amdgcn_cvt_pk_fp8_f32(a, b, w, false); w = __builtin_amdgcn_cvt_pk_fp8_f32(c, d, w, true); return (unsigned)w; }
constexpr float W8_SCALE = 64.f; constexpr int W8_E8M0 = 127 - 6;
__device__ __forceinline__ float bf_lo(unsigned w) { return __uint_as_float(w << 16); }
__device__ __forceinline__ float bf_hi(unsigned w) { return __uint_as_float(w & 0xffff0000u); }
__device__ __forceinline__ float bf1(bf16_t h) { return __uint_as_float(((unsigned)h) << 16); }
template <int CTRL> __device__ __forceinline__ float dpp_f(float v) { return __int_as_float(__builtin_amdgcn_update_dpp(0, __float_as_int(v), CTRL, 0xF, 0xF, false)); }
__device__ __forceinline__ float rdlane(float v, int l) { return __int_as_float(__builtin_amdgcn_readlane(__float_as_int(v), l)); }
__device__ __forceinline__ float wave_sum(float v) {
    v += dpp_f<0xB1>(v); v += dpp_f<0x4E>(v); v += dpp_f<0x141>(v); v += dpp_f<0x140>(v);
    return (__int_as_float(__builtin_amdgcn_readlane(__float_as_int(v), 0)) + __int_as_float(__builtin_amdgcn_readlane(__float_as_int(v), 16)))
         + (__int_as_float(__builtin_amdgcn_readlane(__float_as_int(v), 32)) + __int_as_float(__builtin_amdgcn_readlane(__float_as_int(v), 48)));
}
__device__ __forceinline__ float wave_max(float v) {
    v = fmaxf(v, dpp_f<0xB1>(v)); v = fmaxf(v, dpp_f<0x4E>(v)); v = fmaxf(v, dpp_f<0x141>(v)); v = fmaxf(v, dpp_f<0x140>(v));
    return fmaxf(fmaxf(__int_as_float(__builtin_amdgcn_readlane(__float_as_int(v), 0)), __int_as_float(__builtin_amdgcn_readlane(__float_as_int(v), 16))),
                 fmaxf(__int_as_float(__builtin_amdgcn_readlane(__float_as_int(v), 32)), __int_as_float(__builtin_amdgcn_readlane(__float_as_int(v), 48))));
}
__device__ __forceinline__ float sigmoidf_(float x) { return __builtin_amdgcn_rcpf(1.f + __builtin_amdgcn_exp2f(-1.4426950408889634f * x)); }
__device__ __forceinline__ float siluf_(float x) { return x * __builtin_amdgcn_rcpf(1.f + __builtin_amdgcn_exp2f(-1.4426950408889634f * x)); }
#define LDS_WAIT() asm volatile("s_waitcnt lgkmcnt(0)" ::: "memory")
#define VM_WAIT() asm volatile("s_waitcnt vmcnt(0)" ::: "memory")
__device__ __forceinline__ int lane_opaque() { int z = 0; asm volatile("" : "+v"(z)); return __builtin_amdgcn_mbcnt_hi(~0u, __builtin_amdgcn_mbcnt_lo(~0u, z)); }
__device__ __forceinline__ int wave_sgpr() { return __builtin_amdgcn_readfirstlane((int)threadIdx.x >> 6); }
__device__ __forceinline__ int tid_opaque(int wave) { return wave * 64 + lane_opaque(); }

#define XB_TMO      128
#define XB_XCNT(j)  (256  + 64 * (j))
#define XB_XSUB(j)  (1280 + 64 * (j))
#define XB_XGEN(j)  (2304 + 64 * (j))
#define XB_TOP      3328
#define XB_TOPGEN   3392
#define XCD_BAR_WORDS 3456
#define XB_SPIN_CAP (1u << 18)
__device__ __forceinline__ unsigned xb_ld(unsigned* p)              { return __hip_atomic_load(p, __ATOMIC_RELAXED, __HIP_MEMORY_SCOPE_AGENT); }
__device__ __forceinline__ unsigned xb_add(unsigned* p, unsigned v) { return __hip_atomic_fetch_add(p, v, __ATOMIC_RELAXED, __HIP_MEMORY_SCOPE_AGENT); }
__device__ __forceinline__ unsigned xb_xcc_id() { return (unsigned)__builtin_amdgcn_s_getreg((3 << 11) | 20) & 0xFu; }
#define XB_SPIN(cond, bar) do { unsigned _sp = 0; while (cond) { __builtin_amdgcn_s_sleep(1); \
    if ((++_sp & 255u) == 0u) { if (xb_ld(&(bar)[XB_TMO])) break; if (_sp > XB_SPIN_CAP) { atomicAdd(&(bar)[XB_TMO], 1u); break; } } } } while (0)
struct XcdBarrier { unsigned* bar; unsigned x; volatile LAS unsigned* st; };
__device__ __forceinline__ XcdBarrier xcd_barrier_post(unsigned* bar, volatile LAS unsigned* st) {
    XcdBarrier b; b.bar = bar; b.x = xb_xcc_id(); b.st = st;
    if (threadIdx.x == 0) (void)xb_add(&bar[XB_XCNT(b.x)], 1u);
    return b;
}
__device__ __forceinline__ void xcd_barrier_complete(unsigned* bar, unsigned x, unsigned& nloc, unsigned& nx) {
    const unsigned G = gridDim.x * gridDim.y * gridDim.z;
    unsigned sum, cnt, mine, sp = 0u;
    for (;;) {
        sum = 0u; cnt = 0u; mine = 0u;
#pragma unroll 1
        for (unsigned j = 0; j < 16; ++j) { const unsigned c = xb_ld(&bar[XB_XCNT(j)]); sum += c; cnt += (c > 0u) ? 1u : 0u; mine = (j == x) ? c : mine; }
        if (sum == G) break;
        __builtin_amdgcn_s_sleep(1);
        if ((++sp & 255u) == 0u) { if (xb_ld(&bar[XB_TMO])) break; if (sp > XB_SPIN_CAP) { atomicAdd(&bar[XB_TMO], 1u); break; } }
    }
    nloc = mine > 0u ? mine : 1u; nx = cnt > 0u ? cnt : 1u;
}
__device__ __forceinline__ void xcd_barrier(const XcdBarrier& b) {
    asm volatile("s_waitcnt vmcnt(0)" ::: "memory");
    __syncthreads();
    if (threadIdx.x == 0) {
        unsigned* bar = b.bar;
        __builtin_amdgcn_s_waitcnt(0);
        unsigned nloc = b.st[0], nx = b.st[1];
        if (nloc == 0u) { xcd_barrier_complete(bar, b.x, nloc, nx); b.st[0] = nloc; b.st[1] = nx; }
        const unsigned old = xb_add(&bar[XB_XSUB(b.x)], 1u);
        const unsigned gen = old / nloc;
        if (old + 1u == (gen + 1u) * nloc) {
            __builtin_amdgcn_fence(__ATOMIC_RELEASE, "agent");
            asm volatile("s_waitcnt vmcnt(0)" ::: "memory");
            const unsigned og = xb_add(&bar[XB_TOP], 1u);
            const unsigned tg = og / nx;
            if (og + 1u == (tg + 1u) * nx) xb_add(&bar[XB_TOPGEN], 1u);
            else XB_SPIN(xb_ld(&bar[XB_TOPGEN]) == tg, bar);
            __builtin_amdgcn_fence(__ATOMIC_ACQUIRE, "agent");
            asm volatile("s_waitcnt vmcnt(0)" ::: "memory");
        } else {
            XB_SPIN(xb_ld(&bar[XB_TOPGEN]) == gen, bar);
            __builtin_amdgcn_fence(__ATOMIC_ACQUIRE, "agent");
            asm volatile("s_waitcnt vmcnt(0)" ::: "memory");
        }
    }
    __syncthreads();
}

namespace pg8 {
constexpr int BM = 256, BK = 64, HALF = 128, HTB = HALF * BK * 2, STAGE_BYTES = 8 * HTB, NXCD = 8, WGM = 8;
__host__ __device__ __forceinline__ int lds_byte(int r, int c) { const int st = (r >> 4) * 2 + (c >> 5), rr = r & 15, cc = c & 31, ob = rr * 64 + cc * 2; return st * 1024 + (ob ^ (((ob >> 9) & 1) << 5)); }
__host__ __device__ __forceinline__ void stage_rc(int b, int& R, int& C) { const int st = b / 1024, sb = b % 1024, swz = sb ^ (((sb >> 9) & 1) << 5); R = (st >> 1) * 16 + swz / 64; C = (st & 1) * 32 + (swz % 64) / 2; }
__host__ __device__ __forceinline__ int perm32(int rho) { const int n = rho >> 4, i = rho & 15; return 8 * (i >> 2) + 4 * n + (i & 3); }

struct Unit { int pm, pn, aux, e, r0, nv; };

__device__ __forceinline__ void tile_of(int L, int nM, int nN, int& pm, int& pn) {
    const int nwg = nM * nN; int wgid = L;
    { const int q = nwg / NXCD, r = nwg % NXCD, xcd = wgid % NXCD, off = wgid / NXCD; wgid = (xcd < r ? xcd * (q + 1) : r * (q + 1) + (xcd - r) * q) + off; }
    const int nig = WGM * nN, gid = wgid / nig, fm = gid * WGM, gsz = (nM - fm) < WGM ? (nM - fm) : WGM;
    pm = fm + ((wgid % nig) % gsz); pn = (wgid % nig) / gsz;
}

template <bool F8_>
struct DenseOrderT {
    static constexpr bool GATHER = false, F8 = F8_; static constexpr int EB = F8_ ? 1 : 2;
    const char* A; const char* B; int nM, nN, G, c, K, lda, ldb, scaleA, scaleB;
    __device__ __forceinline__ void init(const void* A_, const void* B_, int M, int N, int K_, int lda_, int ldb_, int G_, int c_, int sB = 127) { A = (const char*)A_; B = (const char*)B_; nM = M / BM; nN = N / BM; G = G_; c = c_; K = K_; lda = lda_; ldb = ldb_; scaleA = 127; scaleB = sB; }
    __device__ __forceinline__ bool next(int i, Unit& u) const { const long L = (long)i * G + c; if (L >= (long)nM * nN) return false; tile_of((int)L, nM, nN, u.pm, u.pn); u.aux = 0; return true; }
    __device__ __forceinline__ const char* abase(const Unit& u) const { return A + (size_t)u.pm * BM * lda * EB; }
    __device__ __forceinline__ const char* bbase(const Unit& u) const { return B + (size_t)u.pn * BM * ldb * EB; }
    __device__ __forceinline__ unsigned arow(const Unit&, int r) const { return (unsigned)r; }
};
typedef DenseOrderT<false> DenseOrder;
typedef DenseOrderT<true> DenseOrder8;

template <class Epi, class Sched>
__device__ __forceinline__ void gemm_phase(LAS unsigned char* lds, const Sched& S, const Epi& E, int wave0) {
    const int tid = tid_opaque(wave0), wid = wave0, lane = tid & 63, wr = wid >> 2, wc = wid & 3, fr = lane & 15, fq = lane >> 4;
    constexpr bool F8 = Sched::F8; constexpr int EB = F8 ? 1 : 2;
    const int K = S.K, nt = K / (F8 ? 128 : BK), lda = S.lda, ldb = S.ldb;
    unsigned voffB0; { int R_, C_; stage_rc(tid * 16, R_, C_); const int Rb = Epi::PERM ? ((R_ & ~31) + perm32(R_ & 31)) : R_; voffB0 = (unsigned)(Rb * ldb * EB + C_ * 2); }
    const size_t pstepA = (size_t)64 * lda * EB, pstepB = (size_t)64 * ldb * EB, hstepA = (size_t)HALF * lda * EB;
    const size_t kstep = (size_t)(BK * 2);
    const size_t hstepB = (size_t)HALF * ldb * EB;
    const unsigned ldsw = (unsigned)wid * 1024u;
    const int aoff = lds_byte(wr * 64 + fr, fq * 8), boff = lds_byte(wc * 32 + fr, fq * 8);
    const int aoff0 = aoff, aoff1 = aoff + 1024, boff0 = boff, boff1 = boff + 1024;
#define PG8_SA(b, h) (((b) * 2 + (h)) * HTB)
#define PG8_SB(b, h) ((4 + (b) * 2 + (h)) * HTB)
#define PG8_STAGE2(bufoff, gbase, v0, pstep) do { \
        __builtin_amdgcn_global_load_lds((const unsigned*)((const char*)(gbase) + (v0)), (LAS unsigned*)(lds + (bufoff) + ldsw), 16, 0, 0); \
        __builtin_amdgcn_global_load_lds((const unsigned*)((const char*)(gbase) + (pstep) + (v0)), (LAS unsigned*)(lds + (bufoff) + ldsw + 8192), 16, 0, 0); } while (0)
#define PG8_STAGE(bufoff, gbase, v0, v1) do { \
        __builtin_amdgcn_global_load_lds((const unsigned*)((const char*)(gbase) + (v0)), (LAS unsigned*)(lds + (bufoff) + ldsw), 16, 0, 0); \
        __builtin_amdgcn_global_load_lds((const unsigned*)((const char*)(gbase) + (v1)), (LAS unsigned*)(lds + (bufoff) + ldsw + 8192), 16, 0, 0); } while (0)
#define PG8_LDA(dst, b, h) do { if constexpr (F8) { _Pragma("unroll") for (int m = 0; m < 4; ++m) { const u32x4 x0_ = *(const LAS u32x4*)(lds + PG8_SA(b, h) + aoff0 + m * 2048), x1_ = *(const LAS u32x4*)(lds + PG8_SA(b, h) + aoff1 + m * 2048); \
            dst##8[m] = (i32x8){(int)x0_.x, (int)x0_.y, (int)x0_.z, (int)x0_.w, (int)x1_.x, (int)x1_.y, (int)x1_.z, (int)x1_.w}; } } \
        else { _Pragma("unroll") for (int m = 0; m < 4; ++m) _Pragma("unroll") for (int k = 0; k < 2; ++k) dst[m][k] = *(const LAS bf16x8*)(lds + PG8_SA(b, h) + aoff + m * 2048 + k * 1024); } } while (0)
#define PG8_LDB(dst, b, h) do { if constexpr (F8) { _Pragma("unroll") for (int n = 0; n < 2; ++n) { const u32x4 x0_ = *(const LAS u32x4*)(lds + PG8_SB(b, h) + boff0 + n * 2048), x1_ = *(const LAS u32x4*)(lds + PG8_SB(b, h) + boff1 + n * 2048); \
            dst##8[n] = (i32x8){(int)x0_.x, (int)x0_.y, (int)x0_.z, (int)x0_.w, (int)x1_.x, (int)x1_.y, (int)x1_.z, (int)x1_.w}; } } \
        else { _Pragma("unroll") for (int n = 0; n < 2; ++n) _Pragma("unroll") for (int k = 0; k < 2; ++k) dst[n][k] = *(const LAS bf16x8*)(lds + PG8_SB(b, h) + boff + n * 2048 + k * 1024); } } while (0)
#define PG8_MMA(ai, bj, At, Bt) do { __builtin_amdgcn_s_setprio(1); if constexpr (F8) { _Pragma("unroll") for (int m = 0; m < 4; ++m) _Pragma("unroll") for (int n = 0; n < 2; ++n) \
            asm volatile("v_mfma_scale_f32_16x16x128_f8f6f4 %0, %1, %2, %0, %3, %4 op_sel_hi:[0,0,0]" : "+v"(acc[ai][bj][m][n]) : "v"(Bt##8[n]), "v"(At##8[m]), "v"(scB), "v"(scA)); } \
        else { _Pragma("unroll") for (int m = 0; m < 4; ++m) _Pragma("unroll") for (int n = 0; n < 2; ++n) _Pragma("unroll") for (int k = 0; k < 2; ++k) \
            acc[ai][bj][m][n] = __builtin_amdgcn_mfma_f32_16x16x32_bf16(Bt[n][k], At[m][k], acc[ai][bj][m][n], 0, 0, 0); } __builtin_amdgcn_s_setprio(0); } while (0)
#define PG8_WAIT_V(n) asm volatile("s_waitcnt vmcnt(" #n ")" ::: "memory")
#define PG8_WAIT_L(n) asm volatile("s_waitcnt lgkmcnt(" #n ")" ::: "memory")
#define PG8_BAR __builtin_amdgcn_s_barrier()
#define PG8_SCHED __builtin_amdgcn_sched_barrier(0)
    LAS unsigned* const rowtab = (LAS unsigned*)(lds + STAGE_BYTES);
    int gR0, gC0; stage_rc(tid * 16, gR0, gC0); const unsigned gcol2 = (unsigned)gC0 * 2u;
#define PG8_FILL(u, par) do { if (tid < 256) rowtab[(par) * 256 + tid] = S.arow(u, tid) * (unsigned)(lda * EB); } while (0)
#define PG8_STAGE_AG(bufoff, gbase, par, h) do { const unsigned o0_ = rowtab[(par) * 256 + (h) * 128 + gR0] + gcol2, o1_ = rowtab[(par) * 256 + (h) * 128 + 64 + gR0] + gcol2; PG8_STAGE(bufoff, gbase, o0_, o1_); } while (0)
#define PG8_VOFFA(u, vo) do { int R_, C_; stage_rc(tid * 16, R_, C_); vo = (unsigned)R_ * (unsigned)(lda * EB) + (unsigned)C_ * 2u; } while (0)
    Unit cur, nxt; int ui = 0;
    if (!S.next(0, cur)) return;
    f32x4 acc[2][2][4][2];
#pragma unroll
    for (int a = 0; a < 2; ++a)
#pragma unroll
        for (int b = 0; b < 2; ++b)
#pragma unroll
            for (int m = 0; m < 4; ++m)
#pragma unroll
                for (int n = 0; n < 2; ++n) acc[a][b][m][n] = (f32x4){0.f, 0.f, 0.f, 0.f};
    bf16x8 At[4][2], B0[2][2], B1[2][2]; i32x8 At8[4], B08[2], B18[2]; (void)At; (void)B0; (void)B1; (void)At8; (void)B08; (void)B18;
    unsigned est[Epi::STATE ? 32 : 1]; (void)est;
    int scA = S.scaleA, scB = S.scaleB; asm volatile("" : "+v"(scA), "+v"(scB));
    unsigned vc0 = 0u;
    int par = 0;
    if constexpr (Sched::GATHER) { PG8_FILL(cur, 0); __syncthreads(); } else { PG8_VOFFA(cur, vc0); }
#define PG8_STAGE_A(bufoff, gbase, nextu, h) do { if constexpr (Sched::GATHER) { PG8_STAGE_AG(bufoff, gbase, (nextu) ? (par ^ 1) : par, h); } else { PG8_STAGE2(bufoff, (gbase) + (h) * hstepA, vc0, pstepA); } } while (0)
    const char* cA = S.abase(cur); const char* cB = S.bbase(cur);
    PG8_STAGE2(PG8_SB(0, 0), cB, voffB0, pstepB); PG8_STAGE2(PG8_SB(0, 1), cB + hstepB, voffB0, pstepB); PG8_STAGE_A(PG8_SA(0, 0), cA, false, 0); PG8_STAGE_A(PG8_SA(0, 1), cA, false, 1);
    if (wr == 1) PG8_BAR;
    PG8_WAIT_V(2); PG8_BAR;
    PG8_STAGE2(PG8_SB(1, 0), cB + kstep, voffB0, pstepB); PG8_STAGE_A(PG8_SA(1, 0), cA + kstep, false, 0); PG8_STAGE2(PG8_SB(1, 1), cB + hstepB + kstep, voffB0, pstepB);
    PG8_WAIT_V(6); PG8_BAR;
    for (;;) {
        const bool has_next = S.next(ui + 1, nxt);
        const char* nA = has_next ? S.abase(nxt) : cA; const char* nB = has_next ? S.bbase(nxt) : cB;
        for (int t = 0; t < nt; t += 2) {
            const bool last = (t == nt - 2);
            const bool nx = last && has_next;
            if constexpr (Sched::GATHER) { if (nx) PG8_FILL(nxt, par ^ 1); }
            const char* a1 = cA + (size_t)(t + 1) * kstep;
            const char* a2 = last ? nA : cA + (size_t)(t + 2) * kstep; const char* b2 = last ? nB : cB + (size_t)(t + 2) * kstep;
            const char* a3 = a2 + kstep; const char* b3 = b2 + kstep;
            PG8_LDB(B0, 0, 0); PG8_LDB(B1, 0, 1); PG8_SCHED; PG8_LDA(At, 0, 0); PG8_STAGE_A(PG8_SA(1, 1), a1, false, 1);
            PG8_WAIT_V(8); PG8_WAIT_L(0); PG8_BAR; PG8_MMA(0, 0, At, B0); PG8_MMA(0, 1, At, B1); PG8_BAR; PG8_SCHED;
            PG8_LDA(At, 0, 1); PG8_STAGE2(PG8_SB(0, 0), b2, voffB0, pstepB); PG8_STAGE2(PG8_SB(0, 1), b2 + hstepB, voffB0, pstepB); PG8_STAGE_A(PG8_SA(0, 0), a2, nx, 0);
            PG8_WAIT_V(8); PG8_WAIT_L(0); PG8_BAR; PG8_MMA(1, 0, At, B0); PG8_MMA(1, 1, At, B1); PG8_BAR; PG8_SCHED;
            PG8_LDB(B0, 1, 0); PG8_LDB(B1, 1, 1); PG8_SCHED; PG8_LDA(At, 1, 0); PG8_STAGE_A(PG8_SA(0, 1), a2, nx, 1);
            PG8_WAIT_V(8); PG8_WAIT_L(0); PG8_BAR; PG8_MMA(0, 0, At, B0); PG8_MMA(0, 1, At, B1); PG8_BAR; PG8_SCHED;
            PG8_LDA(At, 1, 1); PG8_STAGE2(PG8_SB(1, 0), b3, voffB0, pstepB); PG8_STAGE2(PG8_SB(1, 1), b3 + hstepB, voffB0, pstepB); PG8_STAGE_A(PG8_SA(1, 0), a3, nx, 0);
            PG8_WAIT_V(8); PG8_WAIT_L(0); PG8_BAR; PG8_MMA(1, 0, At, B0); PG8_MMA(1, 1, At, B1); PG8_BAR; PG8_SCHED;
        }
        if (wr == 0) PG8_BAR;
        if constexpr (F8) asm volatile("s_nop 15\n\ts_nop 15" ::: "memory");
        { const int ln_ = lane_opaque(); const int fr_ = ln_ & 15, fq_ = ln_ >> 4;
          if constexpr (Epi::STATE) E(acc, cur, wr, wc, fr_, fq_, est); else E(acc, cur, wr, wc, fr_, fq_); }
        if (!has_next) break;
#pragma unroll
        for (int a = 0; a < 2; ++a)
#pragma unroll
            for (int b = 0; b < 2; ++b)
#pragma unroll
                for (int m = 0; m < 4; ++m)
#pragma unroll
                    for (int n = 0; n < 2; ++n) acc[a][b][m][n] = (f32x4){0.f, 0.f, 0.f, 0.f};
        cur = nxt; cA = nA; cB = nB; ++ui; par ^= 1;
        if (wr == 1) PG8_BAR;
    }
    PG8_WAIT_V(0);
    PG8_BAR;
#undef PG8_SA
#undef PG8_SB
#undef PG8_STAGE
#undef PG8_STAGE2
#undef PG8_LDA
#undef PG8_LDB
#undef PG8_MMA
#undef PG8_WAIT_V
#undef PG8_WAIT_L
#undef PG8_BAR
#undef PG8_SCHED
#undef PG8_VOFFA
#undef PG8_FILL
#undef PG8_STAGE_AG
#undef PG8_STAGE_A
}
}

#define EPI8_LOOP(...) \
    _Pragma("unroll") for (int ai = 0; ai < 2; ++ai) _Pragma("unroll") for (int m = 0; m < 4; ++m) { asm volatile("" ::: "memory"); const int rl = ai * 128 + wr * 64 + m * 16 + fr; const int row = u.pm * 256 + rl; (void)row; \
    _Pragma("unroll") for (int bj = 0; bj < 2; ++bj) { const int cl = bj * 128 + wc * 32 + 8 * fq; const int col = u.pn * 256 + cl; (void)col; const f32x4 v0 = acc[ai][bj][m][0], v1 = acc[ai][bj][m][1]; __VA_ARGS__ } }

struct Args { const float* in[26]; float* out; unsigned char* ws; };
#define CAS __attribute__((address_space(4)))
typedef const CAS Args* ArgP;
#define GAS __attribute__((address_space(1)))
#define GIN(a, i) ((const float*)(const GAS float*)(a)->in[i])
#define GOUT(a) ((float*)(GAS float*)(a)->out)
__device__ __forceinline__ ArgP argp() { unsigned long long p = (unsigned long long)(const CAS void*)__builtin_amdgcn_kernarg_segment_ptr(); asm volatile("" : "+s"(p)); return (ArgP)p; }
enum { I_X = 0, I_C, I_MODW, I_MODB, I_N1G, I_WIN, I_CONVW, I_CONVB, I_IGB, I_FGB, I_QNG, I_KVNG, I_WUQ, I_WUKV, I_WBM, I_WBA, I_WOUT, I_N2G, I_WGRP, I_BGRP, I_WRT, I_BRT, I_WEG, I_WEU, I_WED, I_FNG };

struct Frame {
    LAS unsigned char* lds;
    unsigned char* ws;
    int tid, lane, wave, wave0, bid, G;
    __device__ __forceinline__ void refresh() { { int w_ = wave0, b_ = blockIdx.x, g_ = gridDim.x; asm volatile("" : "+s"(w_), "+s"(b_), "+s"(g_)); wave = w_; bid = b_; G = g_; }
        tid = wave * 64 + lane_opaque(); lane = tid & 63;
        unsigned long long w = (unsigned long long)ws; asm volatile("" : "+s"(w)); ws = (unsigned char*)(GAS unsigned char*)w; }
};

template <class ColMap>
__device__ __forceinline__ void cvt_load(const ColMap& cm, int K, int item, int lane, f32x4 (&v)[8]) {
    const int nkb = K / 64, rb = item / nkb, kb = item % nkb, k0 = 64 * kb, r0 = 32 * rb;
    const int rq = r0 + 4 * (lane & 7);
    const float* src; int ld; const float* s1; int l1;
    const int c0 = cm.col(rq, src, ld), c1 = cm.col(rq + 1, s1, l1), c2 = cm.col(rq + 2, s1, l1), c3 = cm.col(rq + 3, s1, l1);
    const bool vec = (c0 >= 0) && (c1 == c0 + 1) && (c2 == c0 + 2) && (c3 == c0 + 3) && ((c0 & 3) == 0) && (s1 == src);
#pragma unroll
    for (int i = 0; i < 8; ++i) { const int kk = (lane >> 3) + 8 * i; v[i] = (f32x4){0.f, 0.f, 0.f, 0.f};
        if (!cm.kvalid(k0 + kk)) continue;
        if (vec) v[i] = *(const f32x4*)(src + (size_t)(k0 + kk) * ld + c0);
        else { const float* sa; int la; int c;
            c = cm.col(rq, sa, la); if (c >= 0) v[i].x = sa[(size_t)(k0 + kk) * la + c];
            c = cm.col(rq + 1, sa, la); if (c >= 0) v[i].y = sa[(size_t)(k0 + kk) * la + c];
            c = cm.col(rq + 2, sa, la); if (c >= 0) v[i].z = sa[(size_t)(k0 + kk) * la + c];
            c = cm.col(rq + 3, sa, la); if (c >= 0) v[i].w = sa[(size_t)(k0 + kk) * la + c]; } }
}
template <bool F8, class ColMap>
__device__ __forceinline__ void cvt_store(const ColMap& cm, int K, void* dstv, LAS float* scr, int item, int lane, const f32x4 (&v)[8]) {
    const int nkb = K / 64, rb = item / nkb, kb = item % nkb, k0 = 64 * kb, r0 = 32 * rb;
#pragma unroll
    for (int i = 0; i < 8; ++i) { const int kk = (lane >> 3) + 8 * i; *(LAS f32x4*)(scr + kk * 36 + 4 * (lane & 7)) = v[i] * cm.kscale(k0 + kk); }
    LDS_WAIT(); asm volatile("" ::: "memory");
    const int c = lane & 7;
#pragma unroll
    for (int j = 0; j < 4; ++j) { const int n = (lane >> 3) + 8 * j; const LAS float* s = scr + (8 * c) * 36 + n;
        if constexpr (F8) { u32x2 o; o.x = pk4_fp8(s[0 * 36] * W8_SCALE, s[1 * 36] * W8_SCALE, s[2 * 36] * W8_SCALE, s[3 * 36] * W8_SCALE); o.y = pk4_fp8(s[4 * 36] * W8_SCALE, s[5 * 36] * W8_SCALE, s[6 * 36] * W8_SCALE, s[7 * 36] * W8_SCALE);
            *(u32x2*)((unsigned char*)dstv + (size_t)(r0 + n) * K + k0 + 8 * c) = o; }
        else { u32x4 o; o.x = cvt_pk_bf16(s[0 * 36], s[1 * 36]); o.y = cvt_pk_bf16(s[2 * 36], s[3 * 36]); o.z = cvt_pk_bf16(s[4 * 36], s[5 * 36]); o.w = cvt_pk_bf16(s[6 * 36], s[7 * 36]);
            *(u32x4*)((bf16_t*)dstv + (size_t)(r0 + n) * K + k0 + 8 * c) = o; } }
    LDS_WAIT(); asm volatile("" ::: "memory");
}
struct CmOffset { const float* W; int ld, off; __device__ __forceinline__ int col(int r, const float*& s, int& l) const { s = W; l = ld; return off + r; } __device__ __forceinline__ bool kvalid(int) const { return true; } __device__ __forceinline__ float kscale(int) const { return 1.f; } };
struct CmIn { const float* W; __device__ __forceinline__ int col(int r, const float*& s, int& l) const { s = W; l = D_IN;
        if (r < 3072) return r; if (r < 3456) return 3080 + (r - 3072); if (r < 3712) return 3464 + (r - 3456);
        if (r < 3776) { const int i = r - 3712, j = i >> 1; return 3720 + ((i & 1) ? 32 + j : j); }
        if (r < 3784) return 3072 + (r - 3776); return -1; }
    __device__ __forceinline__ bool kvalid(int) const { return true; } __device__ __forceinline__ float kscale(int) const { return 1.f; } };
struct CmUq { const float* W; const float* g; __device__ __forceinline__ int col(int r, const float*& s, int& l) const { s = W; l = 1536;
        if (r < 1024) return (r >> 7) * 192 + (r & 127); const int i = r - 1024, h = i >> 6, p = i & 63, jj = p >> 1; return h * 192 + 128 + ((p & 1) ? 32 + jj : jj); }
    __device__ __forceinline__ bool kvalid(int k) const { return k < 384; }
    __device__ __forceinline__ float kscale(int k) const { return k < 384 ? g[k] : 0.f; } };
struct CmUkv { const float* W; const float* g; __device__ __forceinline__ int col(int r, const float*& s, int& l) const { s = W; l = 2048;
        if (r < 1024) return (r >> 7) * 256 + (r & 127); const int i = r - 1024; return (i >> 7) * 256 + 128 + (i & 127); }
    __device__ __forceinline__ bool kvalid(int) const { return true; } __device__ __forceinline__ float kscale(int k) const { return g[k]; } };
struct CmGu { const float* Wg; const float* Wu; __device__ __forceinline__ int col(int r, const float*& s, int& l) const { const int e = r >> 9, w = r & 511, pn = w >> 8, x = w & 255; l = 256;
        if (x < 128) { s = Wg + (size_t)e * 1024 * 256; return pn * 128 + x; } s = Wu + (size_t)e * 1024 * 256; return pn * 128 + x - 128; }
    __device__ __forceinline__ bool kvalid(int) const { return true; } __device__ __forceinline__ float kscale(int) const { return 1.f; } };
struct CmDn { const float* W; __device__ __forceinline__ int col(int r, const float*& s, int& l) const { const int e = r >> 10; s = W + (size_t)e * 256 * 1024; l = 1024; return r & 1023; }
    __device__ __forceinline__ bool kvalid(int) const { return true; } __device__ __forceinline__ float kscale(int) const { return 1.f; } };

template <int N> struct IC { static constexpr int value = N; };
template <class Fn>
__device__ __forceinline__ void cvt_dispatch(ArgP a, unsigned char* W, int l, int it, Fn&& fn) {
    const float* w_in = GIN(a, I_WIN) + (size_t)l * 1024 * D_IN;
    constexpr int N_IN = (NIN / 32) * 16, N_SQ = 32 * 16, N_UQ = 48 * 8, N_UKV = 64 * 4, N_GU = (32 * 512 / 32) * 16;
    int r = it;
    if (r < N_IN) { CmIn cm{w_in}; fn(cm, 1024, (void*)(W + W_IN), IC<1>{}, r); return; } r -= N_IN;
    if (r < N_SQ) { CmOffset cm{w_in, D_IN, 3784}; fn(cm, 1024, (void*)(W + W_GM), IC<1>{}, r); return; } r -= N_SQ;
    if (r < N_SQ) { CmOffset cm{w_in, D_IN, 3784 + 1024}; fn(cm, 1024, (void*)(W + W_GA), IC<1>{}, r); return; } r -= N_SQ;
    if (r < N_SQ) { CmOffset cm{GIN(a, I_WBM) + (size_t)l * 1024 * 1024, 1024, 0}; fn(cm, 1024, (void*)(W + W_M), IC<1>{}, r); return; } r -= N_SQ;
    if (r < N_SQ) { CmOffset cm{GIN(a, I_WBA) + (size_t)l * 1024 * 1024, 1024, 0}; fn(cm, 1024, (void*)(W + W_A), IC<1>{}, r); return; } r -= N_SQ;
    if (r < N_SQ) { CmOffset cm{GIN(a, I_WOUT) + (size_t)l * 1024 * 1024, 1024, 0}; fn(cm, 1024, (void*)(W + W_OUT), IC<1>{}, r); return; } r -= N_SQ;
    if (r < N_UQ) { CmUq cm{GIN(a, I_WUQ) + (size_t)l * 384 * 1536, GIN(a, I_QNG) + l * 384}; fn(cm, 512, (void*)(W + W_UQ), IC<1>{}, r); return; } r -= N_UQ;
    if (r < N_UKV) { CmUkv cm{GIN(a, I_WUKV) + (size_t)l * 256 * 2048, GIN(a, I_KVNG) + l * 256}; fn(cm, 256, (void*)(W + W_UKV), IC<1>{}, r); return; } r -= N_UKV;
    if (r < N_GU) { CmGu cm{GIN(a, I_WEG) + (size_t)l * 32 * 1024 * 256, GIN(a, I_WEU) + (size_t)l * 32 * 1024 * 256}; fn(cm, 1024, (void*)(W + W_GU), IC<1>{}, r); return; } r -= N_GU;
    { CmDn cm{GIN(a, I_WED) + (size_t)l * 32 * 256 * 1024}; fn(cm, 256, (void*)(W + W_DN), IC<1>{}, r); }
}
__device__ __forceinline__ void convert_weights(Frame& F, int l) {
    F.refresh();
    ArgP a = argp();
    LAS float* scr = (LAS float*)(F.lds + F.wave * 16384);
    unsigned char* W = F.ws + WS_W;
    const int gw = F.bid * NWAVES + F.wave, NGW = F.G * NWAVES;
    constexpr int N_IN = (NIN / 32) * 16, N_SQ = 32 * 16, N_UQ = 48 * 8, N_UKV = 64 * 4, N_GU = (32 * 512 / 32) * 16, N_DN = (32 * 1024 / 32) * 4;
    constexpr int NITEMS = N_IN + 5 * N_SQ + N_UQ + N_UKV + N_GU + N_DN;
    f32x4 va[8], vb[8];
    const int lane = F.lane;
    auto load_a = [&](int it) __attribute__((always_inline)) { cvt_dispatch(a, W, l, it, [&](auto cm, int K, void*, auto, int r) __attribute__((always_inline)) { cvt_load(cm, K, r, lane, va); }); };
    auto load_b = [&](int it) __attribute__((always_inline)) { cvt_dispatch(a, W, l, it, [&](auto cm, int K, void*, auto, int r) __attribute__((always_inline)) { cvt_load(cm, K, r, lane, vb); }); };
    auto store_a = [&](int it) __attribute__((always_inline)) { cvt_dispatch(a, W, l, it, [&](auto cm, int K, void* dst, auto f8, int r) __attribute__((always_inline)) { cvt_store<(decltype(f8)::value != 0)>(cm, K, dst, scr, r, lane, va); }); };
    auto store_b = [&](int it) __attribute__((always_inline)) { cvt_dispatch(a, W, l, it, [&](auto cm, int K, void* dst, auto f8, int r) __attribute__((always_inline)) { cvt_store<(decltype(f8)::value != 0)>(cm, K, dst, scr, r, lane, vb); }); };
    if (gw < NITEMS) load_a(gw);
    for (int it = gw; it < NITEMS; it += 2 * NGW) {
        if (it + NGW < NITEMS) load_b(it + NGW);
        store_a(it);
        if (it + 2 * NGW < NITEMS) load_a(it + 2 * NGW);
        if (it + NGW < NITEMS) store_b(it + NGW);
    }
}

__constant__ float kInvFreq[32] = {1.000000000e+00f, 7.498942018e-01f, 5.623413324e-01f, 4.216965139e-01f, 3.162277639e-01f, 2.371373922e-01f, 1.778279394e-01f, 1.333521456e-01f, 1.000000015e-01f, 7.498941571e-02f, 5.623412877e-02f, 4.216964915e-02f, 3.162277862e-02f, 2.371373586e-02f, 1.778279431e-02f, 1.333521493e-02f, 9.999999776e-03f, 7.498942316e-03f, 5.623413250e-03f, 4.216964822e-03f, 3.162277862e-03f, 2.371373819e-03f, 1.778279431e-03f, 1.333521446e-03f, 1.000000047e-03f, 7.498941850e-04f, 5.623413017e-04f, 4.216965463e-04f, 3.162277862e-04f, 2.371373848e-04f, 1.778279402e-04f, 1.333521504e-04f};
__device__ __forceinline__ void p0_prologue(Frame& F) {
    F.refresh();
    ArgP a = argp();
    LAS float* cond = (LAS float*)(F.lds);
    for (int i = F.tid; i < 4096; i += NTHREADS) cond[i] = siluf_(GIN(a, I_C)[i]);
    __syncthreads();
    float* modp = (float*)(F.ws + WS_MODP);
    const int gw = F.bid * NWAVES + F.wave, NGW = F.G * NWAVES;
    for (int it = gw; it < 2 * 96 * 8; it += NGW) {
        const int l = it / 768, r = it % 768, g = r >> 3, p = r & 7, col = g * 64 + F.lane;
        const float* w = GIN(a, I_MODW) + (size_t)l * 1024 * 6144 + (size_t)(p * 128) * 6144 + col;
        float s0 = 0.f, s1 = 0.f, s2 = 0.f, s3 = 0.f;
#pragma unroll 32
        for (int k = 0; k < 128; ++k) { const float wv = w[(size_t)k * 6144]; const int kk = p * 128 + k; s0 += cond[kk] * wv; s1 += cond[1024 + kk] * wv; s2 += cond[2048 + kk] * wv; s3 += cond[3072 + kk] * wv; }
        float* o = modp + ((size_t)(l * 8 + p) * 4) * 6144 + col;
        o[0] = s0; o[6144] = s1; o[2 * 6144] = s2; o[3 * 6144] = s3;
    }
    float* rc = (float*)(F.ws + WS_ROPE); float* rs = rc + 8192 * 32;
    for (int i = F.bid * NTHREADS + F.tid; i < 8192 * 32; i += F.G * NTHREADS) {
        const int pos = i >> 5, j = i & 31;
        const float invf = kInvFreq[j];
        const float angf = (float)pos * invf;
        const double x = (double)angf;
        const double kq = rint(x * 0.63661977236758134308);
        const double r = (x - kq * 1.57079632679489655800e+00) - kq * 6.12323399573676603587e-17;
        const double r2 = r * r;
        double sp = r * (1.0 + r2 * (-1.0 / 6 + r2 * (1.0 / 120 + r2 * (-1.0 / 5040 + r2 * (1.0 / 362880 + r2 * (-1.0 / 39916800 + r2 * (1.0 / 6227020800.0)))))));
        double cp = 1.0 + r2 * (-0.5 + r2 * (1.0 / 24 + r2 * (-1.0 / 720 + r2 * (1.0 / 40320 + r2 * (-1.0 / 3628800 + r2 * (1.0 / 479001600.0 + r2 * (-1.0 / 87178291200.0)))))));
        const int q = ((int)kq) & 3;
        const double sn = (q == 0) ? sp : (q == 1) ? cp : (q == 2) ? -sp : -cp;
        const double cs = (q == 0) ? cp : (q == 1) ? -sp : (q == 2) ? -cp : sp;
        rc[i] = (float)cs; rs[i] = (float)sn;
    }
}
__device__ __forceinline__ float mod_from_partials(ArgP a, const unsigned char* ws, int l, int b, int idx) {
    const float* modp = (const float*)(ws + WS_MODP);
    float s = GIN(a, I_MODB)[l * 6144 + idx];
#pragma unroll
    for (int p = 0; p < 8; ++p) s += modp[((size_t)(l * 8 + p) * 4 + b) * 6144 + idx];
    return s;
}

__device__ __forceinline__ bf16_t* xres(ArgP a, unsigned char* ws, int l) { return (l == DEPTH - 1) ? (bf16_t*)(ws + WS_S(4)) : (bf16_t*)GOUT(a); }
template <int MODE>
__device__ __forceinline__ void row_phase_norm1(Frame& F, int l) {
    F.refresh();
    ArgP a = argp();
    LAS float* tab = (LAS float*)(F.lds + LDSX_OFF);
    const int row0 = F.bid * 128, b = row0 / SEQ;
    for (int i = F.tid; i < 1024; i += NTHREADS) {
        const int p = ((((i >> 9) * 2 + ((i >> 2) & 1)) * 64 + ((i >> 3) & 63)) << 2) + (i & 3);
        const float* mf = (const float*)(F.ws + WS_MODF);
        if (MODE == 2) { tab[p] = GIN(a, I_FNG)[i]; }
        else if (MODE == 0) { tab[p] = GIN(a, I_N1G)[l * 1024 + i]; tab[1024 + p] = 1.f + mod_from_partials(a, F.ws, l, b, 1024 + i); tab[2048 + p] = mod_from_partials(a, F.ws, l, b, i); }
        else { tab[p] = GIN(a, I_N1G)[l * 1024 + i]; tab[1024 + p] = 1.f + mf[((size_t)l * 4 + b) * 6144 + 1024 + i]; tab[2048 + p] = mf[((size_t)l * 4 + b) * 6144 + i]; }
        if (MODE >= 1) tab[3072 + p] = mf[((size_t)((MODE == 2) ? DEPTH - 1 : l - 1) * 4 + b) * 6144 + 5 * 1024 + i];
    }
    __syncthreads();
    const float* xin32 = GIN(a, I_X);
    bf16_t* xb = (MODE == 2) ? xres(a, F.ws, DEPTH - 1) : xres(a, F.ws, l - 1);
    unsigned char* h1 = F.ws + WS_S(0);
    const unsigned char* oa = F.ws + WS_S(2);
    f32x4 xn[2][4]; u32x4 xq[2][2]; u32x2 pn0[2][2], pn1[2][2];
#define ROW_LOAD(S, rrow) do { _Pragma("unroll") for (int j = 0; j < 2; ++j) { \
            if (MODE == 0) { const f32x4* xr_ = (const f32x4*)(xin32 + (size_t)(rrow) * D) + 2 * F.lane + 128 * j; xn[S][2 * j] = xr_[0]; xn[S][2 * j + 1] = xr_[1]; } \
            else { xq[S][j] = *((const u32x4*)(xb + (size_t)(rrow) * D) + F.lane + 64 * j); pn0[S][j] = *((const u32x2*)(oa + (size_t)(2 * (rrow)) * D) + F.lane + 64 * j); pn1[S][j] = *((const u32x2*)(oa + (size_t)(2 * (rrow) + 1) * D) + F.lane + 64 * j); } } } while (0)
    ROW_LOAD(0, row0 + F.wave); ROW_LOAD(1, row0 + F.wave + NWAVES);
    auto body = [&](auto sl, int rr) __attribute__((always_inline)) {
        constexpr int S = decltype(sl)::value;
        const int row = row0 + rr;
        f32x4 v[4]; float ss = 0.f;
        if (MODE == 0) {
#pragma unroll
            for (int q = 0; q < 4; ++q) v[q] = xn[S][q];
        } else {
#pragma unroll
            for (int j = 0; j < 2; ++j) {
                const u32x4 xw = xq[S][j]; const u32x2 p0 = pn0[S][j], p1 = pn1[S][j];
                const f32x4 g0 = *(const LAS f32x4*)(tab + 3072 + (((j * 2 + 0) * 64 + F.lane) << 2)), g1 = *(const LAS f32x4*)(tab + 3072 + (((j * 2 + 1) * 64 + F.lane) << 2));
                const f32x2 a0 = __builtin_amdgcn_cvt_pk_f32_fp8(p0.x, false), a1 = __builtin_amdgcn_cvt_pk_f32_fp8(p0.x, true), a2 = __builtin_amdgcn_cvt_pk_f32_fp8(p0.y, false), a3 = __builtin_amdgcn_cvt_pk_f32_fp8(p0.y, true);
                const f32x2 b0 = __builtin_amdgcn_cvt_pk_f32_fp8(p1.x, false), b1 = __builtin_amdgcn_cvt_pk_f32_fp8(p1.x, true), b2 = __builtin_amdgcn_cvt_pk_f32_fp8(p1.y, false), b3 = __builtin_amdgcn_cvt_pk_f32_fp8(p1.y, true);
                v[2 * j].x = bf_lo(xw.x) + g0.x * (a0.x + b0.x); v[2 * j].y = bf_hi(xw.x) + g0.y * (a0.y + b0.y); v[2 * j].z = bf_lo(xw.y) + g0.z * (a1.x + b1.x); v[2 * j].w = bf_hi(xw.y) + g0.w * (a1.y + b1.y);
                v[2 * j + 1].x = bf_lo(xw.z) + g1.x * (a2.x + b2.x); v[2 * j + 1].y = bf_hi(xw.z) + g1.y * (a2.y + b2.y); v[2 * j + 1].z = bf_lo(xw.w) + g1.z * (a3.x + b3.x); v[2 * j + 1].w = bf_hi(xw.w) + g1.w * (a3.y + b3.y);
            }
        }
        if (rr + 2 * NWAVES < 128) ROW_LOAD(S, row + 2 * NWAVES);
#pragma unroll
        for (int q = 0; q < 4; ++q) ss += (v[q].x * v[q].x + v[q].y * v[q].y) + (v[q].z * v[q].z + v[q].w * v[q].w);
        const float rstd = rsqrtf(wave_sum(ss) * (1.f / D) + EPS);
#pragma unroll
        for (int j = 0; j < 2; ++j) {
            const f32x4 ga = *(const LAS f32x4*)(tab + (((j * 2 + 0) * 64 + F.lane) << 2)), gb = *(const LAS f32x4*)(tab + (((j * 2 + 1) * 64 + F.lane) << 2));
            const f32x4 va = v[2 * j], vb = v[2 * j + 1];
            if (MODE == 2) {
                f32x4 o0, o1; o0.x = va.x * rstd * ga.x; o0.y = va.y * rstd * ga.y; o0.z = va.z * rstd * ga.z; o0.w = va.w * rstd * ga.w; o1.x = vb.x * rstd * gb.x; o1.y = vb.y * rstd * gb.y; o1.z = vb.z * rstd * gb.z; o1.w = vb.w * rstd * gb.w;
                f32x4* op = (f32x4*)(GOUT(a) + (size_t)row * D) + 2 * F.lane + 128 * j; op[0] = o0; op[1] = o1;
            } else {
                if (MODE == 1) { u32x4 w; w.x = cvt_pk_bf16(va.x, va.y); w.y = cvt_pk_bf16(va.z, va.w); w.z = cvt_pk_bf16(vb.x, vb.y); w.w = cvt_pk_bf16(vb.z, vb.w); *((u32x4*)(xb + (size_t)row * D) + F.lane + 64 * j) = w; }
                const f32x4 sca = *(const LAS f32x4*)(tab + 1024 + (((j * 2 + 0) * 64 + F.lane) << 2)), scb = *(const LAS f32x4*)(tab + 1024 + (((j * 2 + 1) * 64 + F.lane) << 2));
                const f32x4 sha = *(const LAS f32x4*)(tab + 2048 + (((j * 2 + 0) * 64 + F.lane) << 2)), shb = *(const LAS f32x4*)(tab + 2048 + (((j * 2 + 1) * 64 + F.lane) << 2));
                u32x2 w8; w8.x = pk4_fp8(va.x * rstd * ga.x * sca.x + sha.x, va.y * rstd * ga.y * sca.y + sha.y, va.z * rstd * ga.z * sca.z + sha.z, va.w * rstd * ga.w * sca.w + sha.w);
                w8.y = pk4_fp8(vb.x * rstd * gb.x * scb.x + shb.x, vb.y * rstd * gb.y * scb.y + shb.y, vb.z * rstd * gb.z * scb.z + shb.z, vb.w * rstd * gb.w * scb.w + shb.w);
                *((u32x2*)(h1 + (size_t)row * D) + F.lane + 64 * j) = w8;
            }
        }
    };
    for (int rr = F.wave; rr < 128; rr += 2 * NWAVES) { body(IC<0>{}, rr); body(IC<1>{}, rr + NWAVES); }
#undef ROW_LOAD
}

__device__ __forceinline__ void row_phase_norm2_route(Frame& F, int l, bool do_append) {
    F.refresh();
    ArgP a = argp();
    LAS bf16_t* wtr16 = (LAS bf16_t*)(F.lds);
    LAS bf16_t* wtg16 = (LAS bf16_t*)(F.lds + 131072);
    LAS float* tab = (LAS float*)(F.lds + 147456);
    LAS float* cstW = (LAS float*)(F.lds + 155648);
    LAS float* cst = cstW + 8 * 48;
    LAS unsigned* cntL = (LAS unsigned*)(cst + 48);
    LAS unsigned* baseL = cntL + 32;
    LAS float* rstdL = (LAS float*)(baseL + 32);
    LAS unsigned* rsel = (LAS unsigned*)(rstdL + 128);
    LAS float* rw = (LAS float*)(rsel + 128);
    LAS float* lg = (LAS float*)(F.lds);
    const int row0 = F.bid * 128, b = row0 / SEQ;
    const float* modf = (const float*)(F.ws + WS_MODF) + ((size_t)l * 4 + b) * 6144;
    for (int i = F.tid; i < 1024; i += NTHREADS) { tab[i] = GIN(a, I_N2G)[l * 1024 + i] * (1.f + modf[4 * 1024 + i]); tab[1024 + i] = modf[3 * 1024 + i]; }
    if (F.tid < 32) cntL[F.tid] = 0u;
    __syncthreads();
    {
        float cj = 0.f, cg = 0.f;
        const float* wrt = GIN(a, I_WRT) + (size_t)l * 32768; const float* wgp = GIN(a, I_WGRP) + (size_t)l * 4096;
#pragma unroll 1
        for (int i0 = F.tid; i0 < 32 * 1024; i0 += NTHREADS * 16) {
            float wv[16];
#pragma unroll
            for (int q = 0; q < 16; ++q) wv[q] = wrt[i0 + NTHREADS * q];
#pragma unroll
            for (int q = 0; q < 16; ++q) { const int i = i0 + NTHREADS * q, k = i >> 5, j = i & 31; const float w = wv[q];
                cj += tab[1024 + k] * w;
                const float wp = w * tab[k]; const unsigned hb = cvt_pk_bf16(wp, 0.f) & 0xffffu, lb = cvt_pk_bf16(wp - __uint_as_float(hb << 16), 0.f) & 0xffffu;
                const int p = ((((((j >> 4) * 32 + (k >> 5)) * 2) * 4 + ((k >> 3) & 3)) * 16 + (j & 15)) << 3) + (k & 7);
                wtr16[p] = (bf16_t)hb; wtr16[p + 512] = (bf16_t)lb; }
        }
        { float wv[8];
#pragma unroll
          for (int q = 0; q < 8; ++q) wv[q] = wgp[F.tid + NTHREADS * q];
#pragma unroll
          for (int q = 0; q < 8; ++q) { const int i = F.tid + NTHREADS * q, k = i >> 2, j = i & 3; const float w = wv[q];
              cg += tab[1024 + k] * w;
              const float wp = w * tab[k]; const unsigned hb = cvt_pk_bf16(wp, 0.f) & 0xffffu, lb = cvt_pk_bf16(wp - __uint_as_float(hb << 16), 0.f) & 0xffffu;
              const int p = (((((k >> 5) * 2) * 4 + ((k >> 3) & 3)) * 4 + j) << 3) + (k & 7);
              wtg16[p] = (bf16_t)hb; wtg16[p + 128] = (bf16_t)lb; } }
        cj += __int_as_float(__builtin_amdgcn_ds_bpermute((F.lane ^ 32) << 2, __float_as_int(cj)));
#pragma unroll
        for (int o = 4; o < 64; o <<= 1) cg += __int_as_float(__builtin_amdgcn_ds_bpermute((F.lane ^ o) << 2, __float_as_int(cg)));
        if (F.lane < 32) cstW[F.wave * 48 + F.lane] = cj;
        if (F.lane < 4) cstW[F.wave * 48 + 32 + F.lane] = cg;
    }
    __syncthreads();
    if (F.tid < 36) {
        float s = (F.tid < 32) ? GIN(a, I_BRT)[l * 32 + F.tid] : GIN(a, I_BGRP)[l * 4 + F.tid - 32];
#pragma unroll
        for (int w = 0; w < 8; ++w) s += cstW[w * 48 + F.tid];
        cst[F.tid] = s;
    }
    f32x4 acc0 = {0.f, 0.f, 0.f, 0.f}, acc1 = acc0, acc2 = acc0; float ss = 0.f;
    {
        const bf16_t* xrow = xres(a, F.ws, l) + (size_t)(row0 + 16 * F.wave + (F.lane & 15)) * D + 8 * (F.lane >> 4);
        LAS const unsigned char* br0 = F.lds + (((F.lane >> 4) * 16 + (F.lane & 15)) << 4);
        LAS const unsigned char* bg0 = F.lds + 131072 + (((F.lane >> 4) * 4 + (F.lane & 3)) << 4);
        u32x4 xw[8];
#pragma unroll
        for (int s = 0; s < 8; ++s) xw[s] = *(const u32x4*)(xrow + 32 * s);
#pragma unroll 1
        for (int o = 0; o < 4; ++o) {
#pragma unroll
            for (int s = 0; s < 8; ++s) {
                const u32x4 cw = xw[s];
                if (o < 3) xw[s] = *(const u32x4*)(xrow + 32 * (8 * o + 8 + s));
                const f32x4 ca = {bf_lo(cw.x), bf_hi(cw.x), bf_lo(cw.y), bf_hi(cw.y)}, cb = {bf_lo(cw.z), bf_hi(cw.z), bf_lo(cw.w), bf_hi(cw.w)};
                const int step = 8 * o + s;
                const bf16x8 r0h = *(const LAS bf16x8*)(br0 + (step * 2 + 0) * 1024), r0l = *(const LAS bf16x8*)(br0 + (step * 2 + 1) * 1024);
                const bf16x8 r1h = *(const LAS bf16x8*)(br0 + ((32 + step) * 2 + 0) * 1024), r1l = *(const LAS bf16x8*)(br0 + ((32 + step) * 2 + 1) * 1024);
                const bf16x8 gh = *(const LAS bf16x8*)(bg0 + (step * 2 + 0) * 256), gl = *(const LAS bf16x8*)(bg0 + (step * 2 + 1) * 256);
                ss += (ca.x * ca.x + ca.y * ca.y) + (ca.z * ca.z + ca.w * ca.w) + (cb.x * cb.x + cb.y * cb.y) + (cb.z * cb.z + cb.w * cb.w);
                const bf16x8 av = *reinterpret_cast<const bf16x8*>(&cw);
                acc0 = __builtin_amdgcn_mfma_f32_16x16x32_bf16(av, r0h, acc0, 0, 0, 0); acc1 = __builtin_amdgcn_mfma_f32_16x16x32_bf16(av, r1h, acc1, 0, 0, 0); acc2 = __builtin_amdgcn_mfma_f32_16x16x32_bf16(av, gh, acc2, 0, 0, 0);
                acc0 = __builtin_amdgcn_mfma_f32_16x16x32_bf16(av, r0l, acc0, 0, 0, 0); acc1 = __builtin_amdgcn_mfma_f32_16x16x32_bf16(av, r1l, acc1, 0, 0, 0); acc2 = __builtin_amdgcn_mfma_f32_16x16x32_bf16(av, gl, acc2, 0, 0, 0);
            }
        }
    }
    ss += __int_as_float(__builtin_amdgcn_ds_bpermute((F.lane ^ 16) << 2, __float_as_int(ss)));
    ss += __int_as_float(__builtin_amdgcn_ds_bpermute((F.lane ^ 32) << 2, __float_as_int(ss)));
    const float rstd = rsqrtf(ss * (1.f / D) + EPS);
    __syncthreads();
    {
        LAS float* lr = lg + (16 * F.wave + 4 * (F.lane >> 4)) * 49 + (F.lane & 15);
        lr[0] = acc0.x; lr[49] = acc0.y; lr[98] = acc0.z; lr[147] = acc0.w;
        lr[16] = acc1.x; lr[16 + 49] = acc1.y; lr[16 + 98] = acc1.z; lr[16 + 147] = acc1.w;
        if ((F.lane & 15) < 4) { lr[32] = acc2.x; lr[32 + 49] = acc2.y; lr[32 + 98] = acc2.z; lr[32 + 147] = acc2.w; }
    }
    if (F.lane < 16) {
        const int r = 16 * F.wave + F.lane;
        LAS const float* lr = lg + r * 49;
        const float g0 = rstd * lr[32] + cst[32], g1 = rstd * lr[33] + cst[33], g2 = rstd * lr[34] + cst[34], g3 = rstd * lr[35] + cst[35];
        int grp = 0; float gm = g0; if (g1 > gm) { gm = g1; grp = 1; } if (g2 > gm) { gm = g2; grp = 2; } if (g3 > gm) { gm = g3; grp = 3; }
        const float pg = 1.f / (__expf(g0 - gm) + __expf(g1 - gm) + __expf(g2 - gm) + __expf(g3 - gm));
        float el[8];
#pragma unroll
        for (int e = 0; e < 8; ++e) el[e] = rstd * lr[grp * 8 + e] + cst[grp * 8 + e];
        int e1 = 0; float m1 = el[0];
#pragma unroll
        for (int e = 1; e < 8; ++e) if (el[e] > m1) { m1 = el[e]; e1 = e; }
        int e2 = -1; float m2 = -3.0e38f;
#pragma unroll
        for (int e = 0; e < 8; ++e) if (e != e1 && el[e] > m2) { m2 = el[e]; e2 = e; }
        const float p2 = __expf(m2 - m1), w1 = pg / (1.f + p2), w2 = pg * p2 / (1.f + p2);
        const unsigned ex1 = (unsigned)(grp * 8 + e1), ex2 = (unsigned)(grp * 8 + e2);
        const unsigned q1 = __hip_atomic_fetch_add(cntL + ex1, 1u, __ATOMIC_RELAXED, __HIP_MEMORY_SCOPE_WORKGROUP);
        const unsigned q2 = __hip_atomic_fetch_add(cntL + ex2, 1u, __ATOMIC_RELAXED, __HIP_MEMORY_SCOPE_WORKGROUP);
        rsel[r] = ex1 | (ex2 << 8) | (q1 << 16) | (q2 << 24); rw[r] = w1; rw[128 + r] = w2; rstdL[r] = rstd;
    }
    __syncthreads();
    unsigned* cnt = ((unsigned*)F.ws) + CW_CNT + l * 32 * 64;
    if (F.tid < 32 && do_append) { const unsigned n = cntL[F.tid]; baseL[F.tid] = n ? atomicAdd(&cnt[F.tid * 64], n) : 0u; }
    __syncthreads();
    if (F.tid < 256 && do_append) {
        unsigned* ldest = (unsigned*)(F.ws + WS_LDEST); float* lw = (float*)(F.ws + WS_LW);
        const int r = F.tid >> 1, k = F.tid & 1; const unsigned sel = rsel[r];
        const unsigned ex = (sel >> (8 * k)) & 0xffu, pos = baseL[ex] + ((sel >> (16 + 8 * k)) & 0xffu);
        ldest[(size_t)ex * T + pos] = (unsigned)(2 * (row0 + r) + k); lw[(size_t)ex * T + pos] = rw[128 * k + r];
    }
    unsigned char* h2 = F.ws + WS_S(0);
    const bf16_t* xb = xres(a, F.ws, l);
    u32x4 xn[2][2];
#pragma unroll
    for (int j = 0; j < 2; ++j) { xn[0][j] = *((const u32x4*)(xb + (size_t)(row0 + F.wave) * D) + F.lane + 64 * j); xn[1][j] = *((const u32x4*)(xb + (size_t)(row0 + F.wave + NWAVES) * D) + F.lane + 64 * j); }
    auto body = [&](auto sl, int rr) __attribute__((always_inline)) {
        constexpr int S = decltype(sl)::value;
        const int row = row0 + rr;
        u32x4 v[2];
#pragma unroll
        for (int j = 0; j < 2; ++j) v[j] = xn[S][j];
        if (rr + 2 * NWAVES < 128) {
#pragma unroll
            for (int j = 0; j < 2; ++j) xn[S][j] = *((const u32x4*)(xb + (size_t)(row + 2 * NWAVES) * D) + F.lane + 64 * j); }
        const float rs = rstdL[rr];
#pragma unroll
        for (int j = 0; j < 2; ++j) {
            const f32x4 ga = *(const LAS f32x4*)(tab + 8 * F.lane + 512 * j), gb = *(const LAS f32x4*)(tab + 8 * F.lane + 512 * j + 4), sa = *(const LAS f32x4*)(tab + 1024 + 8 * F.lane + 512 * j), sb = *(const LAS f32x4*)(tab + 1024 + 8 * F.lane + 512 * j + 4);
            u32x2 o; o.x = pk4_fp8(bf_lo(v[j].x) * rs * ga.x + sa.x, bf_hi(v[j].x) * rs * ga.y + sa.y, bf_lo(v[j].y) * rs * ga.z + sa.z, bf_hi(v[j].y) * rs * ga.w + sa.w);
            o.y = pk4_fp8(bf_lo(v[j].z) * rs * gb.x + sb.x, bf_hi(v[j].z) * rs * gb.y + sb.y, bf_lo(v[j].w) * rs * gb.z + sb.z, bf_hi(v[j].w) * rs * gb.w + sb.w);
            *((u32x2*)(h2 + (size_t)row * D) + F.lane + 64 * j) = o;
        }
    };
    for (int rr = F.wave; rr < 128; rr += 2 * NWAVES) { body(IC<0>{}, rr); body(IC<1>{}, rr + NWAVES); }
}

struct MoeOrder {
    static constexpr bool F8 = false; static constexpr int scaleA = 127, scaleB = 127;
    const char* A; const char* B; int G, c, K, lda, ldb, npn; const LAS int* pfx;
    const unsigned* ldest;
    __device__ __forceinline__ bool next(int i, pg8::Unit& u) const {
        const int L = i * G + ((c & 7) * (G >> 3) + (c >> 3));
        const int ntl = __builtin_amdgcn_readfirstlane(pfx[32]); if (L >= ntl * npn) return false;
        const int tile = L / npn; u.pn = L % npn; u.pm = tile;
        int e = 0;
#pragma unroll
        for (int j = 1; j < 32; ++j) e += (tile >= __builtin_amdgcn_readfirstlane(pfx[j])) ? 1 : 0;
        u.e = e; u.r0 = (tile - __builtin_amdgcn_readfirstlane(pfx[e])) * 256; const int n = __builtin_amdgcn_readfirstlane(pfx[33 + e]) - u.r0; u.nv = n < 256 ? n : 256; u.aux = 0; return true;
    }
};
struct MoeOrderUp : MoeOrder {
    static constexpr bool GATHER = true, F8 = true; static constexpr int scaleA = 127, scaleB = W8_E8M0;
    __device__ __forceinline__ const char* abase(const pg8::Unit&) const { return A; }
    __device__ __forceinline__ const char* bbase(const pg8::Unit& u) const { return B + ((size_t)u.e * 512 + (size_t)u.pn * 256) * 1024; }
    __device__ __forceinline__ unsigned arow(const pg8::Unit& u, int r) const { const int rr = r < u.nv ? r : 0; return ldest[(size_t)u.e * T + u.r0 + rr] >> 1; }
};
struct MoeOrderDn : MoeOrder {
    static constexpr bool GATHER = false, F8 = true; static constexpr int scaleA = 127 - 4, scaleB = W8_E8M0;
    __device__ __forceinline__ const char* abase(const pg8::Unit& u) const { return A + (size_t)u.pm * 256 * 256; }
    __device__ __forceinline__ const char* bbase(const pg8::Unit& u) const { return B + ((size_t)u.e * 1024 + (size_t)u.pn * 256) * 256; }
    __device__ __forceinline__ unsigned arow(const pg8::Unit&, int r) const { return (unsigned)r; }
};
struct EpiMoeUp {
    static constexpr bool PERM = true, STATE = false;
    bf16_t* act;
    __device__ __forceinline__ void operator()(const f32x4 (&acc)[2][2][4][2], const pg8::Unit& u, int wr, int wc, int fr, int fq) const {
#pragma unroll
        for (int ai = 0; ai < 2; ++ai)
#pragma unroll
            for (int m = 0; m < 4; ++m) {
                const int rl = ai * 128 + wr * 64 + m * 16 + fr;
                const f32x4 g0 = acc[ai][0][m][0], g1 = acc[ai][0][m][1], u0 = acc[ai][1][m][0] * 16.f, u1 = acc[ai][1][m][1] * 16.f;
                u32x2 w; w.x = pk4_fp8(siluf_(g0.x) * u0.x, siluf_(g0.y) * u0.y, siluf_(g0.z) * u0.z, siluf_(g0.w) * u0.w);
                w.y = pk4_fp8(siluf_(g1.x) * u1.x, siluf_(g1.y) * u1.y, siluf_(g1.z) * u1.z, siluf_(g1.w) * u1.w);
                *(u32x2*)((unsigned char*)act + ((size_t)u.pm * 256 + rl) * 256 + u.pn * 128 + wc * 32 + 8 * fq) = w;
            }
    }
};
struct EpiMoeDn {
    static constexpr bool PERM = true, STATE = false;
    bf16_t* oa; const unsigned* ldest; const float* lw;
    __device__ __forceinline__ void operator()(const f32x4 (&acc)[2][2][4][2], const pg8::Unit& u, int wr, int wc, int fr, int fq) const {
        unsigned dv[8]; float wv[8];
#pragma unroll
        for (int k = 0; k < 8; ++k) { const int rl = (k >> 2) * 128 + wr * 64 + (k & 3) * 16 + fr; const int rc = rl < u.nv ? rl : 0; dv[k] = ldest[(size_t)u.e * T + u.r0 + rc]; wv[k] = lw[(size_t)u.e * T + u.r0 + rc]; }
#pragma unroll
        for (int ai = 0; ai < 2; ++ai)
#pragma unroll
            for (int m = 0; m < 4; ++m) {
                const int rl = ai * 128 + wr * 64 + m * 16 + fr;
                if (rl < u.nv) {
                    const unsigned dest = dv[ai * 4 + m]; const float w = wv[ai * 4 + m];
#pragma unroll
                    for (int bj = 0; bj < 2; ++bj) {
                        const f32x4 v0 = acc[ai][bj][m][0] * w, v1 = acc[ai][bj][m][1] * w;
                        u32x2 o; o.x = pk4_fp8(v0.x, v0.y, v0.z, v0.w); o.y = pk4_fp8(v1.x, v1.y, v1.z, v1.w);
                        *(u32x2*)((unsigned char*)oa + (size_t)dest * 1024 + u.pn * 256 + bj * 128 + wc * 32 + 8 * fq) = o;
                    }
                }
            }
    }
};
__device__ __forceinline__ void moe_prefix(Frame& F, int l) {
    F.refresh();
    LAS int* pfx = (LAS int*)(F.lds + LDSCTL_OFF + 64);
    if (F.wave == 0) {
        const int e = F.lane & 31;
        const int c = (int)__hip_atomic_load(((unsigned*)F.ws) + CW_CNT + (l * 32 + e) * 64, __ATOMIC_RELAXED, __HIP_MEMORY_SCOPE_AGENT);
        int incl = (F.lane < 32) ? ((c + 255) >> 8) : 0; const int mine = incl;
#pragma unroll
        for (int o = 1; o < 32; o <<= 1) { const int t = __builtin_amdgcn_ds_bpermute((F.lane - o) << 2, incl); if (F.lane >= o) incl += t; }
        if (F.lane < 32) { pfx[e] = incl - mine; pfx[33 + e] = c; if (F.lane == 31) pfx[32] = incl; }
    }
    __syncthreads();
}


template <bool ST, class V> __device__ __forceinline__ void st_or_keep(V* p, const V& w) { if (ST) *p = w; else asm volatile("" :: "v"(w)); }
template <bool ST>
struct EpiInProjT {
    static constexpr bool PERM = true, STATE = false;
    unsigned char* ws; const float* rope;
    __device__ __forceinline__ void operator()(const f32x4 (&acc)[2][2][4][2], const pg8::Unit& u, int wr, int wc, int fr, int fq) const {
        const unsigned r0 = (unsigned)(wr * 64 + fr);
        const size_t rowu = (size_t)u.pm * 256;
#pragma unroll
        for (int bj = 0; bj < 2; ++bj) {
            const int colw = u.pn * 256 + bj * 128 + wc * 32;
            if (colw < 2048) {
                unsigned char* base = ws + (colw < 1024 ? WS_S(1) : WS_S(2)) + (rowu * 1024 + (size_t)(colw & 1023)) * 2;
                const unsigned lo = (r0 * 1024u + 8u * fq) * 2u;
#pragma unroll
                for (int ai = 0; ai < 2; ++ai)
#pragma unroll
                    for (int m = 0; m < 4; ++m) { const f32x4 v0 = acc[ai][bj][m][0], v1 = acc[ai][bj][m][1];
                        u32x4 w; w.x = cvt_pk_bf16(v0.x, v0.y); w.y = cvt_pk_bf16(v0.z, v0.w); w.z = cvt_pk_bf16(v1.x, v1.y); w.w = cvt_pk_bf16(v1.z, v1.w);
                        st_or_keep<ST>((u32x4*)(base + (lo + (unsigned)(ai * 128 + m * 16) * 2048u)), w); }
            } else if (colw < 3072) {
                unsigned char* base = ws + WS_S(3) + (rowu * 1024 + (size_t)(colw - 2048)) * 2;
                const unsigned lo = (r0 * 1024u + 8u * fq) * 2u;
#pragma unroll
                for (int ai = 0; ai < 2; ++ai)
#pragma unroll
                    for (int m = 0; m < 4; ++m) { const f32x4 v0 = acc[ai][bj][m][0], v1 = acc[ai][bj][m][1];
                        u32x4 w; w.x = cvt_pk_bf16(sigmoidf_(v0.x), sigmoidf_(v0.y)); w.y = cvt_pk_bf16(sigmoidf_(v0.z), sigmoidf_(v0.w)); w.z = cvt_pk_bf16(sigmoidf_(v1.x), sigmoidf_(v1.y)); w.w = cvt_pk_bf16(sigmoidf_(v1.z), sigmoidf_(v1.w));
                        st_or_keep<ST>((u32x4*)(base + (lo + (unsigned)(ai * 128 + m * 16) * 2048u)), w); }
            } else if (colw >= 3456 && colw < 3712) {
                unsigned char* base = ws + WS_CKV + rowu * 256 + (size_t)(colw - 3456);
                const unsigned lo = r0 * 256u + 8u * fq;
#pragma unroll
                for (int ai = 0; ai < 2; ++ai)
#pragma unroll
                    for (int m = 0; m < 4; ++m) { const f32x4 v0 = acc[ai][bj][m][0], v1 = acc[ai][bj][m][1];
                        u32x2 w; w.x = pk4_fp8(v0.x, v0.y, v0.z, v0.w); w.y = pk4_fp8(v1.x, v1.y, v1.z, v1.w);
                        st_or_keep<ST>((u32x2*)(base + (lo + (unsigned)(ai * 128 + m * 16) * 256u)), w); }
            } else if (colw < 3456) {
                unsigned char* base = ws + WS_CQ + rowu * 512 + (size_t)(colw - 3072);
                const unsigned lo = r0 * 512u + 8u * fq;
#pragma unroll
                for (int ai = 0; ai < 2; ++ai)
#pragma unroll
                    for (int m = 0; m < 4; ++m) { const f32x4 v0 = acc[ai][bj][m][0], v1 = acc[ai][bj][m][1];
                        u32x2 w; w.x = pk4_fp8(v0.x, v0.y, v0.z, v0.w); w.y = pk4_fp8(v1.x, v1.y, v1.z, v1.w);
                        st_or_keep<ST>((u32x2*)(base + (lo + (unsigned)(ai * 128 + m * 16) * 512u)), w); }
            } else if (colw < 3776) {
                const int c = colw - 3712 + 8 * fq;
#pragma unroll
                for (int ai = 0; ai < 2; ++ai) {
                    f32x4 csv[4], snv[4];
#pragma unroll
                    for (int m = 0; m < 4; ++m) { const int pos = (u.pm * 256 + ai * 128 + m * 16 + (int)r0) & (SEQ - 1); csv[m] = *(const f32x4*)(rope + pos * 32 + (c >> 1)); snv[m] = *(const f32x4*)(rope + 8192 * 32 + pos * 32 + (c >> 1)); }
#pragma unroll
                    for (int m = 0; m < 4; ++m) { const f32x4 v0 = acc[ai][bj][m][0], v1 = acc[ai][bj][m][1];
                        const int row = u.pm * 256 + ai * 128 + m * 16 + (int)r0;
                        const f32x4 cs = csv[m], sn = snv[m];
                        u32x2 w; w.x = pk4_fp8(v0.x * cs.x - v0.y * sn.x, v0.x * sn.x + v0.y * cs.x, v0.z * cs.y - v0.w * sn.y, v0.z * sn.y + v0.w * cs.y);
                        w.y = pk4_fp8(v1.x * cs.z - v1.y * sn.z, v1.x * sn.z + v1.y * cs.z, v1.z * cs.w - v1.w * sn.w, v1.z * sn.w + v1.w * cs.w);
                        st_or_keep<ST>((u32x2*)(ws + WS_KR + (size_t)row * 64 + c), w); }
                }
            } else if (colw == 3776) {
                if (fq == 0) {
#pragma unroll
                    for (int ai = 0; ai < 2; ++ai)
#pragma unroll
                        for (int m = 0; m < 4; ++m) { const int row = u.pm * 256 + ai * 128 + m * 16 + (int)r0; float* ifg = (float*)(ws + WS_IFG) + (size_t)row * 8;
                            st_or_keep<ST>((f32x4*)ifg, acc[ai][bj][m][0]); st_or_keep<ST>((f32x4*)(ifg + 4), acc[ai][bj][m][1]); }
                }
            }
        }
    }
};
using EpiInProj = EpiInProjT<true>;
struct EpiNull { static constexpr bool PERM = true, STATE = false;
    __device__ __forceinline__ void operator()(const f32x4 (&acc)[2][2][4][2], const pg8::Unit& u, int wr, int wc, int fr, int fq) const {
#pragma unroll
        for (int ai = 0; ai < 2; ++ai)
#pragma unroll
            for (int bj = 0; bj < 2; ++bj)
#pragma unroll
                for (int m = 0; m < 4; ++m)
#pragma unroll
                    for (int n = 0; n < 2; ++n) asm volatile("" :: "v"(acc[ai][bj][m][n])); } };
struct EpiUq {
    static constexpr bool PERM = true, STATE = false;
    unsigned char* ws; const float* rope;
    __device__ __forceinline__ void operator()(const f32x4 (&acc)[2][2][4][2], const pg8::Unit& u, int wr, int wc, int fr, int fq) const {
        unsigned char* qn = ws + WS_S(1); unsigned char* qr = ws + WS_S(2); const float* rstd = (const float*)(ws + WS_RSTD);
        float rsv[8];
#pragma unroll
        for (int k = 0; k < 8; ++k) rsv[k] = rstd[u.pm * 256 + (k >> 2) * 128 + wr * 64 + (k & 3) * 16 + fr];
        if (u.pn < 4) {
            EPI8_LOOP({
                const float rs = rsv[ai * 4 + m];
                u32x2 w; w.x = pk4_fp8(v0.x * rs, v0.y * rs, v0.z * rs, v0.w * rs); w.y = pk4_fp8(v1.x * rs, v1.y * rs, v1.z * rs, v1.w * rs);
                *(u32x2*)(qn + (size_t)row * 1024 + col) = w;
            })
        } else {
#pragma unroll
            for (int ai = 0; ai < 2; ++ai) {
                f32x4 csv[4][2], snv[4][2];
#pragma unroll
                for (int m = 0; m < 4; ++m)
#pragma unroll
                    for (int bj = 0; bj < 2; ++bj) { const int row = u.pm * 256 + ai * 128 + wr * 64 + m * 16 + fr, p = (bj * 128 + wc * 32 + 8 * fq) & 63, pos = row & (SEQ - 1);
                        csv[m][bj] = *(const f32x4*)(rope + pos * 32 + (p >> 1)); snv[m][bj] = *(const f32x4*)(rope + 8192 * 32 + pos * 32 + (p >> 1)); }
#pragma unroll
                for (int m = 0; m < 4; ++m)
#pragma unroll
                    for (int bj = 0; bj < 2; ++bj) { const int row = u.pm * 256 + ai * 128 + wr * 64 + m * 16 + fr, c = (u.pn - 4) * 256 + bj * 128 + wc * 32 + 8 * fq; const float rs = rsv[ai * 4 + m];
                        const f32x4 v0 = acc[ai][bj][m][0], v1 = acc[ai][bj][m][1], cs = csv[m][bj] * rs, sn = snv[m][bj] * rs;
                        u32x2 w; w.x = pk4_fp8(v0.x * cs.x - v0.y * sn.x, v0.x * sn.x + v0.y * cs.x, v0.z * cs.y - v0.w * sn.y, v0.z * sn.y + v0.w * cs.y);
                        w.y = pk4_fp8(v1.x * cs.z - v1.y * sn.z, v1.x * sn.z + v1.y * cs.z, v1.z * cs.w - v1.w * sn.w, v1.z * sn.w + v1.w * cs.w);
                        *(u32x2*)(qr + (size_t)row * 512 + c) = w; }
            }
        }
    }
};
struct EpiUkv {
    static constexpr bool PERM = true, STATE = false;
    unsigned char* ws;
    __device__ __forceinline__ void operator()(const f32x4 (&acc)[2][2][4][2], const pg8::Unit& u, int wr, int wc, int fr, int fq) const {
        unsigned char* kn = ws + WS_S(4); unsigned char* va = ws + WS_S(5); const float* rstd = (const float*)(ws + WS_RSTD) + T;
        float rsv[8];
#pragma unroll
        for (int k = 0; k < 8; ++k) rsv[k] = rstd[u.pm * 256 + (k >> 2) * 128 + wr * 64 + (k & 3) * 16 + fr];
        EPI8_LOOP({
            const float rs = rsv[ai * 4 + m];
            if (col < 1024) { u32x2 w; w.x = pk4_fp8(v0.x * rs, v0.y * rs, v0.z * rs, v0.w * rs); w.y = pk4_fp8(v1.x * rs, v1.y * rs, v1.z * rs, v1.w * rs); *(u32x2*)(kn + (size_t)row * 1024 + col) = w; }
            else { u32x2 w; w.x = pk4_fp8(v0.x * rs, v0.y * rs, v0.z * rs, v0.w * rs); w.y = pk4_fp8(v1.x * rs, v1.y * rs, v1.z * rs, v1.w * rs); *(u32x2*)(va + (size_t)row * 1024 + (col - 1024)) = w; }
        })
    }
};
__device__ __forceinline__ void row_phase_stats(Frame& F) {
    F.refresh();
    unsigned char* cq = F.ws + WS_CQ; const unsigned char* ckv = F.ws + WS_CKV; float* rstd = (float*)(F.ws + WS_RSTD);
    const int row0 = F.bid * 128;
#pragma unroll 1
    for (int hb = 0; hb < 2; ++hb) {
        unsigned wq[8][2]; unsigned wk2[8];
#pragma unroll
        for (int i = 0; i < 8; ++i) { const int row = row0 + F.wave + NWAVES * (hb * 8 + i); unsigned* p = (unsigned*)(cq + (size_t)row * 512) + F.lane;
            wq[i][0] = p[0]; wq[i][1] = (F.lane < 32) ? p[64] : 0u;
            if (F.lane >= 32) p[64] = 0u;
            wk2[i] = *((const unsigned*)(ckv + (size_t)row * 256) + F.lane); }
#pragma unroll
        for (int i = 0; i < 8; ++i) { const int row = row0 + F.wave + NWAVES * (hb * 8 + i);
            float s = 0.f;
#pragma unroll
            for (int j = 0; j < 2; ++j) { const f32x2 a = __builtin_amdgcn_cvt_pk_f32_fp8(wq[i][j], false), b = __builtin_amdgcn_cvt_pk_f32_fp8(wq[i][j], true); s += (a.x * a.x + a.y * a.y) + (b.x * b.x + b.y * b.y); }
            const f32x2 k0 = __builtin_amdgcn_cvt_pk_f32_fp8(wk2[i], false), k1 = __builtin_amdgcn_cvt_pk_f32_fp8(wk2[i], true);
            float s2 = (k0.x * k0.x + k0.y * k0.y) + (k1.x * k1.x + k1.y * k1.y);
            s = wave_sum(s); s2 = wave_sum(s2);
            if (F.lane == 0) { rstd[row] = rsqrtf(s * (1.f / 384.f) + EPS); rstd[T + row] = rsqrtf(s2 * (1.f / 256.f) + EPS); } }
    }
}
struct MergeOrder {
    static constexpr bool GATHER = false, F8 = true; static constexpr int scaleA = 127, scaleB = W8_E8M0;
    const unsigned char* ws; int G, c, K, lda, ldb, pass0;
    __device__ __forceinline__ bool next(int i, pg8::Unit& u) const { const int npass = 4 - pass0, j = i / npass, L = j * G + c; if (L >= 512) return false; pg8::tile_of(L, 128, 4, u.pm, u.pn); u.aux = pass0 + i % npass; return true; }
    __device__ __forceinline__ const char* abase(const pg8::Unit& u) const { const size_t off = (u.aux == 1) ? WS_S(0) + 32 * MiB : (u.aux == 3) ? WS_S(3) : WS_S(0); return (const char*)ws + off + (size_t)u.pm * 256 * 1024; }
    __device__ __forceinline__ const char* bbase(const pg8::Unit& u) const { const size_t off = (u.aux == 0) ? W_GM : (u.aux == 1) ? W_M : (u.aux == 2) ? W_GA : W_A; return (const char*)ws + WS_W + off + (size_t)u.pn * 256 * 1024; }
    __device__ __forceinline__ unsigned arow(const pg8::Unit&, int r) const { return (unsigned)r; }
};
struct EpiMerge {
    static constexpr bool PERM = true, STATE = true;
    unsigned char* ws; int has_t;
    __device__ __forceinline__ void operator()(const f32x4 (&acc)[2][2][4][2], const pg8::Unit& u, int wr, int wc, int fr, int fq, unsigned (&st)[32]) const {
        bf16_t* t2 = (bf16_t*)(ws + WS_S(2));
        const int pass = u.aux;
#pragma unroll
        for (int ah = 0; ah < 4; ++ah) { const int ai = ah >> 1;
            u32x4 tv[4][2];
            if (pass == 3 && has_t) {
#pragma unroll
                for (int m = 2 * (ah & 1); m < 2 * (ah & 1) + 2; ++m)
#pragma unroll
                    for (int bj = 0; bj < 2; ++bj) tv[m][bj] = *(const u32x4*)(t2 + (size_t)(u.pm * 256 + ai * 128 + wr * 64 + m * 16 + fr) * 1024 + u.pn * 256 + bj * 128 + wc * 32 + 8 * fq);
            }
#pragma unroll
            for (int m = 2 * (ah & 1); m < 2 * (ah & 1) + 2; ++m) { asm volatile("" ::: "memory"); const int row = u.pm * 256 + ai * 128 + wr * 64 + m * 16 + fr;
#pragma unroll
                for (int bj = 0; bj < 2; ++bj) { const int col = u.pn * 256 + bj * 128 + wc * 32 + 8 * fq; const size_t o = (size_t)row * 1024 + col; const int si = ((ai * 4 + m) * 2 + bj) * 2;
                    f32x4 a0 = acc[ai][bj][m][0], a1 = acc[ai][bj][m][1];
                    if (pass == 0 || pass == 2) {
                        st[si] = pk4_fp8(sigmoidf_(a0.x), sigmoidf_(a0.y), sigmoidf_(a0.z), sigmoidf_(a0.w)); st[si + 1] = pk4_fp8(sigmoidf_(a1.x), sigmoidf_(a1.y), sigmoidf_(a1.z), sigmoidf_(a1.w));
                    } else {
                        const f32x2 g0 = __builtin_amdgcn_cvt_pk_f32_fp8(st[si], false), g1 = __builtin_amdgcn_cvt_pk_f32_fp8(st[si], true), g2 = __builtin_amdgcn_cvt_pk_f32_fp8(st[si + 1], false), g3 = __builtin_amdgcn_cvt_pk_f32_fp8(st[si + 1], true);
                        a0.x *= g0.x; a0.y *= g0.y; a0.z *= g1.x; a0.w *= g1.y; a1.x *= g2.x; a1.y *= g2.y; a1.z *= g3.x; a1.w *= g3.y;
                        if (pass == 1) { u32x4 w; w.x = cvt_pk_bf16(a0.x, a0.y); w.y = cvt_pk_bf16(a0.z, a0.w); w.z = cvt_pk_bf16(a1.x, a1.y); w.w = cvt_pk_bf16(a1.z, a1.w); *(u32x4*)(t2 + o) = w; }
                        else { if (has_t) { const u32x4 tt = tv[m][bj];
                                a0.x += bf_lo(tt.x); a0.y += bf_hi(tt.x); a0.z += bf_lo(tt.y); a0.w += bf_hi(tt.y); a1.x += bf_lo(tt.z); a1.y += bf_hi(tt.z); a1.z += bf_lo(tt.w); a1.w += bf_hi(tt.w); }
                            u32x2 w8; w8.x = pk4_fp8(a0.x, a0.y, a0.z, a0.w); w8.y = pk4_fp8(a1.x, a1.y, a1.z, a1.w); *(u32x2*)(ws + WS_S(5) + o) = w8; }
                    }
                } }
        }
    }
};
struct EpiOut {
    static constexpr bool PERM = true, STATE = false;
    const float* xin32; const bf16_t* xin16; bf16_t* xo; const float* gate; bool do_store;
    __device__ __forceinline__ void operator()(const f32x4 (&acc)[2][2][4][2], const pg8::Unit& u, int wr, int wc, int fr, int fq) const {
        const float* g = gate + (size_t)((u.pm * 256) / SEQ) * 6144;
        f32x4 gv[2][2];
#pragma unroll
        for (int bj = 0; bj < 2; ++bj) { const int col = u.pn * 256 + bj * 128 + wc * 32 + 8 * fq; gv[bj][0] = *(const f32x4*)(g + col); gv[bj][1] = *(const f32x4*)(g + col + 4); }
#pragma unroll
        for (int ai = 0; ai < 2; ++ai) {
            asm volatile("" ::: "memory");
            if (xin32) {
#pragma unroll
                for (int mp = 0; mp < 2; ++mp) {
                    f32x4 xr[2][2][2];
#pragma unroll
                    for (int mm = 0; mm < 2; ++mm)
#pragma unroll
                        for (int bj = 0; bj < 2; ++bj) { const int row = u.pm * 256 + ai * 128 + wr * 64 + (mp * 2 + mm) * 16 + fr, col = u.pn * 256 + bj * 128 + wc * 32 + 8 * fq; const size_t o = (size_t)row * 1024 + col;
                            xr[mm][bj][0] = *(const f32x4*)(xin32 + o); xr[mm][bj][1] = *(const f32x4*)(xin32 + o + 4); }
#pragma unroll
                    for (int mm = 0; mm < 2; ++mm)
#pragma unroll
                        for (int bj = 0; bj < 2; ++bj) { const int m = mp * 2 + mm; const int row = u.pm * 256 + ai * 128 + wr * 64 + m * 16 + fr, col = u.pn * 256 + bj * 128 + wc * 32 + 8 * fq; const size_t o = (size_t)row * 1024 + col;
                            const f32x4 x0 = xr[mm][bj][0] + gv[bj][0] * acc[ai][bj][m][0], x1 = xr[mm][bj][1] + gv[bj][1] * acc[ai][bj][m][1];
                            u32x4 w; w.x = cvt_pk_bf16(x0.x, x0.y); w.y = cvt_pk_bf16(x0.z, x0.w); w.z = cvt_pk_bf16(x1.x, x1.y); w.w = cvt_pk_bf16(x1.z, x1.w);
                            if (do_store) *(u32x4*)(xo + o) = w; else asm volatile("" :: "v"(w)); }
                    asm volatile("" ::: "memory");
                }
            } else {
                u32x4 xr[4][2];
#pragma unroll
                for (int m = 0; m < 4; ++m)
#pragma unroll
                    for (int bj = 0; bj < 2; ++bj) { const int row = u.pm * 256 + ai * 128 + wr * 64 + m * 16 + fr, col = u.pn * 256 + bj * 128 + wc * 32 + 8 * fq; xr[m][bj] = *(const u32x4*)(xin16 + (size_t)row * 1024 + col); }
#pragma unroll
                for (int m = 0; m < 4; ++m)
#pragma unroll
                    for (int bj = 0; bj < 2; ++bj) { const int row = u.pm * 256 + ai * 128 + wr * 64 + m * 16 + fr, col = u.pn * 256 + bj * 128 + wc * 32 + 8 * fq; const size_t o = (size_t)row * 1024 + col; const u32x4 t = xr[m][bj];
                        f32x4 x0 = {bf_lo(t.x), bf_hi(t.x), bf_lo(t.y), bf_hi(t.y)}, x1 = {bf_lo(t.z), bf_hi(t.z), bf_lo(t.w), bf_hi(t.w)};
                        x0 = x0 + gv[bj][0] * acc[ai][bj][m][0]; x1 = x1 + gv[bj][1] * acc[ai][bj][m][1];
                        u32x4 w; w.x = cvt_pk_bf16(x0.x, x0.y); w.y = cvt_pk_bf16(x0.z, x0.w); w.z = cvt_pk_bf16(x1.x, x1.y); w.w = cvt_pk_bf16(x1.z, x1.w);
                        if (do_store) *(u32x4*)(xo + o) = w; else asm volatile("" :: "v"(w)); }
            }
        }
    }
};


namespace att {
constexpr int KVBLK = 64;
constexpr float SCALE = 0.07216878364870322f;
constexpr float THR = 2.5f;
constexpr int P8_E8M0 = 127 - 5;
constexpr int SHM_V = 64 * 128, SHM_K = 64 * 192, OFF_K = 3 * SHM_V, OFF_WS = OFF_K + 3 * SHM_K;
static_assert(OFF_WS + 2048 <= 90112, "attention LDS layout");
#define KSWZ(row, colB) ((row) * 384 + ((colB) ^ (((row) & 7) << 4)))
#define SBAR() __builtin_amdgcn_sched_barrier(0)
__device__ __forceinline__ int crow(int r, int hi) { return (r & 3) + 8 * (r >> 2) + 4 * hi; }
__device__ __forceinline__ void partialSM(f32x16& p0, f32x16& p1, float& m_reg, float& mn, float& alpha, bool vis) {
  constexpr float C = SCALE * 1.4426950408889634f;
  float pmax = p0[0];
#pragma unroll
  for (int r = 1; r < 16; ++r) pmax = fmaxf(pmax, p0[r]);
#pragma unroll
  for (int r = 0; r < 16; ++r) pmax = fmaxf(pmax, p1[r]);
  { auto rr = __builtin_amdgcn_permlane32_swap(__float_as_uint(pmax), __float_as_uint(pmax), false, false);
    pmax = fmaxf(__uint_as_float(rr[0]), __uint_as_float(rr[1])); }
  pmax = vis ? pmax : -1e30f;
  if (__builtin_expect(__all(pmax - m_reg <= THR / SCALE), 1)) { mn = m_reg; alpha = 1.f; }
  else { mn = fmaxf(m_reg, pmax); alpha = __builtin_amdgcn_exp2f((m_reg - mn) * C); m_reg = mn; }
  const float mnC = vis ? 5.f - mn * C : -1e30f;
#pragma unroll
  for (int r = 0; r < 16; ++r) p0[r] = fmaf(p0[r], C, mnC);
#pragma unroll
  for (int r = 0; r < 16; ++r) p1[r] = fmaf(p1[r], C, mnC);
#pragma unroll
  for (int r = 0; r < 16; ++r) p0[r] = __builtin_amdgcn_exp2f(p0[r]);
}
__device__ __forceinline__ void finishSM(f32x16& p0, f32x16& p1, float alpha, float& l_reg, i32x8& P8) {
#pragma unroll
  for (int r = 0; r < 16; ++r) p1[r] = __builtin_amdgcn_exp2f(p1[r]);
  float ps = 0;
#pragma unroll
  for (int r = 0; r < 16; ++r) ps += p0[r];
#pragma unroll
  for (int r = 0; r < 16; ++r) ps += p1[r];
  { auto rr = __builtin_amdgcn_permlane32_swap(__float_as_uint(ps), __float_as_uint(ps), false, false);
    ps = __uint_as_float(rr[0]) + __uint_as_float(rr[1]); }
  l_reg = l_reg * alpha + ps * 0.03125f;
#pragma unroll
  for (int w = 0; w < 4; ++w) { P8[w] = (int)pk4_fp8(p0[4 * w], p0[4 * w + 1], p0[4 * w + 2], p0[4 * w + 3]); P8[4 + w] = (int)pk4_fp8(p1[4 * w], p1[4 * w + 1], p1[4 * w + 2], p1[4 * w + 3]); }
}
__device__ __forceinline__ void qkt(f32x16& p0, f32x16& p1, const char* Ks, const i32x8* qf, int kb0, int kb1) {
#pragma unroll
  for (int r = 0; r < 16; ++r) { p0[r] = 0.f; p1[r] = 0.f; }
#pragma unroll
  for (int st = 0; st < 3; ++st) {
    const u32x4 a0 = *reinterpret_cast<const u32x4*>(Ks + kb0 + st * 64), a1 = *reinterpret_cast<const u32x4*>(Ks + kb1 + st * 64);
    const u32x4 b0 = *reinterpret_cast<const u32x4*>(Ks + 6144 + kb0 + st * 64), b1 = *reinterpret_cast<const u32x4*>(Ks + 6144 + kb1 + st * 64);
    const i32x8 ka = {(int)a0.x, (int)a0.y, (int)a0.z, (int)a0.w, (int)a1.x, (int)a1.y, (int)a1.z, (int)a1.w}, kb = {(int)b0.x, (int)b0.y, (int)b0.z, (int)b0.w, (int)b1.x, (int)b1.y, (int)b1.z, (int)b1.w};
    p0 = __builtin_amdgcn_mfma_scale_f32_32x32x64_f8f6f4(ka, qf[st], p0, 0, 0, 0, 127, 0, 127);
    p1 = __builtin_amdgcn_mfma_scale_f32_32x32x64_f8f6f4(kb, qf[st], p1, 0, 0, 0, 127, 0, 127); }
}
__device__ __forceinline__ int v_st(int k, int c) { const int kk = (k & ~0xC) | ((k & 4) << 1) | ((k & 8) >> 1); return ((kk >> 3) * 4 + (c >> 5)) * 512 + ((kk & 7) * 32 + (c & 31)) * 2; }
__device__ __forceinline__ int v_rd_base(int lane) { return ((lane & 3) << 3) | (((lane >> 2) & 3) << 6) | (((lane >> 4) & 1) << 5) | (((lane >> 5) & 1) << 8); }
constexpr int v_rd_off(int d0, int ks, int half) { return d0 * 512 + ks * 4096 + half * 2048; }
template <int OFF> __device__ __forceinline__ s16x4 tr_read(int vb) {
  s16x4 r; asm volatile("ds_read_b64_tr_b16 %0, %1 offset:%2" : "=&v"(r) : "v"(vb), "i"(OFF) : "memory"); return r;
}
template <int D0> __device__ __forceinline__ void pv_one(f32x16& od, int vb, bf16x8 pa0, bf16x8 pa1, bf16x8 pa2, bf16x8 pa3) {
  const s16x4 l0 = tr_read<v_rd_off(D0, 0, 0)>(vb), h0 = tr_read<v_rd_off(D0, 0, 1)>(vb), l1 = tr_read<v_rd_off(D0, 1, 0)>(vb), h1 = tr_read<v_rd_off(D0, 1, 1)>(vb);
  const s16x4 l2 = tr_read<v_rd_off(D0, 2, 0)>(vb), h2 = tr_read<v_rd_off(D0, 2, 1)>(vb), l3 = tr_read<v_rd_off(D0, 3, 0)>(vb), h3 = tr_read<v_rd_off(D0, 3, 1)>(vb);
  asm volatile("s_waitcnt lgkmcnt(0)" ::: "memory"); SBAR();
#define PK(L, H) (bf16x8){L[0], L[1], L[2], L[3], H[0], H[1], H[2], H[3]}
  od = __builtin_amdgcn_mfma_f32_32x32x16_bf16(pa0, PK(l0, h0), od, 0, 0, 0);
  od = __builtin_amdgcn_mfma_f32_32x32x16_bf16(pa1, PK(l1, h1), od, 0, 0, 0);
  od = __builtin_amdgcn_mfma_f32_32x32x16_bf16(pa2, PK(l2, h2), od, 0, 0, 0);
  od = __builtin_amdgcn_mfma_f32_32x32x16_bf16(pa3, PK(l3, h3), od, 0, 0, 0);
#undef PK
}
template <int OFF> __device__ __forceinline__ u32x2 tr8_read(int vb) {
  u32x2 r; asm volatile("ds_read_b64_tr_b8 %0, %1 offset:%2" : "=&v"(r) : "v"(vb), "i"(OFF) : "memory"); return r;
}
__device__ __forceinline__ void pv8_one(f32x16& od, int vb, const i32x8& P8) {
  const u32x2 r0 = tr8_read<0>(vb), r1 = tr8_read<2048>(vb), r2 = tr8_read<4096>(vb), r3 = tr8_read<6144>(vb);
  asm volatile("s_waitcnt lgkmcnt(0)" ::: "memory"); SBAR();
  const i32x8 vf = {(int)r0.x, (int)r0.y, (int)r1.x, (int)r1.y, (int)r2.x, (int)r2.y, (int)r3.x, (int)r3.y};
  od = __builtin_amdgcn_mfma_scale_f32_32x32x64_f8f6f4(P8, vf, od, 0, 0, 0, P8_E8M0, 0, 127);
}
__device__ __forceinline__ void pv8(f32x16* o, const int (&vbd)[4], int soff, const i32x8& P8) {
  u32x2 r[4][4];
#pragma unroll
  for (int d = 0; d < 4; ++d) { const int vb = vbd[d] + soff; r[d][0] = tr8_read<0>(vb); r[d][1] = tr8_read<2048>(vb); r[d][2] = tr8_read<4096>(vb); r[d][3] = tr8_read<6144>(vb); }
  asm volatile("s_waitcnt lgkmcnt(0)" ::: "memory"); SBAR();
#pragma unroll
  for (int d = 0; d < 4; ++d) { const i32x8 vf = {(int)r[d][0].x, (int)r[d][0].y, (int)r[d][1].x, (int)r[d][1].y, (int)r[d][2].x, (int)r[d][2].y, (int)r[d][3].x, (int)r[d][3].y};
    o[d] = __builtin_amdgcn_mfma_scale_f32_32x32x64_f8f6f4(P8, vf, o[d], 0, 0, 0, P8_E8M0, 0, 127); }
}
__device__ __forceinline__ void pv_d0(f32x16* o, int vb, bf16x8 pa0, bf16x8 pa1, bf16x8 pa2, bf16x8 pa3) {
  pv_one<0>(o[0], vb, pa0, pa1, pa2, pa3); pv_one<1>(o[1], vb, pa0, pa1, pa2, pa3); pv_one<2>(o[2], vb, pa0, pa1, pa2, pa3); pv_one<3>(o[3], vb, pa0, pa1, pa2, pa3);
}
__device__ __forceinline__ void attn_unit(const unsigned char* __restrict__ Qn, const unsigned char* __restrict__ Qr, const unsigned char* __restrict__ Kn, const unsigned char* __restrict__ Kr, const unsigned char* __restrict__ Vv,
                                          unsigned char* __restrict__ Ob, int qb, char* lds, bool do_store, int wave0) {
  const int tid = tid_opaque(wave0), wid = wave0, lane = tid & 63, r32 = lane & 31, hi = lane >> 5;
  char* V_lds = lds; char* K_lds = lds + OFF_K;
  float* wsf = (float*)(lds + OFF_WS) + wid * 64; float* li_l = wsf; float* al_l = wsf + 32;
  float m_reg = -1e30f, l_reg = 0; f32x16 o[4]; i32x8 qf[3];
#pragma unroll
  for (int d = 0; d < 4; ++d)
#pragma unroll
    for (int r = 0; r < 16; ++r) o[d][r] = 0.f;
  { const unsigned char* Qw = Qn + (size_t)(wid * 32 + r32) * 1024 + hi * 32; const unsigned char* Qw2 = Qr + (size_t)(wid * 32 + r32) * 512 + hi * 32;
#pragma unroll
    for (int st = 0; st < 3; ++st) { const unsigned char* p = (st < 2) ? Qw + st * 64 : Qw2; const u32x4 x0 = *reinterpret_cast<const u32x4*>(p), x1 = *reinterpret_cast<const u32x4*>(p + 16);
      qf[st] = (i32x8){(int)x0.x, (int)x0.y, (int)x0.z, (int)x0.w, (int)x1.x, (int)x1.y, (int)x1.z, (int)x1.w}; } }
  const int NT = 4 * qb + 4, myq = 4 * qb + (wid >> 1);
  const int krow = tid >> 3, kc = tid & 7, ksw = (krow >> 2) & 3;
  const int vst0 = krow * 128 + ((kc ^ (2 * (((krow >> 1) & 1) | (((krow >> 3) & 1) << 1)))) << 4);
  const int kst0 = krow * 192 + ((kc ^ ksw) * 16), kst2 = krow * 192 + ((8 + ((kc & 3) ^ ksw)) * 16);
  int vbd[4];
  { const int g = lane >> 4, ll = lane & 15, jj = ll >> 1, cc = ll & 1, kr_l = 4 * (g >> 1) + (jj < 4 ? jj : jj + 4), fl = ((kr_l >> 1) & 1) | (((kr_l >> 3) & 1) << 1);
#pragma unroll
    for (int d = 0; d < 4; ++d) vbd[d] = (int)(uintptr_t)V_lds + kr_l * 128 + ((2 * (d ^ fl) + (g & 1)) << 4) + 8 * cc; }
  const int qsw = (r32 >> 2) & 3, kb0 = r32 * 192 + (((2 * hi) ^ qsw) * 16), kb1 = r32 * 192 + (((2 * hi + 1) ^ qsw) * 16);
  u32x4 vs0, ks0, ks2;
  const unsigned voV = (unsigned)(krow * 1024 + kc * 16), voK = (unsigned)(krow * 1024 + kc * 16), voR = (unsigned)(krow * 64 + (kc & 3) * 16);
#define SLOAD(k0) do { const char* vb_ = (const char*)(Vv + (size_t)(k0) * 1024); const char* kb_ = (const char*)(Kn + (size_t)(k0) * 1024); const char* rb_ = (const char*)(Kr + (size_t)(k0) * 64); \
    vs0 = *reinterpret_cast<const u32x4*>(vb_ + voV); \
    ks0 = *reinterpret_cast<const u32x4*>(kb_ + voK); ks2 = *reinterpret_cast<const u32x4*>(rb_ + voR); } while (0)
#define SWRITE(b) do { *(u32x4*)(V_lds + (b) * SHM_V + vst0) = vs0; \
    *(u32x4*)(K_lds + (b) * SHM_K + kst0) = ks0; if (kc < 4) *(u32x4*)(K_lds + (b) * SHM_K + kst2) = ks2; } while (0)
#define RESC(a) do { if (__any((a) < 1.f)) { if (hi == 0) al_l[r32] = (a); asm volatile("s_waitcnt lgkmcnt(0)" ::: "memory"); \
    _Pragma("unroll") for (int d = 0; d < 4; ++d) _Pragma("unroll") for (int r = 0; r < 16; ++r) o[d][r] *= al_l[crow(r, hi)]; } } while (0)
  f32x16 pA0, pA1, pB0, pB1; float mnA, mnB, alA, alB; i32x8 P8;
  const int lastk = (NT - 1) * KVBLK;
#define TILE_K0(t) (((t) < NT ? (t) : NT - 1) * KVBLK)
  SLOAD(0); SWRITE(0); SLOAD(KVBLK); __syncthreads();
  qkt(pA0, pA1, K_lds, qf, kb0, kb1); partialSM(pA0, pA1, m_reg, mnA, alA, true);
  SWRITE(1); SLOAD(TILE_K0(2)); __syncthreads();
  int b0 = 0, b1 = 1, b2 = 2;
  for (int j = 1; j + 1 < NT; j += 2) {
    SBAR(); qkt(pB0, pB1, K_lds + b1 * SHM_K, qf, kb0, kb1);
    finishSM(pA0, pA1, alA, l_reg, P8); SBAR();
    pv8(o, vbd, b0 * SHM_V, P8);
    partialSM(pB0, pB1, m_reg, mnB, alB, j <= myq);
    SWRITE(b2); SLOAD(TILE_K0(j + 2));
    RESC(alB); __syncthreads();
    SBAR(); qkt(pA0, pA1, K_lds + b2 * SHM_K, qf, kb0, kb1);
    finishSM(pB0, pB1, alB, l_reg, P8); SBAR();
    pv8(o, vbd, b1 * SHM_V, P8);
    partialSM(pA0, pA1, m_reg, mnA, alA, j + 1 <= myq);
    SWRITE(b0); SLOAD(TILE_K0(j + 3));
    RESC(alA); __syncthreads();
    { const int t0 = b0; b0 = b2; b2 = b1; b1 = t0; }
  }
  (void)lastk;
  SBAR(); qkt(pB0, pB1, K_lds + b1 * SHM_K, qf, kb0, kb1);
  finishSM(pA0, pA1, alA, l_reg, P8); SBAR();
  pv8(o, vbd, b0 * SHM_V, P8);
  partialSM(pB0, pB1, m_reg, mnB, alB, NT - 1 <= myq);
  RESC(alB);
  finishSM(pB0, pB1, alB, l_reg, P8); SBAR();
  pv8(o, vbd, b1 * SHM_V, P8);
#undef TILE_K0
  if (hi == 0) li_l[r32] = l_reg; asm volatile("s_waitcnt lgkmcnt(0)" ::: "memory");
  { char* Os = lds + 90112 + wid * 4096;
#pragma unroll
    for (int r = 0; r < 16; ++r) { const int orow = crow(r, hi); const float rl = __builtin_amdgcn_rcpf(li_l[orow]);
#pragma unroll
      for (int d0 = 0; d0 < 4; ++d0) { const float x = o[d0][r] * rl; *(unsigned char*)(Os + orow * 128 + d0 * 32 + r32) = (unsigned char)(__builtin_amdgcn_cvt_pk_fp8_f32(x, x, 0, false) & 0xff); } }
    asm volatile("s_waitcnt lgkmcnt(0)" ::: "memory");
    unsigned char* Ow = Ob + (size_t)(wid * 32) * 1024;
#pragma unroll
    for (int k = 0; k < 4; ++k) { const int ch = lane + 64 * k, row = ch >> 3, c16 = ch & 7; const u32x4 v = *(const u32x4*)(Os + row * 128 + c16 * 16);
      if (do_store) *(u32x4*)(Ow + (size_t)row * 1024 + c16 * 16) = v; else asm volatile("" :: "v"(v)); } }
  __syncthreads();
#undef SLOAD
#undef SWRITE
#undef SWAIT
#undef RESC
}
}
constexpr int NBH = 16, NCH = 128;
__device__ __forceinline__ float wave_incl_sum(float v, int lane) {
#pragma unroll
    for (int o = 1; o < 64; o <<= 1) { const float t = __int_as_float(__builtin_amdgcn_ds_bpermute((lane - o) << 2, __float_as_int(v))); if (lane >= o) v += t; }
    return v;
}
__device__ __forceinline__ float wave_incl_max(float v, int lane) {
#pragma unroll
    for (int o = 1; o < 64; o <<= 1) { const float t = __int_as_float(__builtin_amdgcn_ds_bpermute((lane - o) << 2, __float_as_int(v))); if (lane >= o) v = fmaxf(v, t); }
    return v;
}
__device__ __forceinline__ void conv_table(LAS float* cwl, const float* cw, const float* cb, int tid) {
    float t[10];
#pragma unroll
    for (int q = 0; q < 8; ++q) t[q] = cw[tid + NTHREADS * q];
#pragma unroll
    for (int q = 0; q < 2; ++q) t[8 + q] = cb[tid + NTHREADS * q];
#pragma unroll
    for (int q = 0; q < 8; ++q) cwl[tid + NTHREADS * q] = t[q];
#pragma unroll
    for (int q = 0; q < 2; ++q) cwl[4096 + tid + NTHREADS * q] = t[8 + q];
}
__device__ __forceinline__ void conv8(const u32x4 (&x)[4], int s_abs, const LAS float* cwl, int ch, float scale, float (&out)[8]) {
    float acc[8];
    { const f32x4 b0 = *(const LAS f32x4*)(cwl + 4096 + ch), b1 = *(const LAS f32x4*)(cwl + 4096 + ch + 4); acc[0] = b0.x; acc[1] = b0.y; acc[2] = b0.z; acc[3] = b0.w; acc[4] = b1.x; acc[5] = b1.y; acc[6] = b1.z; acc[7] = b1.w; }
#pragma unroll
    for (int j = 0; j < 4; ++j) {
        const float m = (s_abs - 3 + j >= 0) ? 1.f : 0.f;
        const f32x4 w0 = *(const LAS f32x4*)(cwl + j * 1024 + ch) * m, w1 = *(const LAS f32x4*)(cwl + j * 1024 + ch + 4) * m;
        acc[0] += w0.x * bf_lo(x[j].x); acc[1] += w0.y * bf_hi(x[j].x); acc[2] += w0.z * bf_lo(x[j].y); acc[3] += w0.w * bf_hi(x[j].y);
        acc[4] += w1.x * bf_lo(x[j].z); acc[5] += w1.y * bf_hi(x[j].z); acc[6] += w1.z * bf_lo(x[j].w); acc[7] += w1.w * bf_hi(x[j].w);
    }
#pragma unroll
    for (int i = 0; i < 8; ++i) out[i] = siluf_(acc[i]) * scale;
}
__device__ __forceinline__ void conv_load(const bf16_t* raw, int s_abs, u32x4 (&x)[4]) {
#pragma unroll
    for (int j = 0; j < 4; ++j) x[j] = *(const u32x4*)(raw + (ptrdiff_t)((s_abs - 3 + j >= 0) ? (j - 3) : 0) * 1024);
}
#define KSW256(row, colB) ((row) * 256 + ((colB) ^ (((row) & 7) << 4)))
#define CSW256(row, colB) ((row) * 256 + ((colB) ^ (((row) & 15) << 4)))
__device__ __forceinline__ void attn_phase(Frame& F, bool do_store) {
    const unsigned char* qn = F.ws + WS_S(1); const unsigned char* qr = F.ws + WS_S(2); const unsigned char* kn = F.ws + WS_S(4); const unsigned char* va = F.ws + WS_S(5);
    const unsigned char* kr = F.ws + WS_KR;
    const int vcu = (F.G % 8 == 0) ? (F.bid % 8) * (F.G / 8) + F.bid / 8 : F.bid;
    for (int it = 0; it < 4; ++it) {
        const int P = vcu + (it >> 1) * F.G; if (P >= 512) break;
        const int bh = P >> 4, i = P & 15, qb = (it & 1) ? i : 31 - i, b = bh >> 3, h = bh & 7;
        const size_t row0 = (size_t)b * SEQ + (size_t)qb * 256, key0 = (size_t)b * SEQ;
        att::attn_unit(qn + row0 * 1024 + h * 128, qr + row0 * 512 + h * 64, kn + key0 * 1024 + h * 128, kr + key0 * 64, va + key0 * 1024 + h * 128, F.ws + WS_S(3) + row0 * 1024 + h * 128, qb, (char*)F.lds, do_store, F.wave);
    }
}


constexpr int NGRP = 16, GCH = 8;
__device__ __forceinline__ void mlstm_gates_local(Frame& F, int l) {
    F.refresh();
    ArgP a = argp();
    const float* ifg = (const float*)(F.ws + WS_IFG); float* GT = (float*)(F.ws + WS_GATE); float* CH = (float*)(F.ws + WS_CHK);
    for (int gw = F.bid * NWAVES + F.wave; gw < NBH * NCH; gw += F.G * NWAVES) {
        const int bh = gw >> 7, c = gw & 127, b = bh >> 2, h = bh & 3, s = c * 64 + F.lane; const size_t t = (size_t)b * SEQ + s;
        const float li = ifg[t * 8 + h] + GIN(a, I_IGB)[l * 4 + h], x = ifg[t * 8 + 4 + h] + GIN(a, I_FGB)[l * 4 + h];
        const float lf = fminf(x, 0.f) - log1pf(__expf(-fabsf(x)));
        const float bc = wave_incl_sum(lf, F.lane), ct = li - bc, pm = wave_incl_max(ct, F.lane);
        GT[(size_t)bh * SEQ + s] = bc; GT[(size_t)(NBH + bh) * SEQ + s] = ct; GT[(size_t)(2 * NBH + bh) * SEQ + s] = pm;
        if (F.lane == 63) { CH[bh * NCH + c] = bc; CH[2048 + bh * NCH + c] = bc + pm; }
    }
}
__device__ __forceinline__ void mlstm_mtab(LAS float* mt, const float* CH, int bh, int tid) {
    if (tid < 64) {
        const int lane = tid;
        const float a0 = CH[bh * NCH + 2 * lane], b0 = CH[2048 + bh * NCH + 2 * lane], a1 = CH[bh * NCH + 2 * lane + 1], b1 = CH[2048 + bh * NCH + 2 * lane + 1];
        float A = a0 + a1, B = fmaxf(b0 + a1, b1);
#pragma unroll
        for (int o = 1; o < 64; o <<= 1) {
            const float Ap = __int_as_float(__builtin_amdgcn_ds_bpermute((lane - o) << 2, __float_as_int(A))), Bp = __int_as_float(__builtin_amdgcn_ds_bpermute((lane - o) << 2, __float_as_int(B)));
            if (lane >= o) { B = fmaxf(Bp + A, B); A = Ap + A; }
        }
        const float Ae = __int_as_float(__builtin_amdgcn_ds_bpermute((lane - 1) << 2, __float_as_int(A))), Be = __int_as_float(__builtin_amdgcn_ds_bpermute((lane - 1) << 2, __float_as_int(B)));
        const float m0 = (lane == 0) ? 0.f : fmaxf(Ae, Be), m1 = fmaxf(a0 + m0, b0), m2 = fmaxf(a1 + m1, b1);
        mt[2 * lane] = m0; mt[128 + 2 * lane] = m1; mt[256 + 2 * lane] = __expf(a0 + m0 - m1);
        mt[2 * lane + 1] = m1; mt[128 + 2 * lane + 1] = m2; mt[256 + 2 * lane + 1] = __expf(a1 + m1 - m2);
    }
}
#define PK8(L, H) (bf16x8){L[0], L[1], L[2], L[3], H[0], H[1], H[2], H[3]}
__device__ __forceinline__ void mlstm_group_state(Frame& F, int l) {
    F.refresh();
    ArgP a = argp();
    char* lds = (char*)F.lds; char* Vimg = lds; char* KWimg = lds + 32768; char* Ut = lds + 49152;
    LAS float* gx = (LAS float*)(F.lds + LDSX_OFF); LAS float* mt = gx + 704; LAS float* cwl = (LAS float*)(F.lds + LDSX_OFF + 4608); LAS float* npart = (LAS float*)(F.lds + LDSX_OFF + 25088);
    const bf16_t* qk = (const bf16_t*)(F.ws + WS_S(1)); const bf16_t* vm = (const bf16_t*)(F.ws + WS_S(2)); bf16_t* Gs = (bf16_t*)(F.ws + WS_S(4));
    const float* GT = (const float*)(F.ws + WS_GATE); const float* CH = (const float*)(F.ws + WS_CHK); float* Dg = (float*)(F.ws + WS_CHK + 16384); float* gn = (float*)(F.ws + WS_CHK + 32768);
    const int tid = F.tid, lane = F.lane, wid = F.wave, r32 = lane & 31, hi = lane >> 5;
    bf16_t* kcv = (bf16_t*)GOUT(a) + (size_t)T * 1024;
    conv_table(cwl, GIN(a, I_CONVW) + (size_t)l * 4096, GIN(a, I_CONVB) + (size_t)l * 1024, tid);
    for (int u = F.bid; u < NBH * NGRP; u += F.G) {
        const int bh = u >> 4, g = u & 15, b = bh >> 2, h = bh & 3;
        bf16x8 xv[4]; u32x4 xk[2][4]; float gch, gct;
#define GA_LOADS(cidx) do { const int sr_ = tid >> 4, sc_ = (tid & 15) * 8, srow_ = tid >> 3; const size_t tk_ = (size_t)b * SEQ + (size_t)(cidx) * 64; \
            _Pragma("unroll") for (int img = 0; img < 2; ++img) _Pragma("unroll") for (int hf = 0; hf < 2; ++hf) xv[img * 2 + hf] = *(const bf16x8*)(vm + (tk_ + sr_ + 32 * hf) * 1024 + h * 256 + img * 128 + sc_); \
            _Pragma("unroll") for (int hf = 0; hf < 2; ++hf) conv_load(qk + (tk_ + srow_) * 1024 + 512 + h * 128 + (tid & 7) * 8 + 64 * hf, (cidx) * 64 + srow_, xk[hf]); \
            gch = CH[bh * NCH + (cidx)]; gct = GT[(size_t)(NBH + bh) * SEQ + (cidx) * 64 + srow_]; } while (0)
        GA_LOADS(g * GCH);
        __syncthreads();
        mlstm_mtab(mt, CH, bh, tid);
        __syncthreads();
        f32x16 acc[4]; float nacc = 0.f, dprod = 1.f;
#pragma unroll
        for (int j = 0; j < 4; ++j)
#pragma unroll
            for (int r = 0; r < 16; ++r) acc[j][r] = 0.f;
#pragma unroll 1
        for (int cc = 0; cc < GCH; ++cc) {
            const int c = g * GCH + cc;
            { const int sr = tid >> 4, sc = (tid & 15) * 8, srow = tid >> 3;
              const float wk = __expf(gch + gct - mt[128 + c]);
#pragma unroll
              for (int img = 0; img < 2; ++img)
#pragma unroll
                for (int hf = 0; hf < 2; ++hf) *(bf16x8*)(Vimg + img * 16384 + att::v_st(sr + 32 * hf, sc)) = xv[img * 2 + hf];
#pragma unroll
              for (int hf = 0; hf < 2; ++hf) { const int d = (tid & 7) * 8 + 64 * hf; float o[8];
                conv8(xk[hf], c * 64 + srow, cwl, 512 + h * 128 + d, 1.f, o);
                u32x4 w; w.x = cvt_pk_bf16(o[0], o[1]); w.y = cvt_pk_bf16(o[2], o[3]); w.z = cvt_pk_bf16(o[4], o[5]); w.w = cvt_pk_bf16(o[6], o[7]);
                *(u32x4*)(kcv + ((size_t)b * SEQ + (size_t)c * 64 + srow) * 512 + h * 128 + d) = w;
                w.x = cvt_pk_bf16(o[0] * wk, o[1] * wk); w.y = cvt_pk_bf16(o[2] * wk, o[3] * wk); w.z = cvt_pk_bf16(o[4] * wk, o[5] * wk); w.w = cvt_pk_bf16(o[6] * wk, o[7] * wk);
                *(u32x4*)(KWimg + att::v_st(srow, d)) = w; } }
            __syncthreads();
            { const int cn = (cc + 1 < GCH) ? c + 1 : c; GA_LOADS(cn); }
            const float dec = mt[256 + c];
#pragma unroll
            for (int j = 0; j < 4; ++j)
#pragma unroll
                for (int r = 0; r < 16; ++r) acc[j][r] *= dec;
            { const int vbV = (int)(uintptr_t)(Vimg + (wid >> 2) * 16384) + att::v_rd_base(lane) + (wid & 3) * 512, vbK = (int)(uintptr_t)KWimg + att::v_rd_base(lane);
#define GASTEP(KS) do { \
                const s16x4 al = att::tr_read<att::v_rd_off(0, KS, 0)>(vbV), ah = att::tr_read<att::v_rd_off(0, KS, 1)>(vbV); \
                const s16x4 l0 = att::tr_read<att::v_rd_off(0, KS, 0)>(vbK), h0 = att::tr_read<att::v_rd_off(0, KS, 1)>(vbK), l1 = att::tr_read<att::v_rd_off(1, KS, 0)>(vbK), h1 = att::tr_read<att::v_rd_off(1, KS, 1)>(vbK); \
                const s16x4 l2 = att::tr_read<att::v_rd_off(2, KS, 0)>(vbK), h2 = att::tr_read<att::v_rd_off(2, KS, 1)>(vbK), l3 = att::tr_read<att::v_rd_off(3, KS, 0)>(vbK), h3 = att::tr_read<att::v_rd_off(3, KS, 1)>(vbK); \
                asm volatile("s_waitcnt lgkmcnt(0)" ::: "memory"); SBAR(); \
                const bf16x8 af = PK8(al, ah); \
                acc[0] = __builtin_amdgcn_mfma_f32_32x32x16_bf16(af, PK8(l0, h0), acc[0], 0, 0, 0); acc[1] = __builtin_amdgcn_mfma_f32_32x32x16_bf16(af, PK8(l1, h1), acc[1], 0, 0, 0); \
                acc[2] = __builtin_amdgcn_mfma_f32_32x32x16_bf16(af, PK8(l2, h2), acc[2], 0, 0, 0); acc[3] = __builtin_amdgcn_mfma_f32_32x32x16_bf16(af, PK8(l3, h3), acc[3], 0, 0, 0); } while (0)
              GASTEP(0); GASTEP(1); GASTEP(2); GASTEP(3);
#undef GASTEP
            }
            { float sacc = 0.f; const int dq = tid & 127, kq = (tid >> 7) * 16;
#pragma unroll
              for (int k = 0; k < 16; ++k) sacc += bf1(*(const bf16_t*)(KWimg + att::v_st(kq + k, dq & ~7) + (dq & 7) * 2));
              npart[tid] = sacc; }
            dprod *= dec;
            __syncthreads();
            if (tid < 128) nacc = dec * nacc + ((npart[tid] + npart[128 + tid]) + (npart[256 + tid] + npart[384 + tid]));
        }
#pragma unroll
        for (int j = 0; j < 4; ++j)
#pragma unroll
            for (int r = 0; r < 16; ++r) *(bf16_t*)(Ut + (wid * 32 + att::crow(r, hi)) * 272 + (j * 32 + r32) * 2) = (bf16_t)(cvt_pk_bf16(acc[j][r], 0.f) & 0xffffu);
        if (tid < 128) gn[(size_t)(bh * NGRP + g) * 128 + tid] = nacc;
        if (tid == 0) Dg[bh * NGRP + g] = dprod;
        __syncthreads();
        { bf16_t* Go = Gs + (size_t)(bh * NGRP + g) * 32768;
#pragma unroll
          for (int k = 0; k < 8; ++k) { const int p = tid + 512 * k, row = p >> 4, ck = p & 15; *(u32x4*)(Go + (size_t)row * 128 + ck * 8) = *(const u32x4*)(Ut + row * 272 + ck * 16); } }
    }
}
__device__ __forceinline__ void mlstm_group_scan(Frame& F) {
    F.refresh();
    const float* Dg = (const float*)(F.ws + WS_CHK + 16384);
    for (int gid = F.bid * NTHREADS + F.tid; gid < NBH * 8192; gid += F.G * NTHREADS) {
        const int bh = gid >> 13, e4 = gid & 8191;
        bf16_t* Gs = (bf16_t*)(F.ws + WS_S(4)) + (size_t)bh * NGRP * 32768 + (size_t)e4 * 4;
        u32x2 uu[NGRP];
#pragma unroll
        for (int k = 0; k < NGRP; ++k) uu[k] = *(const u32x2*)(Gs + (size_t)k * 32768);
        float c0 = 0.f, c1 = 0.f, c2 = 0.f, c3 = 0.f; asm volatile("" : "+v"(c0), "+v"(c1), "+v"(c2), "+v"(c3));
#pragma unroll
        for (int k = 0; k < NGRP; ++k) { const float d = Dg[bh * NGRP + k];
            u32x2 o; o.x = cvt_pk_bf16(c0, c1); o.y = cvt_pk_bf16(c2, c3); *(u32x2*)(Gs + (size_t)k * 32768) = o;
            c0 = d * c0 + bf_lo(uu[k].x); c1 = d * c1 + bf_hi(uu[k].x); c2 = d * c2 + bf_lo(uu[k].y); c3 = d * c3 + bf_hi(uu[k].y); }
    }
    { const int gid = F.bid * NTHREADS + F.tid;
      if (gid < NBH * 128) { const int b2 = gid >> 7, d = gid & 127; float* gn = (float*)(F.ws + WS_CHK + 32768) + (size_t)b2 * NGRP * 128 + d;
        float n = 0.f; for (int k = 0; k < NGRP; ++k) { const float uv = gn[k * 128]; gn[k * 128] = n; n = Dg[b2 * NGRP + k] * n + uv; } } }
}
__device__ __forceinline__ void mlstm_group_output(Frame& F, int l) {
    F.refresh();
    ArgP a = argp();
    char* lds = (char*)F.lds; char* Qs = lds; char* Ks = lds + 16384; char* Vimg = lds + 32768; char* Cs = lds + 65536; char* Yt = lds;
    LAS float* gx = (LAS float*)(F.lds + LDSX_OFF);
    LAS float* mt = gx + 704; LAS float* cwl = (LAS float*)(F.lds + LDSX_OFF + 4608); LAS float* npart = (LAS float*)(F.lds + LDSX_OFF + 25088);
    const bf16_t* qk = (const bf16_t*)(F.ws + WS_S(1)); const bf16_t* vm = (const bf16_t*)(F.ws + WS_S(2)); const bf16_t* Gs = (const bf16_t*)(F.ws + WS_S(4)); const bf16_t* so = (const bf16_t*)(F.ws + WS_S(3)); unsigned char* ym8 = F.ws + WS_S(0) + 32 * MiB;
    const float* GT = (const float*)(F.ws + WS_GATE); const float* CH = (const float*)(F.ws + WS_CHK); const float* gn = (const float*)(F.ws + WS_CHK + 32768);
    const int tid0 = F.tid, wid = F.wave;
    const bf16_t* kcv = (const bf16_t*)GOUT(a) + (size_t)T * 1024;
    conv_table(cwl, GIN(a, I_CONVW) + (size_t)l * 4096, GIN(a, I_CONVB) + (size_t)l * 1024, tid0);
    for (int u = F.bid; u < NBH * NGRP; u += F.G) {
        const int bh = u >> 4, g = u & 15, b = bh >> 2, h = bh & 3;
        bf16x8 xv[4]; u32x4 xq[2][4], xk[2]; float gbc, gct, gpm, gch;
#define GB_LOAD_G(cidx) do { int tid_ = tid0; asm volatile("" : "+v"(tid_)); const int t64_ = tid_ & 63; gbc = GT[(size_t)bh * SEQ + (cidx) * 64 + t64_]; gct = GT[(size_t)(NBH + bh) * SEQ + (cidx) * 64 + t64_]; \
            gpm = GT[(size_t)(2 * NBH + bh) * SEQ + (cidx) * 64 + t64_]; gch = CH[bh * NCH + (cidx)]; } while (0)
#define GB_LOAD_V(cidx) do { int tid_ = tid0; asm volatile("" : "+v"(tid_)); const int sr_ = tid_ >> 4, sc_ = (tid_ & 15) * 8; const size_t tk_ = (size_t)b * SEQ + (size_t)(cidx) * 64; \
            _Pragma("unroll") for (int img = 0; img < 2; ++img) _Pragma("unroll") for (int hf = 0; hf < 2; ++hf) xv[img * 2 + hf] = *(const bf16x8*)(vm + (tk_ + sr_ + 32 * hf) * 1024 + h * 256 + img * 128 + sc_); } while (0)
#define GB_LOAD_QK(cidx, dst, off, hf) do { int tid_ = tid0; asm volatile("" : "+v"(tid_)); const int srow_ = tid_ >> 3; const size_t tk_ = (size_t)b * SEQ + (size_t)(cidx) * 64; \
            conv_load(qk + (tk_ + srow_) * 1024 + (off) + h * 128 + (tid_ & 7) * 8 + 64 * (hf), (cidx) * 64 + srow_, dst[hf]); } while (0)
#define GB_LOAD_K(cidx) do { int tid_ = tid0; asm volatile("" : "+v"(tid_)); const int srow_ = tid_ >> 3; const bf16_t* kp_ = kcv + ((size_t)b * SEQ + (size_t)(cidx) * 64 + srow_) * 512 + h * 128 + (tid_ & 7) * 8; \
            xk[0] = *(const u32x4*)kp_; xk[1] = *(const u32x4*)(kp_ + 64); } while (0)
#define GB_LOADS(cidx) do { GB_LOAD_G(cidx); GB_LOAD_V(cidx); GB_LOAD_QK(cidx, xq, 0, 0); GB_LOAD_QK(cidx, xq, 0, 1); GB_LOAD_K(cidx); } while (0)
        GB_LOADS(g * GCH);
        __syncthreads();
        { const int tid = tid0; const bf16_t* Gc = Gs + (size_t)(bh * NGRP + g) * 32768;
          u32x4 cv[8];
#pragma unroll
          for (int k = 0; k < 8; ++k) { const int p = tid + 512 * k; cv[k] = *(const u32x4*)(Gc + (size_t)(p >> 4) * 128 + (p & 15) * 8); }
          mlstm_mtab(mt, CH, bh, tid0);
#pragma unroll
          for (int k = 0; k < 8; ++k) { const int p = tid + 512 * k; *(u32x4*)(Cs + CSW256(p >> 4, (p & 15) * 16)) = cv[k]; }
          if (tid < 128) gx[256 + tid] = gn[(size_t)(bh * NGRP + g) * 128 + tid]; }
#pragma unroll 1
        for (int cc = 0; cc < GCH; ++cc) {
            const int c = g * GCH + cc; const size_t tok0 = (size_t)b * SEQ + c * 64;
            __syncthreads();
            { int tid = tid0; asm volatile("" : "+v"(tid));
              const int sr = tid >> 4, sc = (tid & 15) * 8, srow = tid >> 3;
              if (tid < 64) { const float bc = gbc, ct = gct, pm = gpm;
                  const float mc = mt[c], mm = fmaxf(pm, mc);
                  gx[tid] = ct; gx[64 + tid] = -mm; gx[128 + tid] = __expf(mc - mm); gx[192 + tid] = __expf(-(bc + mm)); gx[640 + tid] = __expf(gch + ct - mt[128 + c]); }
#pragma unroll
              for (int img = 0; img < 2; ++img)
#pragma unroll
                for (int hf = 0; hf < 2; ++hf) *(bf16x8*)(Vimg + img * 16384 + att::v_st(sr + 32 * hf, sc)) = xv[img * 2 + hf];
#pragma unroll
              for (int hf = 0; hf < 2; ++hf) { const int d = (tid & 7) * 8 + 64 * hf; float o[8]; u32x4 w;
                conv8(xq[hf], c * 64 + srow, cwl, h * 128 + d, 0.08838834764831845f, o);
                w.x = cvt_pk_bf16(o[0], o[1]); w.y = cvt_pk_bf16(o[2], o[3]); w.z = cvt_pk_bf16(o[4], o[5]); w.w = cvt_pk_bf16(o[6], o[7]); *(u32x4*)(Qs + KSW256(srow, d * 2)) = w;
                *(u32x4*)(Ks + KSW256(srow, d * 2)) = xk[hf]; } }
            __syncthreads();
            const float dec = mt[256 + c];
            float yv[2][16]; f32x16 ua[4];
            {
                int tid = tid0; asm volatile("" : "+v"(tid)); const int lane = tid & 63, r32 = lane & 31, hi = lane >> 5;
                const int rb = wid & 1, vq = wid >> 1, t = 32 * rb + r32;
                bf16x8 qr[8];
#pragma unroll
                for (int d0 = 0; d0 < 8; ++d0) qr[d0] = *(const bf16x8*)(Qs + KSW256(t, (d0 * 16 + hi * 8) * 2));
                f32x16 p0, p1;
#pragma unroll
                for (int r = 0; r < 16; ++r) { p0[r] = 0.f; p1[r] = 0.f; }
#pragma unroll
                for (int d0 = 0; d0 < 8; ++d0) { const int cbb = (d0 * 16 + hi * 8) * 2;
                    const bf16x8 k0 = *(const bf16x8*)(Ks + KSW256(r32, cbb));
                    p0 = __builtin_amdgcn_mfma_f32_32x32x16_bf16(k0, qr[d0], p0, 0, 0, 0);
                    if (rb) { const bf16x8 k1 = *(const bf16x8*)(Ks + KSW256(32 + r32, cbb)); p1 = __builtin_amdgcn_mfma_f32_32x32x16_bf16(k1, qr[d0], p1, 0, 0, 0); } }
                const float rowt = gx[64 + t];
                float ps = 0.f;
#pragma unroll
                for (int a4 = 0; a4 < 4; ++a4) { const f32x4 c0 = *(const LAS f32x4*)(gx + 8 * a4 + 4 * hi), c1 = *(const LAS f32x4*)(gx + 32 + 8 * a4 + 4 * hi);
#pragma unroll
                    for (int b4 = 0; b4 < 4; ++b4) { const int r = 4 * a4 + b4, s0 = att::crow(r, hi), s1 = 32 + s0;
                        p0[r] = (s0 <= t) ? p0[r] * __expf(rowt + c0[b4]) : 0.f; p1[r] = (s1 <= t) ? p1[r] * __expf(rowt + c1[b4]) : 0.f; ps += p0[r] + p1[r]; } }
                { auto rr = __builtin_amdgcn_permlane32_swap(__float_as_uint(ps), __float_as_uint(ps), false, false); ps = __uint_as_float(rr[0]) + __uint_as_float(rr[1]); }
                bf16x8 pa0, pa1, pa2, pa3;
#define PK4(P, BASE, OUT) do { unsigned a0_ = cvt_pk_bf16(P[BASE + 0], P[BASE + 1]), a1_ = cvt_pk_bf16(P[BASE + 2], P[BASE + 3]); unsigned b0_ = cvt_pk_bf16(P[BASE + 4], P[BASE + 5]), b1_ = cvt_pk_bf16(P[BASE + 6], P[BASE + 7]); \
    auto r0_ = __builtin_amdgcn_permlane32_swap(a0_, b0_, false, false); auto r1_ = __builtin_amdgcn_permlane32_swap(a1_, b1_, false, false); u32x4 w_ = {r0_[0], r1_[0], r0_[1], r1_[1]}; OUT = *reinterpret_cast<bf16x8*>(&w_); } while (0)
                PK4(p0, 0, pa0); PK4(p0, 8, pa1); PK4(p1, 0, pa2); PK4(p1, 8, pa3);
#undef PK4
                float qn = 0.f;
#pragma unroll
                for (int d0 = 0; d0 < 8; ++d0) { const u32x4 qq = *reinterpret_cast<const u32x4*>(&qr[d0]); const f32x4 n0 = *(const LAS f32x4*)(gx + 256 + d0 * 16 + hi * 8), n1 = *(const LAS f32x4*)(gx + 256 + d0 * 16 + hi * 8 + 4);
                    qn += bf_lo(qq.x) * n0.x + bf_hi(qq.x) * n0.y + bf_lo(qq.y) * n0.z + bf_hi(qq.y) * n0.w + bf_lo(qq.z) * n1.x + bf_hi(qq.z) * n1.y + bf_lo(qq.w) * n1.z + bf_hi(qq.w) * n1.w; }
                { auto rr = __builtin_amdgcn_permlane32_swap(__float_as_uint(qn), __float_as_uint(qn), false, false); qn = __uint_as_float(rr[0]) + __uint_as_float(rr[1]); }
                const float wint = gx[128 + t];
                const float den = ps + wint * qn;
                const float ivr = __builtin_amdgcn_rcpf(fmaxf(fabsf(den), gx[192 + t]));
                f32x16 o[2], oi[2];
#pragma unroll
                for (int j = 0; j < 2; ++j)
#pragma unroll
                    for (int r = 0; r < 16; ++r) { o[j][r] = 0.f; oi[j][r] = 0.f; }
                const int vb = (int)(uintptr_t)(Vimg + (vq >> 1) * 16384) + att::v_rd_base(lane) + (vq & 1) * 1024;
#define GB_PV(D0, OD) do { \
                    const s16x4 l0_ = att::tr_read<att::v_rd_off(D0, 0, 0)>(vb), h0_ = att::tr_read<att::v_rd_off(D0, 0, 1)>(vb), l1_ = att::tr_read<att::v_rd_off(D0, 1, 0)>(vb), h1_ = att::tr_read<att::v_rd_off(D0, 1, 1)>(vb); \
                    const s16x4 l2_ = att::tr_read<att::v_rd_off(D0, 2, 0)>(vb), h2_ = att::tr_read<att::v_rd_off(D0, 2, 1)>(vb), l3_ = att::tr_read<att::v_rd_off(D0, 3, 0)>(vb), h3_ = att::tr_read<att::v_rd_off(D0, 3, 1)>(vb); \
                    asm volatile("s_waitcnt lgkmcnt(0)" ::: "memory"); SBAR(); \
                    OD = __builtin_amdgcn_mfma_f32_32x32x16_bf16(PK8(l0_, h0_), pa0, OD, 0, 0, 0); OD = __builtin_amdgcn_mfma_f32_32x32x16_bf16(PK8(l1_, h1_), pa1, OD, 0, 0, 0); \
                    OD = __builtin_amdgcn_mfma_f32_32x32x16_bf16(PK8(l2_, h2_), pa2, OD, 0, 0, 0); OD = __builtin_amdgcn_mfma_f32_32x32x16_bf16(PK8(l3_, h3_), pa3, OD, 0, 0, 0); } while (0)
                GB_PV(0, o[0]); GB_PV(1, o[1]);
#undef GB_PV
#pragma unroll
                for (int j = 0; j < 2; ++j)
#pragma unroll
                    for (int d0 = 0; d0 < 8; ++d0) { const bf16x8 cf = *(const bf16x8*)(Cs + CSW256(vq * 64 + j * 32 + r32, (d0 * 16 + hi * 8) * 2)); oi[j] = __builtin_amdgcn_mfma_f32_32x32x16_bf16(cf, qr[d0], oi[j], 0, 0, 0); }
#pragma unroll
                for (int r = 0; r < 16; ++r)
#pragma unroll
                    for (int j = 0; j < 2; ++j) yv[j][r] = (o[j][r] + wint * oi[j][r]) * ivr;
            }
            __builtin_amdgcn_sched_barrier(0);
            {
                int tid = tid0; asm volatile("" : "+v"(tid)); const int lane = tid & 63, hi = lane >> 5;
#pragma unroll
                for (int j = 0; j < 4; ++j)
#pragma unroll
                    for (int r = 0; r < 16; ++r) ua[j][r] = 0.f;
                const int vbV = (int)(uintptr_t)(Vimg + (wid >> 2) * 16384) + att::v_rd_base(lane) + (wid & 3) * 512;
                const int q4 = (lane >> 2) & 3, p4 = lane & 3, g1 = (lane >> 4) & 1;
                int kb[2][4];
#pragma unroll
                for (int hf = 0; hf < 2; ++hf)
#pragma unroll
                    for (int j = 0; j < 4; ++j) kb[hf][j] = (int)(uintptr_t)Ks + (8 * hi + 4 * hf + q4) * 256 + ((64 * j + 32 * g1 + 8 * p4) ^ ((4 * hf + q4) << 4));
#define GBSTEP(KS) do { \
                    const s16x4 al = att::tr_read<att::v_rd_off(0, KS, 0)>(vbV), ah = att::tr_read<att::v_rd_off(0, KS, 1)>(vbV); \
                    const s16x4 l0 = att::tr_read<KS * 4096>(kb[0][0]), h0 = att::tr_read<KS * 4096>(kb[1][0]), l1 = att::tr_read<KS * 4096>(kb[0][1]), h1 = att::tr_read<KS * 4096>(kb[1][1]); \
                    const s16x4 l2 = att::tr_read<KS * 4096>(kb[0][2]), h2 = att::tr_read<KS * 4096>(kb[1][2]), l3 = att::tr_read<KS * 4096>(kb[0][3]), h3 = att::tr_read<KS * 4096>(kb[1][3]); \
                    const f32x4 w0 = *(const LAS f32x4*)(gx + 640 + 16 * KS + 8 * hi), w1 = *(const LAS f32x4*)(gx + 640 + 16 * KS + 8 * hi + 4); \
                    asm volatile("s_waitcnt lgkmcnt(0)" ::: "memory"); SBAR(); \
                    u32x4 af_; af_.x = cvt_pk_bf16(bf1((bf16_t)al[0]) * w0.x, bf1((bf16_t)al[1]) * w0.y); af_.y = cvt_pk_bf16(bf1((bf16_t)al[2]) * w0.z, bf1((bf16_t)al[3]) * w0.w); \
                    af_.z = cvt_pk_bf16(bf1((bf16_t)ah[0]) * w1.x, bf1((bf16_t)ah[1]) * w1.y); af_.w = cvt_pk_bf16(bf1((bf16_t)ah[2]) * w1.z, bf1((bf16_t)ah[3]) * w1.w); \
                    const bf16x8 af = *reinterpret_cast<const bf16x8*>(&af_); \
                    ua[0] = __builtin_amdgcn_mfma_f32_32x32x16_bf16(PK8(l0, h0), af, ua[0], 0, 0, 0); ua[1] = __builtin_amdgcn_mfma_f32_32x32x16_bf16(PK8(l1, h1), af, ua[1], 0, 0, 0); \
                    ua[2] = __builtin_amdgcn_mfma_f32_32x32x16_bf16(PK8(l2, h2), af, ua[2], 0, 0, 0); ua[3] = __builtin_amdgcn_mfma_f32_32x32x16_bf16(PK8(l3, h3), af, ua[3], 0, 0, 0); } while (0)
                GBSTEP(0); GBSTEP(1); GBSTEP(2); GBSTEP(3);
#undef GBSTEP
                { float sacc = 0.f; const int dq = tid & 127, kq = (tid >> 7) * 16;
#pragma unroll
                  for (int k = 0; k < 16; ++k) sacc += gx[640 + kq + k] * bf1(*(const bf16_t*)(Ks + KSW256(kq + k, (dq & ~7) * 2) + (dq & 7) * 2));
                  npart[tid] = sacc; }
            }
            __syncthreads();
            u32x4 sv[4];
            { int tid = tid0; asm volatile("" : "+v"(tid));
#pragma unroll
              for (int k = 0; k < 4; ++k) { const int p = tid + 512 * k, row = p >> 5, ck = p & 31; sv[k] = *(const u32x4*)(so + (tok0 + row) * 1024 + h * 256 + ck * 8); } }
            { int tid = tid0; asm volatile("" : "+v"(tid)); const int lane = tid & 63, r32 = lane & 31, hi = lane >> 5;
              const int rb = wid & 1, vq = wid >> 1;
#pragma unroll
              for (int j = 0; j < 2; ++j)
#pragma unroll
                for (int a4 = 0; a4 < 4; ++a4) { u32x2 w; w.x = cvt_pk_bf16(yv[j][4 * a4 + 0], yv[j][4 * a4 + 1]); w.y = cvt_pk_bf16(yv[j][4 * a4 + 2], yv[j][4 * a4 + 3]);
                  *(u32x2*)(Yt + (32 * rb + r32) * 528 + (vq * 64 + j * 32 + 8 * a4 + 4 * hi) * 2) = w; }
              const int cn = (cc + 1 < GCH) ? c + 1 : c;
              GB_LOAD_G(cn); GB_LOAD_V(cn);
              {
                u32x2 cv[4][4];
#pragma unroll
                for (int j = 0; j < 4; ++j)
#pragma unroll
                  for (int a4 = 0; a4 < 4; ++a4) cv[j][a4] = *(const u32x2*)(Cs + CSW256(wid * 32 + r32, (32 * j + 8 * a4 + 4 * hi) * 2));
#pragma unroll
                for (int j = 0; j < 4; ++j) {
#pragma unroll
                  for (int a4 = 0; a4 < 4; ++a4) { u32x2 nv;
                    nv.x = cvt_pk_bf16(dec * bf_lo(cv[j][a4].x) + ua[j][4 * a4 + 0], dec * bf_hi(cv[j][a4].x) + ua[j][4 * a4 + 1]); nv.y = cvt_pk_bf16(dec * bf_lo(cv[j][a4].y) + ua[j][4 * a4 + 2], dec * bf_hi(cv[j][a4].y) + ua[j][4 * a4 + 3]);
                    *(u32x2*)(Cs + CSW256(wid * 32 + r32, (32 * j + 8 * a4 + 4 * hi) * 2)) = nv; }
                  if (j == 0) GB_LOAD_QK(cn, xq, 0, 0); else if (j == 1) GB_LOAD_QK(cn, xq, 0, 1); else if (j == 2) GB_LOAD_K(cn);
                } }
              if (tid < 128) gx[256 + tid] = dec * gx[256 + tid] + ((npart[tid] + npart[128 + tid]) + (npart[256 + tid] + npart[384 + tid])); }
            __syncthreads();
            { int tid = tid0; asm volatile("" : "+v"(tid));
#pragma unroll
              for (int k = 0; k < 4; ++k) { const int p = tid + 512 * k, row = p >> 5, ck = p & 31; const u32x4 y = *(const u32x4*)(Yt + row * 528 + ck * 16); u32x2 w;
                w.x = pk4_fp8(bf_lo(y.x) * bf_lo(sv[k].x), bf_hi(y.x) * bf_hi(sv[k].x), bf_lo(y.y) * bf_lo(sv[k].y), bf_hi(y.y) * bf_hi(sv[k].y));
                w.y = pk4_fp8(bf_lo(y.z) * bf_lo(sv[k].z), bf_hi(y.z) * bf_hi(sv[k].z), bf_lo(y.w) * bf_lo(sv[k].w), bf_hi(y.w) * bf_hi(sv[k].w));
                *(u32x2*)(ym8 + (tok0 + row) * 1024 + h * 256 + ck * 8) = w; } }
        }
    }
}

__global__ void __launch_bounds__(NTHREADS, 2) fwd_kernel(Args args) {
    __shared__ __attribute__((aligned(16))) unsigned char lds_raw[LDS_BYTES];
    Frame F;
    F.lds = (LAS unsigned char*)lds_raw;
    F.wave0 = wave_sgpr(); F.tid = threadIdx.x; F.lane = F.tid & 63; F.wave = F.wave0;
    F.ws = (unsigned char*)(GAS unsigned char*)argp()->ws;
    for (int u = F.tid; u < (LDS_BYTES - LDSCTL_OFF) / 4; u += NTHREADS) ((LAS unsigned*)(F.lds + LDSCTL_OFF))[u] = 0u;
    __syncthreads();
    XcdBarrier bar = xcd_barrier_post(((unsigned*)F.ws) + CW_BAR, (volatile LAS unsigned*)(F.lds + LDSCTL_OFF));
#define GRID_BAR() xcd_barrier(bar)
#define PH(k) ((PHASE_MASK >> (k)) & 1u)
#ifndef PROBE
#define PROBE -1
#endif
#define REPS(k) for (int rep_ = 0; rep_ < ((PROBE == (k)) ? 2 : 1); ++rep_)

    p0_prologue(F);
    GRID_BAR();
    if (F.bid * NTHREADS + F.tid < 2 * 4 * 6144) {
        const int i = F.bid * NTHREADS + F.tid, l = i / (4 * 6144), r = i % (4 * 6144), b = r / 6144, idx = r % 6144;
        ((float*)(F.ws + WS_MODF))[i] = mod_from_partials(argp(), F.ws, l, b, idx);
    }
    for (int l = 0; l < DEPTH; ++l) {
        REPS(1) convert_weights(F, l);
        __syncthreads();
        if (l == 0) { REPS(11) { row_phase_norm1<0>(F, l); __syncthreads(); } } else row_phase_norm1<1>(F, l);
        GRID_BAR();
        F.refresh();
#if PROBE == 41
        { pg8::DenseOrder8 S; S.init(F.ws + WS_S(0), F.ws + WS_W + W_IN, T, NIN, 1024, 1024, 1024, F.G, F.bid, W8_E8M0); EpiInProjT<false> E{F.ws, (const float*)(F.ws + WS_ROPE)}; pg8::gemm_phase(F.lds, S, E, F.wave); }
#endif
#if PROBE == 30
        { pg8::DenseOrder8 S; S.init(F.ws + WS_S(0), F.ws + WS_W + W_IN, T, NIN, 1024, 1024, 1024, F.G, F.bid, W8_E8M0); EpiNull E; pg8::gemm_phase(F.lds, S, E, F.wave); }
#endif
        REPS(2) if (PH(2)) {
            pg8::DenseOrder8 S; S.init(F.ws + WS_S(0), F.ws + WS_W + W_IN, T, NIN, 1024, 1024, 1024, F.G, F.bid, W8_E8M0);
            EpiInProj E{F.ws, (const float*)(F.ws + WS_ROPE)};
            pg8::gemm_phase(F.lds, S, E, F.wave);
        }
        GRID_BAR();
        REPS(3) { if (PH(3)) row_phase_stats(F);
        if (PH(6)) mlstm_gates_local(F, l); __syncthreads(); }
        GRID_BAR();
        REPS(4) if (PH(6)) mlstm_group_state(F, l);
        GRID_BAR();
        if (PH(6)) mlstm_group_scan(F);
        GRID_BAR();
        REPS(6) if (PH(6)) mlstm_group_output(F, l);
        GRID_BAR();
        F.refresh();
        REPS(7) if (PH(7)) {
            { pg8::DenseOrder8 S; S.init(F.ws + WS_CQ, F.ws + WS_W + W_UQ, T, 1536, 512, 512, 512, F.G, F.bid, W8_E8M0); EpiUq E{F.ws, (const float*)(F.ws + WS_ROPE)}; pg8::gemm_phase(F.lds, S, E, F.wave); }
            { pg8::DenseOrder8 S; S.init(F.ws + WS_CKV, F.ws + WS_W + W_UKV, T, 2048, 256, 256, 256, F.G, F.bid, W8_E8M0); EpiUkv E{F.ws}; pg8::gemm_phase(F.lds, S, E, F.wave); }
        }
#if PROBE == 71
        { pg8::DenseOrder8 S; S.init(F.ws + WS_CQ, F.ws + WS_W + W_UQ, T, 1536, 512, 512, 512, F.G, F.bid, W8_E8M0); EpiUq E{F.ws, (const float*)(F.ws + WS_ROPE)}; pg8::gemm_phase(F.lds, S, E, F.wave); }
#endif
#if PROBE == 72
        { pg8::DenseOrder8 S; S.init(F.ws + WS_CKV, F.ws + WS_W + W_UKV, T, 2048, 256, 256, 256, F.G, F.bid, W8_E8M0); EpiUkv E{F.ws}; pg8::gemm_phase(F.lds, S, E, F.wave); }
#endif
#if PROBE == 73
        { pg8::DenseOrder8 S; S.init(F.ws + WS_CQ, F.ws + WS_W + W_UQ, T, 1536, 512, 512, 512, F.G, F.bid, W8_E8M0); EpiNull E; pg8::gemm_phase(F.lds, S, E, F.wave); }
        { pg8::DenseOrder8 S; S.init(F.ws + WS_CKV, F.ws + WS_W + W_UKV, T, 2048, 256, 256, 256, F.G, F.bid, W8_E8M0); EpiNull E; pg8::gemm_phase(F.lds, S, E, F.wave); }
#endif
        GRID_BAR();
        F.refresh();
        REPS(8) if (PH(8)) attn_phase(F, (PROBE != 8) || rep_ == 1);
        GRID_BAR();
        F.refresh();
        REPS(9) if (PH(9)) {
            MergeOrder S; S.ws = F.ws; S.G = F.G; S.c = F.bid; S.K = 1024; S.lda = 1024; S.ldb = 1024; S.pass0 = PH(6) ? 0 : 2;
            EpiMerge E{F.ws, PH(6) ? 1 : 0};
            pg8::gemm_phase(F.lds, S, E, F.wave);
        }
        GRID_BAR();
        F.refresh();
        REPS(10) if (PH(10)) {
            pg8::DenseOrder8 S; S.init(F.ws + WS_S(5), F.ws + WS_W + W_OUT, T, 1024, 1024, 1024, 1024, F.G, F.bid, W8_E8M0);
            EpiOut E{(l == 0) ? GIN(argp(), I_X) : (const float*)nullptr, (const bf16_t*)GOUT(argp()), xres(argp(), F.ws, l), (const float*)(F.ws + WS_MODF) + (size_t)l * 4 * 6144 + 2 * 1024, (PROBE != 10) || rep_ == 1};
            pg8::gemm_phase(F.lds, S, E, F.wave);
        }
        GRID_BAR();
#if PROBE == 20
        for (int xb = 0; xb < 10; ++xb) GRID_BAR();
#endif
        REPS(12) { if (PH(12)) row_phase_norm2_route(F, l, (PROBE != 12) || rep_ == 1); __syncthreads(); }
        GRID_BAR();
        moe_prefix(F, l);
        F.refresh();
        if (PH(13)) {
            MoeOrderUp S; S.A = (const char*)(F.ws + WS_S(0)); S.B = (const char*)(F.ws + WS_W + W_GU); S.G = F.G; S.c = F.bid; S.K = 1024; S.lda = 1024; S.ldb = 1024; S.npn = 2;
            S.pfx = (const LAS int*)(F.lds + LDSCTL_OFF + 64); S.ldest = (const unsigned*)(F.ws + WS_LDEST);
            EpiMoeUp E{(bf16_t*)(F.ws + WS_S(1))};
            pg8::gemm_phase(F.lds, S, E, F.wave);
        }
#if PROBE == 13
        if (PH(13)) {
            MoeOrderUp S; S.A = (const char*)(F.ws + WS_S(0)); S.B = (const char*)(F.ws + WS_W + W_GU); S.G = F.G; S.c = F.bid; S.K = 1024; S.lda = 1024; S.ldb = 1024; S.npn = 2;
            S.pfx = (const LAS int*)(F.lds + LDSCTL_OFF + 64); S.ldest = (const unsigned*)(F.ws + WS_LDEST);
            EpiMoeUp E{(bf16_t*)(F.ws + WS_S(1))};
            pg8::gemm_phase(F.lds, S, E, F.wave);
        }
#endif
        GRID_BAR();
        F.refresh();
        if (PH(14)) {
            MoeOrderDn S; S.A = (const char*)(F.ws + WS_S(1)); S.B = (const char*)(F.ws + WS_W + W_DN); S.G = F.G; S.c = F.bid; S.K = 256; S.lda = 256; S.ldb = 256; S.npn = 4;
            S.pfx = (const LAS int*)(F.lds + LDSCTL_OFF + 64); S.ldest = (const unsigned*)(F.ws + WS_LDEST);
            EpiMoeDn E{(bf16_t*)(F.ws + WS_S(2)), (const unsigned*)(F.ws + WS_LDEST), (const float*)(F.ws + WS_LW)};
            pg8::gemm_phase(F.lds, S, E, F.wave);
        }
#if PROBE == 14
        if (PH(14)) {
            MoeOrderDn S; S.A = (const char*)(F.ws + WS_S(1)); S.B = (const char*)(F.ws + WS_W + W_DN); S.G = F.G; S.c = F.bid; S.K = 256; S.lda = 256; S.ldb = 256; S.npn = 4;
            S.pfx = (const LAS int*)(F.lds + LDSCTL_OFF + 64); S.ldest = (const unsigned*)(F.ws + WS_LDEST);
            EpiMoeDn E{(bf16_t*)(F.ws + WS_S(2)), (const unsigned*)(F.ws + WS_LDEST), (const float*)(F.ws + WS_LW)};
            pg8::gemm_phase(F.lds, S, E, F.wave);
        }
#endif
        GRID_BAR();
    }
    row_phase_norm1<2>(F, 0);
}

extern "C" void kernel_launch(void* const* d_in, const int* in_sizes, int n_in, void* d_out, int out_size, void* d_ws, size_t ws_size, hipStream_t stream) {
    static int grid = 0;
    if (grid == 0) {
        if (n_in != 26 || out_size != T * D || ws_size < WS_END) { fprintf(stderr, "kernel_launch: unexpected shapes n_in %d out %d ws %zu (need %zu)\n", n_in, out_size, ws_size, (size_t)WS_END); grid = -1; return; }
        int dev = 0, cus = 0, per_cu = 0;
        if (hipGetDevice(&dev) != hipSuccess || hipDeviceGetAttribute(&cus, hipDeviceAttributeMultiprocessorCount, dev) != hipSuccess) { grid = -1; return; }
        if (hipOccupancyMaxActiveBlocksPerMultiprocessor(&per_cu, (const void*)fwd_kernel, NTHREADS, 0) != hipSuccess || per_cu < 1) fprintf(stderr, "kernel_launch: occupancy query says %d\n", per_cu);
        (void)hipGetLastError();
        if (cus < 256) { fprintf(stderr, "kernel_launch: built for a 256-CU device (one workgroup per CU), found %d CUs\n", cus); grid = -1; return; }
        grid = 256;
    }
    if (grid < 0) return;
    if (hipMemsetAsync((char*)d_ws + WS_CTL, 0, CTL_ZERO_BYTES, stream) != hipSuccess) return;
    Args a{};
    for (int i = 0; i < 26; ++i) a.in[i] = (const float*)d_in[i];
    a.out = (float*)d_out; a.ws = (unsigned char*)d_ws;
    hipLaunchKernelGGL(fwd_kernel, dim3(grid), dim3(NTHREADS), 0, stream, a);
}
```

```cpp
#include <hip/hip_runtime.h>
#include <cstdio>
#include <cstdint>

#ifndef PHASE_MASK
#define PHASE_MASK 0xFFFFFFFFu
#endif

#define LAS __attribute__((address_space(3)))
#define GAS __attribute__((address_space(1)))
typedef unsigned short bf16_t;
typedef short bf16x8 __attribute__((ext_vector_type(8)));
typedef short s16x4 __attribute__((ext_vector_type(4)));
typedef float f32x2 __attribute__((ext_vector_type(2)));
typedef float f32x4 __attribute__((ext_vector_type(4)));
typedef float f32x16 __attribute__((ext_vector_type(16)));
typedef unsigned u32x2 __attribute__((ext_vector_type(2)));
typedef unsigned u32x4 __attribute__((ext_vector_type(4)));
typedef int i32x8 __attribute__((ext_vector_type(8)));

constexpr int T = 32768, D = 1024, NBATCH = 4, SEQ = 8192, DEPTH = 2;
constexpr int D_IN = 5832, NIN = 3840;
constexpr int NWAVES = 8, NTHREADS = 512;
constexpr float EPS = 1e-6f;

constexpr size_t MiB = 1u << 20;
constexpr size_t WS_CTL = 0, CTL_ZERO_BYTES = 128 * 1024;
constexpr size_t WS_MODP = 1 * MiB;
constexpr size_t WS_MODF = 3 * MiB;
constexpr size_t WS_ROPE = 4 * MiB;
constexpr size_t WS_GATE = 6 * MiB;
constexpr size_t WS_CHK = 9 * MiB;
constexpr size_t WS_IFG = 11 * MiB;
constexpr size_t WS_RSTD = 12 * MiB;
constexpr size_t WS_W = 13 * MiB;
constexpr size_t W_IN = 0, W_GM = W_IN + (size_t)NIN * 1024 * 2, W_GA = W_GM + 2 * MiB, W_M = W_GA + 2 * MiB, W_A = W_M + 2 * MiB, W_OUT = W_A + 2 * MiB,
                 W_UQ = W_OUT + 2 * MiB, W_UKV = W_UQ + (size_t)1536 * 384 * 2, W_GU = W_UKV + (size_t)2048 * 256 * 2, W_DN = W_GU + 32 * MiB, W_END = W_DN + 16 * MiB;
static_assert(WS_W + W_END <= 84 * MiB, "weights region");
constexpr size_t WS_SMALL = 84 * MiB;
constexpr size_t WS_CQ = WS_SMALL, WS_CKV = WS_CQ + 24 * MiB, WS_KR = WS_CKV + 16 * MiB;
constexpr size_t WS_LDEST = WS_SMALL, WS_LW = WS_SMALL + 4 * MiB;
constexpr size_t WS_S0 = 128 * MiB, SLOT = 64 * MiB;
constexpr size_t WS_END = WS_S0 + 6 * SLOT;
#define WS_S(i) (WS_S0 + (size_t)(i) * SLOT)

constexpr int CW_BAR = 4096;
constexpr int CW_CNT = 16384;

constexpr int RING_BYTES = 131072;
constexpr int LDSX_OFF = RING_BYTES;
constexpr int LDSCTL_OFF = 163840 - 512;
constexpr int LDS_BYTES = 163840;

typedef __bf16 bf16x2_t __attribute__((ext_vector_type(2)));
__device__ __forceinline__ unsigned cvt_pk_bf16(float lo, float hi) { const f32x2 v = {lo, hi}; return __builtin_bit_cast(unsigned, __builtin_convertvector(v, bf16x2_t)); }
__device__ __forceinline__ unsigned pk4_fp8(float a, float b, float c, float d) { int w = 0; w = __builtin_amdgcn_cvt_pk_fp8_f32(a, b, w, false); w = __builtin_amdgcn_cvt_pk_fp8_f32(c, d, w, true); return (unsigned)w; }
constexpr float W8_SCALE = 64.f; constexpr int W8_E8M0 = 127 - 6;
__device__ __forceinline__ float bf_lo(unsigned w) { return __uint_as_float(w << 16); }
__device__ __forceinline__ float bf_hi(unsigned w) { return __uint_as_float(w & 0xffff0000u); }
__device__ __forceinline__ float bf1(bf16_t h) { return __uint_as_float(((unsigned)h) << 16); }
template <int CTRL> __device__ __forceinline__ float dpp_f(float v) { return __int_as_float(__builtin_amdgcn_update_dpp(0, __float_as_int(v), CTRL, 0xF, 0xF, false)); }
__device__ __forceinline__ float rdlane(float v, int l) { return __int_as_float(__builtin_amdgcn_readlane(__float_as_int(v), l)); }
__device__ __forceinline__ float wave_sum(float v) {
    v += dpp_f<0xB1>(v); v += dpp_f<0x4E>(v); v += dpp_f<0x141>(v); v += dpp_f<0x140>(v);
    return (__int_as_float(__builtin_amdgcn_readlane(__float_as_int(v), 0)) + __int_as_float(__builtin_amdgcn_readlane(__float_as_int(v), 16)))
         + (__int_as_float(__builtin_amdgcn_readlane(__float_as_int(v), 32)) + __int_as_float(__builtin_amdgcn_readlane(__float_as_int(v), 48)));
}
__device__ __forceinline__ float wave_max(float v) {
    v = fmaxf(v, dpp_f<0xB1>(v)); v = fmaxf(v, dpp_f<0x4E>(v)); v = fmaxf(v, dpp_f<0x141>(v)); v = fmaxf(v, dpp_f<0x140>(v));
    return fmaxf(fmaxf(__int_as_float(__builtin_amdgcn_readlane(__float_as_int(v), 0)), __int_as_float(__builtin_amdgcn_readlane(__float_as_int(v), 16))),
                 fmaxf(__int_as_float(__builtin_amdgcn_readlane(__float_as_int(v), 32)), __int_as_float(__builtin_amdgcn_readlane(__float_as_int(v), 48))));
}
__device__ __forceinline__ float sigmoidf_(float x) { return __builtin_amdgcn_rcpf(1.f + __builtin_amdgcn_exp2f(-1.4426950408889634f * x)); }
__device__ __forceinline__ float siluf_(float x) { return x * __builtin_amdgcn_rcpf(1.f + __builtin_amdgcn_exp2f(-1.4426950408889634f * x)); }
#define LDS_WAIT() asm volatile("s_waitcnt lgkmcnt(0)" ::: "memory")
#define VM_WAIT() asm volatile("s_waitcnt vmcnt(0)" ::: "memory")
__device__ __forceinline__ int lane_opaque() { int z = 0; asm volatile("" : "+v"(z)); return __builtin_amdgcn_mbcnt_hi(~0u, __builtin_amdgcn_mbcnt_lo(~0u, z)); }
__device__ __forceinline__ int wave_sgpr() { return __builtin_amdgcn_readfirstlane((int)threadIdx.x >> 6); }
__device__ __forceinline__ int tid_opaque(int wave) { return wave * 64 + lane_opaque(); }

#define XB_TMO      128
#define XB_XCNT(j)  (256  + 64 * (j))
#define XB_XSUB(j)  (1280 + 64 * (j))
#define XB_XGEN(j)  (2304 + 64 * (j))
#define XB_TOP      3328
#define XB_TOPGEN   3392
#define XCD_BAR_WORDS 3456
#define XB_SPIN_CAP (1u << 18)
__device__ __forceinline__ unsigned xb_ld(unsigned* p)              { return __hip_atomic_load(p, __ATOMIC_RELAXED, __HIP_MEMORY_SCOPE_AGENT); }
__device__ __forceinline__ unsigned xb_add(unsigned* p, unsigned v) { return __hip_atomic_fetch_add(p, v, __ATOMIC_RELAXED, __HIP_MEMORY_SCOPE_AGENT); }
__device__ __forceinline__ unsigned xb_xcc_id() { return (unsigned)__builtin_amdgcn_s_getreg((3 << 11) | 20) & 0xFu; }
#define XB_SPIN(cond, bar) do { unsigned _sp = 0; while (cond) { __builtin_amdgcn_s_sleep(1); \
    if ((++_sp & 255u) == 0u) { if (xb_ld(&(bar)[XB_TMO])) break; if (_sp > XB_SPIN_CAP) { atomicAdd(&(bar)[XB_TMO], 1u); break; } } } } while (0)
struct XcdBarrier { unsigned* bar; unsigned x; volatile LAS unsigned* st; };
__device__ __forceinline__ XcdBarrier xcd_barrier_post(unsigned* bar, volatile LAS unsigned* st) {
    XcdBarrier b; b.bar = bar; b.x = xb_xcc_id(); b.st = st;
    if (threadIdx.x == 0) (void)xb_add(&bar[XB_XCNT(b.x)], 1u);
    return b;
}
__device__ __forceinline__ void xcd_barrier_complete(unsigned* bar, unsigned x, unsigned& nloc, unsigned& nx) {
    const unsigned G = gridDim.x * gridDim.y * gridDim.z;
    unsigned sum, cnt, mine, sp = 0u;
    for (;;) {
        sum = 0u; cnt = 0u; mine = 0u;
#pragma unroll 1
        for (unsigned j = 0; j < 16; ++j) { const unsigned c = xb_ld(&bar[XB_XCNT(j)]); sum += c; cnt += (c > 0u) ? 1u : 0u; mine = (j == x) ? c : mine; }
        if (sum == G) break;
        __builtin_amdgcn_s_sleep(1);
        if ((++sp & 255u) == 0u) { if (xb_ld(&bar[XB_TMO])) break; if (sp > XB_SPIN_CAP) { atomicAdd(&bar[XB_TMO], 1u); break; } }
    }
    nloc = mine > 0u ? mine : 1u; nx = cnt > 0u ? cnt : 1u;
}
__device__ __forceinline__ void xcd_barrier(const XcdBarrier& b) {
    asm volatile("s_waitcnt vmcnt(0)" ::: "memory");
    __syncthreads();
    if (threadIdx.x == 0) {
        unsigned* bar = b.bar;
        __builtin_amdgcn_s_waitcnt(0);
        unsigned nloc = b.st[0], nx = b.st[1];
        if (nloc == 0u) { xcd_barrier_complete(bar, b.x, nloc, nx); b.st[0] = nloc; b.st[1] = nx; }
        const unsigned old = xb_add(&bar[XB_XSUB(b.x)], 1u);
        const unsigned gen = old / nloc;
        if (old + 1u == (gen + 1u) * nloc) {
            __builtin_amdgcn_fence(__ATOMIC_RELEASE, "agent");
            asm volatile("s_waitcnt vmcnt(0)" ::: "memory");
            const unsigned og = xb_add(&bar[XB_TOP], 1u);
            const unsigned tg = og / nx;
            if (og + 1u == (tg + 1u) * nx) xb_add(&bar[XB_TOPGEN], 1u);
            else XB_SPIN(xb_ld(&bar[XB_TOPGEN]) == tg, bar);
            __builtin_amdgcn_fence(__ATOMIC_ACQUIRE, "agent");
            asm volatile("s_waitcnt vmcnt(0)" ::: "memory");
        } else {
            XB_SPIN(xb_ld(&bar[XB_TOPGEN]) == gen, bar);
            __builtin_amdgcn_fence(__ATOMIC_ACQUIRE, "agent");
            asm volatile("s_waitcnt vmcnt(0)" ::: "memory");
        }
    }
    __syncthreads();
}

namespace pg8 {
constexpr int BM = 256, BK = 64, HALF = 128, HTB = HALF * BK * 2, STAGE_BYTES = 8 * HTB, NXCD = 8, WGM = 8;
__host__ __device__ __forceinline__ int lds_byte(int r, int c) { const int st = (r >> 4) * 2 + (c >> 5), rr = r & 15, cc = c & 31, ob = rr * 64 + cc * 2; return st * 1024 + (ob ^ (((ob >> 9) & 1) << 5)); }
__host__ __device__ __forceinline__ void stage_rc(int b, int& R, int& C) { const int st = b / 1024, sb = b % 1024, swz = sb ^ (((sb >> 9) & 1) << 5); R = (st >> 1) * 16 + swz / 64; C = (st & 1) * 32 + (swz % 64) / 2; }
__host__ __device__ __forceinline__ int perm32(int rho) { const int n = rho >> 4, i = rho & 15; return 8 * (i >> 2) + 4 * n + (i & 3); }

struct Unit { int pm, pn, aux, e, r0, nv; };

__device__ __forceinline__ void tile_of(int L, int nM, int nN, int& pm, int& pn) {
    const int nwg = nM * nN; int wgid = L;
    { const int q = nwg / NXCD, r = nwg % NXCD, xcd = wgid % NXCD, off = wgid / NXCD; wgid = (xcd < r ? xcd * (q + 1) : r * (q + 1) + (xcd - r) * q) + off; }
    const int nig = WGM * nN, gid = wgid / nig, fm = gid * WGM, gsz = (nM - fm) < WGM ? (nM - fm) : WGM;
    pm = fm + ((wgid % nig) % gsz); pn = (wgid % nig) / gsz;
}

template <bool F8_>
struct DenseOrderT {
    static constexpr bool GATHER = false, F8 = F8_; static constexpr int EB = F8_ ? 1 : 2;
    const char* A; const char* B; int nM, nN, G, c, K, lda, ldb, scaleA, scaleB;
    __device__ __forceinline__ void init(const void* A_, const void* B_, int M, int N, int K_, int lda_, int ldb_, int G_, int c_, int sB = 127) { A = (const char*)A_; B = (const char*)B_; nM = M / BM; nN = N / BM; G = G_; c = c_; K = K_; lda = lda_; ldb = ldb_; scaleA = 127; scaleB = sB; }
    __device__ __forceinline__ bool next(int i, Unit& u) const { const long L = (long)i * G + c; if (L >= (long)nM * nN) return false; tile_of((int)L, nM, nN, u.pm, u.pn); u.aux = 0; return true; }
    __device__ __forceinline__ const char* abase(const Unit& u) const { return A + (size_t)u.pm * BM * lda * EB; }
    __device__ __forceinline__ const char* bbase(const Unit& u) const { return B + (size_t)u.pn * BM * ldb * EB; }
    __device__ __forceinline__ unsigned arow(const Unit&, int r) const { return (unsigned)r; }
};
typedef DenseOrderT<false> DenseOrder;
typedef DenseOrderT<true> DenseOrder8;

template <class Epi, class Sched>
__device__ __forceinline__ void gemm_phase(LAS unsigned char* lds, const Sched& S, const Epi& E, int wave0) {
    const int tid = tid_opaque(wave0), wid = wave0, lane = tid & 63, wr = wid >> 2, wc = wid & 3, fr = lane & 15, fq = lane >> 4;
    constexpr bool F8 = Sched::F8; constexpr int EB = F8 ? 1 : 2;
    const int K = S.K, nt = K / (F8 ? 128 : BK), lda = S.lda, ldb = S.ldb;
    unsigned voffB0; { int R_, C_; stage_rc(tid * 16, R_, C_); const int Rb = Epi::PERM ? ((R_ & ~31) + perm32(R_ & 31)) : R_; voffB0 = (unsigned)(Rb * ldb * EB + C_ * 2); }
    const size_t pstepA = (size_t)64 * lda * EB, pstepB = (size_t)64 * ldb * EB, hstepA = (size_t)HALF * lda * EB;
    const size_t kstep = (size_t)(BK * 2);
    const size_t hstepB = (size_t)HALF * ldb * EB;
    const unsigned ldsw = (unsigned)wid * 1024u;
    const int aoff = lds_byte(wr * 64 + fr, fq * 8), boff = lds_byte(wc * 32 + fr, fq * 8);
    const int aoff0 = aoff, aoff1 = aoff + 1024, boff0 = boff, boff1 = boff + 1024;
#define PG8_SA(b, h) (((b) * 2 + (h)) * HTB)
#define PG8_SB(b, h) ((4 + (b) * 2 + (h)) * HTB)
#define PG8_STAGE2(bufoff, gbase, v0, pstep) do { \
        __builtin_amdgcn_global_load_lds((const unsigned*)((const char*)(gbase) + (v0)), (LAS unsigned*)(lds + (bufoff) + ldsw), 16, 0, 0); \
        __builtin_amdgcn_global_load_lds((const unsigned*)((const char*)(gbase) + (pstep) + (v0)), (LAS unsigned*)(lds + (bufoff) + ldsw + 8192), 16, 0, 0); } while (0)
#define PG8_STAGE(bufoff, gbase, v0, v1) do { \
        __builtin_amdgcn_global_load_lds((const unsigned*)((const char*)(gbase) + (v0)), (LAS unsigned*)(lds + (bufoff) + ldsw), 16, 0, 0); \
        __builtin_amdgcn_global_load_lds((const unsigned*)((const char*)(gbase) + (v1)), (LAS unsigned*)(lds + (bufoff) + ldsw + 8192), 16, 0, 0); } while (0)
#define PG8_LDA(dst, b, h) do { if constexpr (F8) { _Pragma("unroll") for (int m = 0; m < 4; ++m) { const u32x4 x0_ = *(const LAS u32x4*)(lds + PG8_SA(b, h) + aoff0 + m * 2048), x1_ = *(const LAS u32x4*)(lds + PG8_SA(b, h) + aoff1 + m * 2048); \
            dst##8[m] = (i32x8){(int)x0_.x, (int)x0_.y, (int)x0_.z, (int)x0_.w, (int)x1_.x, (int)x1_.y, (int)x1_.z, (int)x1_.w}; } } \
        else { _Pragma("unroll") for (int m = 0; m < 4; ++m) _Pragma("unroll") for (int k = 0; k < 2; ++k) dst[m][k] = *(const LAS bf16x8*)(lds + PG8_SA(b, h) + aoff + m * 2048 + k * 1024); } } while (0)
#define PG8_LDB(dst, b, h) do { if constexpr (F8) { _Pragma("unroll") for (int n = 0; n < 2; ++n) { const u32x4 x0_ = *(const LAS u32x4*)(lds + PG8_SB(b, h) + boff0 + n * 2048), x1_ = *(const LAS u32x4*)(lds + PG8_SB(b, h) + boff1 + n * 2048); \
            dst##8[n] = (i32x8){(int)x0_.x, (int)x0_.y, (int)x0_.z, (int)x0_.w, (int)x1_.x, (int)x1_.y, (int)x1_.z, (int)x1_.w}; } } \
        else { _Pragma("unroll") for (int n = 0; n < 2; ++n) _Pragma("unroll") for (int k = 0; k < 2; ++k) dst[n][k] = *(const LAS bf16x8*)(lds + PG8_SB(b, h) + boff + n * 2048 + k * 1024); } } while (0)
#define PG8_MMA(ai, bj, At, Bt) do { __builtin_amdgcn_s_setprio(1); if constexpr (F8) { _Pragma("unroll") for (int m = 0; m < 4; ++m) _Pragma("unroll") for (int n = 0; n < 2; ++n) \
            asm volatile("v_mfma_scale_f32_16x16x128_f8f6f4 %0, %1, %2, %0, %3, %4 op_sel_hi:[0,0,0]" : "+v"(acc[ai][bj][m][n]) : "v"(Bt##8[n]), "v"(At##8[m]), "v"(scB), "v"(scA)); } \
        else { _Pragma("unroll") for (int m = 0; m < 4; ++m) _Pragma("unroll") for (int n = 0; n < 2; ++n) _Pragma("unroll") for (int k = 0; k < 2; ++k) \
            acc[ai][bj][m][n] = __builtin_amdgcn_mfma_f32_16x16x32_bf16(Bt[n][k], At[m][k], acc[ai][bj][m][n], 0, 0, 0); } __builtin_amdgcn_s_setprio(0); } while (0)
#define PG8_WAIT_V(n) asm volatile("s_waitcnt vmcnt(" #n ")" ::: "memory")
#define PG8_WAIT_L(n) asm volatile("s_waitcnt lgkmcnt(" #n ")" ::: "memory")
#define PG8_BAR __builtin_amdgcn_s_barrier()
#define PG8_SCHED __builtin_amdgcn_sched_barrier(0)
    LAS unsigned* const rowtab = (LAS unsigned*)(lds + STAGE_BYTES);
    int gR0, gC0; stage_rc(tid * 16, gR0, gC0); const unsigned gcol2 = (unsigned)gC0 * 2u;
#define PG8_FILL(u, par) do { if (tid < 256) rowtab[(par) * 256 + tid] = S.arow(u, tid) * (unsigned)(lda * EB); } while (0)
#define PG8_STAGE_AG(bufoff, gbase, par, h) do { const unsigned o0_ = rowtab[(par) * 256 + (h) * 128 + gR0] + gcol2, o1_ = rowtab[(par) * 256 + (h) * 128 + 64 + gR0] + gcol2; PG8_STAGE(bufoff, gbase, o0_, o1_); } while (0)
#define PG8_VOFFA(u, vo) do { int R_, C_; stage_rc(tid * 16, R_, C_); vo = (unsigned)R_ * (unsigned)(lda * EB) + (unsigned)C_ * 2u; } while (0)
    Unit cur, nxt; int ui = 0;
    if (!S.next(0, cur)) return;
    f32x4 acc[2][2][4][2];
#pragma unroll
    for (int a = 0; a < 2; ++a)
#pragma unroll
        for (int b = 0; b < 2; ++b)
#pragma unroll
            for (int m = 0; m < 4; ++m)
#pragma unroll
                for (int n = 0; n < 2; ++n) acc[a][b][m][n] = (f32x4){0.f, 0.f, 0.f, 0.f};
    bf16x8 At[4][2], B0[2][2], B1[2][2]; i32x8 At8[4], B08[2], B18[2]; (void)At; (void)B0; (void)B1; (void)At8; (void)B08; (void)B18;
    unsigned est[Epi::STATE ? 32 : 1]; (void)est;
    int scA = S.scaleA, scB = S.scaleB; asm volatile("" : "+v"(scA), "+v"(scB));
    unsigned vc0 = 0u;
    int par = 0;
    if constexpr (Sched::GATHER) { PG8_FILL(cur, 0); __syncthreads(); } else { PG8_VOFFA(cur, vc0); }
#define PG8_STAGE_A(bufoff, gbase, nextu, h) do { if constexpr (Sched::GATHER) { PG8_STAGE_AG(bufoff, gbase, (nextu) ? (par ^ 1) : par, h); } else { PG8_STAGE2(bufoff, (gbase) + (h) * hstepA, vc0, pstepA); } } while (0)
    const char* cA = S.abase(cur); const char* cB = S.bbase(cur);
    PG8_STAGE2(PG8_SB(0, 0), cB, voffB0, pstepB); PG8_STAGE2(PG8_SB(0, 1), cB + hstepB, voffB0, pstepB); PG8_STAGE_A(PG8_SA(0, 0), cA, false, 0); PG8_STAGE_A(PG8_SA(0, 1), cA, false, 1);
    if (wr == 1) PG8_BAR;
    PG8_WAIT_V(2); PG8_BAR;
    PG8_STAGE2(PG8_SB(1, 0), cB + kstep, voffB0, pstepB); PG8_STAGE_A(PG8_SA(1, 0), cA + kstep, false, 0); PG8_STAGE2(PG8_SB(1, 1), cB + hstepB + kstep, voffB0, pstepB);
    PG8_WAIT_V(6); PG8_BAR;
    for (;;) {
        const bool has_next = S.next(ui + 1, nxt);
        const char* nA = has_next ? S.abase(nxt) : cA; const char* nB = has_next ? S.bbase(nxt) : cB;
        for (int t = 0; t < nt; t += 2) {
            const bool last = (t == nt - 2);
            const bool nx = last && has_next;
            if constexpr (Sched::GATHER) { if (nx) PG8_FILL(nxt, par ^ 1); }
            const char* a1 = cA + (size_t)(t + 1) * kstep;
            const char* a2 = last ? nA : cA + (size_t)(t + 2) * kstep; const char* b2 = last ? nB : cB + (size_t)(t + 2) * kstep;
            const char* a3 = a2 + kstep; const char* b3 = b2 + kstep;
            PG8_LDB(B0, 0, 0); PG8_LDB(B1, 0, 1); PG8_SCHED; PG8_LDA(At, 0, 0); PG8_STAGE_A(PG8_SA(1, 1), a1, false, 1);
            PG8_WAIT_V(8); PG8_WAIT_L(0); PG8_BAR; PG8_MMA(0, 0, At, B0); PG8_MMA(0, 1, At, B1); PG8_BAR; PG8_SCHED;
            PG8_LDA(At, 0, 1); PG8_STAGE2(PG8_SB(0, 0), b2, voffB0, pstepB); PG8_STAGE2(PG8_SB(0, 1), b2 + hstepB, voffB0, pstepB); PG8_STAGE_A(PG8_SA(0, 0), a2, nx, 0);
            PG8_WAIT_V(8); PG8_WAIT_L(0); PG8_BAR; PG8_MMA(1, 0, At, B0); PG8_MMA(1, 1, At, B1); PG8_BAR; PG8_SCHED;
            PG8_LDB(B0, 1, 0); PG8_LDB(B1, 1, 1); PG8_SCHED; PG8_LDA(At, 1, 0); PG8_STAGE_A(PG8_SA(0, 1), a2, nx, 1);
            PG8_WAIT_V(8); PG8_WAIT_L(0); PG8_BAR; PG8_MMA(0, 0, At, B0); PG8_MMA(0, 1, At, B1); PG8_BAR; PG8_SCHED;
            PG8_LDA(At, 1, 1); PG8_STAGE2(PG8_SB(1, 0), b3, voffB0, pstepB); PG8_STAGE2(PG8_SB(1, 1), b3 + hstepB, voffB0, pstepB); PG8_STAGE_A(PG8_SA(1, 0), a3, nx, 0);
            PG8_WAIT_V(8); PG8_WAIT_L(0); PG8_BAR; PG8_MMA(1, 0, At, B0); PG8_MMA(1, 1, At, B1); PG8_BAR; PG8_SCHED;
        }
        if (wr == 0) PG8_BAR;
        if constexpr (F8) asm volatile("s_nop 15\n\ts_nop 15" ::: "memory");
        { const int ln_ = lane_opaque(); const int fr_ = ln_ & 15, fq_ = ln_ >> 4;
          if constexpr (Epi::STATE) E(acc, cur, wr, wc, fr_, fq_, est); else E(acc, cur, wr, wc, fr_, fq_); }
        if (!has_next) break;
#pragma unroll
        for (int a = 0; a < 2; ++a)
#pragma unroll
            for (int b = 0; b < 2; ++b)
#pragma unroll
                for (int m = 0; m < 4; ++m)
#pragma unroll
                    for (int n = 0; n < 2; ++n) acc[a][b][m][n] = (f32x4){0.f, 0.f, 0.f, 0.f};
        cur = nxt; cA = nA; cB = nB; ++ui; par ^= 1;
        if (wr == 1) PG8_BAR;
    }
    PG8_WAIT_V(0);
    PG8_BAR;
#undef PG8_SA
#undef PG8_SB
#undef PG8_STAGE
#undef PG8_STAGE2
#undef PG8_LDA
#undef PG8_LDB
#undef PG8_MMA
#undef PG8_WAIT_V
#undef PG8_WAIT_L
#undef PG8_BAR
#undef PG8_SCHED
#undef PG8_VOFFA
#undef PG8_FILL
#undef PG8_STAGE_AG
#undef PG8_STAGE_A
}
}

#define EPI8_LOOP(...) \
    _Pragma("unroll") for (int ai = 0; ai < 2; ++ai) _Pragma("unroll") for (int m = 0; m < 4; ++m) { asm volatile("" ::: "memory"); const int rl = ai * 128 + wr * 64 + m * 16 + fr; const int row = u.pm * 256 + rl; (void)row; \
    _Pragma("unroll") for (int bj = 0; bj < 2; ++bj) { const int cl = bj * 128 + wc * 32 + 8 * fq; const int col = u.pn * 256 + cl; (void)col; const f32x4 v0 = acc[ai][bj][m][0], v1 = acc[ai][bj][m][1]; __VA_ARGS__ } }

struct Args { const float* in[26]; float* out; unsigned char* ws; };
#define CAS __attribute__((address_space(4)))
typedef const CAS Args* ArgP;
#define GAS __attribute__((address_space(1)))
#define GIN(a, i) ((const float*)(const GAS float*)(a)->in[i])
#define GOUT(a) ((float*)(GAS float*)(a)->out)
__device__ __forceinline__ ArgP argp() { unsigned long long p = (unsigned long long)(const CAS void*)__builtin_amdgcn_kernarg_segment_ptr(); asm volatile("" : "+s"(p)); return (ArgP)p; }
enum { I_X = 0, I_C, I_MODW, I_MODB, I_N1G, I_WIN, I_CONVW, I_CONVB, I_IGB, I_FGB, I_QNG, I_KVNG, I_WUQ, I_WUKV, I_WBM, I_WBA, I_WOUT, I_N2G, I_WGRP, I_BGRP, I_WRT, I_BRT, I_WEG, I_WEU, I_WED, I_FNG };

struct Frame {
    LAS unsigned char* lds;
    unsigned char* ws;
    int tid, lane, wave, wave0, bid, G;
    __device__ __forceinline__ void refresh() { { int w_ = wave0, b_ = blockIdx.x, g_ = gridDim.x; asm volatile("" : "+s"(w_), "+s"(b_), "+s"(g_)); wave = w_; bid = b_; G = g_; }
        tid = wave * 64 + lane_opaque(); lane = tid & 63;
        unsigned long long w = (unsigned long long)ws; asm volatile("" : "+s"(w)); ws = (unsigned char*)(GAS unsigned char*)w; }
};

template <class ColMap>
__device__ __forceinline__ void cvt_load(const ColMap& cm, int K, int item, int lane, f32x4 (&v)[8]) {
    const int nkb = K / 64, rb = item / nkb, kb = item % nkb, k0 = 64 * kb, r0 = 32 * rb;
    const int rq = r0 + 4 * (lane & 7);
    const float* src; int ld; const float* s1; int l1;
    const int c0 = cm.col(rq, src, ld), c1 = cm.col(rq + 1, s1, l1), c2 = cm.col(rq + 2, s1, l1), c3 = cm.col(rq + 3, s1, l1);
    const bool vec = (c0 >= 0) && (c1 == c0 + 1) && (c2 == c0 + 2) && (c3 == c0 + 3) && ((c0 & 3) == 0) && (s1 == src);
#pragma unroll
    for (int i = 0; i < 8; ++i) { const int kk = (lane >> 3) + 8 * i; v[i] = (f32x4){0.f, 0.f, 0.f, 0.f};
        if (!cm.kvalid(k0 + kk)) continue;
        if (vec) v[i] = *(const f32x4*)(src + (size_t)(k0 + kk) * ld + c0);
        else { const float* sa; int la; int c;
            c = cm.col(rq, sa, la); if (c >= 0) v[i].x = sa[(size_t)(k0 + kk) * la + c];
            c = cm.col(rq + 1, sa, la); if (c >= 0) v[i].y = sa[(size_t)(k0 + kk) * la + c];
            c = cm.col(rq + 2, sa, la); if (c >= 0) v[i].z = sa[(size_t)(k0 + kk) * la + c];
            c = cm.col(rq + 3, sa, la); if (c >= 0) v[i].w = sa[(size_t)(k0 + kk) * la + c]; } }
}
template <bool F8, class ColMap>
__device__ __forceinline__ void cvt_store(const ColMap& cm, int K, void* dstv, LAS float* scr, int item, int lane, const f32x4 (&v)[8]) {
    const int nkb = K / 64, rb = item / nkb, kb = item % nkb, k0 = 64 * kb, r0 = 32 * rb;
#pragma unroll
    for (int i = 0; i < 8; ++i) { const int kk = (lane >> 3) + 8 * i; *(LAS f32x4*)(scr + kk * 36 + 4 * (lane & 7)) = v[i] * cm.kscale(k0 + kk); }
    LDS_WAIT(); asm volatile("" ::: "memory");
    const int c = lane & 7;
#pragma unroll
    for (int j = 0; j < 4; ++j) { const int n = (lane >> 3) + 8 * j; const LAS float* s = scr + (8 * c) * 36 + n;
        if constexpr (F8) { u32x2 o; o.x = pk4_fp8(s[0 * 36] * W8_SCALE, s[1 * 36] * W8_SCALE, s[2 * 36] * W8_SCALE, s[3 * 36] * W8_SCALE); o.y = pk4_fp8(s[4 * 36] * W8_SCALE, s[5 * 36] * W8_SCALE, s[6 * 36] * W8_SCALE, s[7 * 36] * W8_SCALE);
            *(u32x2*)((unsigned char*)dstv + (size_t)(r0 + n) * K + k0 + 8 * c) = o; }
        else { u32x4 o; o.x = cvt_pk_bf16(s[0 * 36], s[1 * 36]); o.y = cvt_pk_bf16(s[2 * 36], s[3 * 36]); o.z = cvt_pk_bf16(s[4 * 36], s[5 * 36]); o.w = cvt_pk_bf16(s[6 * 36], s[7 * 36]);
            *(u32x4*)((bf16_t*)dstv + (size_t)(r0 + n) * K + k0 + 8 * c) = o; } }
    LDS_WAIT(); asm volatile("" ::: "memory");
}
struct CmOffset { const float* W; int ld, off; __device__ __forceinline__ int col(int r, const float*& s, int& l) const { s = W; l = ld; return off + r; } __device__ __forceinline__ bool kvalid(int) const { return true; } __device__ __forceinline__ float kscale(int) const { return 1.f; } };
struct CmIn { const float* W; __device__ __forceinline__ int col(int r, const float*& s, int& l) const { s = W; l = D_IN;
        if (r < 3072) return r; if (r < 3456) return 3080 + (r - 3072); if (r < 3712) return 3464 + (r - 3456);
        if (r < 3776) { const int i = r - 3712, j = i >> 1; return 3720 + ((i & 1) ? 32 + j : j); }
        if (r < 3784) return 3072 + (r - 3776); return -1; }
    __device__ __forceinline__ bool kvalid(int) const { return true; } __device__ __forceinline__ float kscale(int) const { return 1.f; } };
struct CmUq { const float* W; const float* g; __device__ __forceinline__ int col(int r, const float*& s, int& l) const { s = W; l = 1536;
        if (r < 1024) return (r >> 7) * 192 + (r & 127); const int i = r - 1024, h = i >> 6, p = i & 63, jj = p >> 1; return h * 192 + 128 + ((p & 1) ? 32 + jj : jj); }
    __device__ __forceinline__ bool kvalid(int k) const { return k < 384; }
    __device__ __forceinline__ float kscale(int k) const { return k < 384 ? g[k] : 0.f; } };
struct CmUkv { const float* W; const float* g; __device__ __forceinline__ int col(int r, const float*& s, int& l) const { s = W; l = 2048;
        if (r < 1024) return (r >> 7) * 256 + (r & 127); const int i = r - 1024; return (i >> 7) * 256 + 128 + (i & 127); }
    __device__ __forceinline__ bool kvalid(int) const { return true; } __device__ __forceinline__ float kscale(int k) const { return g[k]; } };
struct CmGu { const float* Wg; const float* Wu; __device__ __forceinline__ int col(int r, const float*& s, int& l) const { const int e = r >> 9, w = r & 511, pn = w >> 8, x = w & 255; l = 256;
        if (x < 128) { s = Wg + (size_t)e * 1024 * 256; return pn * 128 + x; } s = Wu + (size_t)e * 1024 * 256; return pn * 128 + x - 128; }
    __device__ __forceinline__ bool kvalid(int) const { return true; } __device__ __forceinline__ float kscale(int) const { return 1.f; } };
struct CmDn { const float* W; __device__ __forceinline__ int col(int r, const float*& s, int& l) const { const int e = r >> 10; s = W + (size_t)e * 256 * 1024; l = 1024; return r & 1023; }
    __device__ __forceinline__ bool kvalid(int) const { return true; } __device__ __forceinline__ float kscale(int) const { return 1.f; } };

template <int N> struct IC { static constexpr int value = N; };
template <class Fn>
__device__ __forceinline__ void cvt_dispatch(ArgP a, unsigned char* W, int l, int it, Fn&& fn) {
    const float* w_in = GIN(a, I_WIN) + (size_t)l * 1024 * D_IN;
    constexpr int N_IN = (NIN / 32) * 16, N_SQ = 32 * 16, N_UQ = 48 * 8, N_UKV = 64 * 4, N_GU = (32 * 512 / 32) * 16;
    int r = it;
    if (r < N_IN) { CmIn cm{w_in}; fn(cm, 1024, (void*)(W + W_IN), IC<1>{}, r); return; } r -= N_IN;
    if (r < N_SQ) { CmOffset cm{w_in, D_IN, 3784}; fn(cm, 1024, (void*)(W + W_GM), IC<1>{}, r); return; } r -= N_SQ;
    if (r < N_SQ) { CmOffset cm{w_in, D_IN, 3784 + 1024}; fn(cm, 1024, (void*)(W + W_GA), IC<1>{}, r); return; } r -= N_SQ;
    if (r < N_SQ) { CmOffset cm{GIN(a, I_WBM) + (size_t)l * 1024 * 1024, 1024, 0}; fn(cm, 1024, (void*)(W + W_M), IC<1>{}, r); return; } r -= N_SQ;
    if (r < N_SQ) { CmOffset cm{GIN(a, I_WBA) + (size_t)l * 1024 * 1024, 1024, 0}; fn(cm, 1024, (void*)(W + W_A), IC<1>{}, r); return; } r -= N_SQ;
    if (r < N_SQ) { CmOffset cm{GIN(a, I_WOUT) + (size_t)l * 1024 * 1024, 1024, 0}; fn(cm, 1024, (void*)(W + W_OUT), IC<1>{}, r); return; } r -= N_SQ;
    if (r < N_UQ) { CmUq cm{GIN(a, I_WUQ) + (size_t)l * 384 * 1536, GIN(a, I_QNG) + l * 384}; fn(cm, 512, (void*)(W + W_UQ), IC<1>{}, r); return; } r -= N_UQ;
    if (r < N_UKV) { CmUkv cm{GIN(a, I_WUKV) + (size_t)l * 256 * 2048, GIN(a, I_KVNG) + l * 256}; fn(cm, 256, (void*)(W + W_UKV), IC<1>{}, r); return; } r -= N_UKV;
    if (r < N_GU) { CmGu cm{GIN(a, I_WEG) + (size_t)l * 32 * 1024 * 256, GIN(a, I_WEU) + (size_t)l * 32 * 1024 * 256}; fn(cm, 1024, (void*)(W + W_GU), IC<1>{}, r); return; } r -= N_GU;
    { CmDn cm{GIN(a, I_WED) + (size_t)l * 32 * 256 * 1024}; fn(cm, 256, (void*)(W + W_DN), IC<1>{}, r); }
}
__device__ __forceinline__ void convert_weights(Frame& F, int l) {
    F.refresh();
    ArgP a = argp();
    LAS float* scr = (LAS float*)(F.lds + F.wave * 16384);
    unsigned char* W = F.ws + WS_W;
    const int gw = F.bid * NWAVES + F.wave, NGW = F.G * NWAVES;
    constexpr int N_IN = (NIN / 32) * 16, N_SQ = 32 * 16, N_UQ = 48 * 8, N_UKV = 64 * 4, N_GU = (32 * 512 / 32) * 16, N_DN = (32 * 1024 / 32) * 4;
    constexpr int NITEMS = N_IN + 5 * N_SQ + N_UQ + N_UKV + N_GU + N_DN;
    f32x4 va[8], vb[8];
    const int lane = F.lane;
    auto load_a = [&](int it) __attribute__((always_inline)) { cvt_dispatch(a, W, l, it, [&](auto cm, int K, void*, auto, int r) __attribute__((always_inline)) { cvt_load(cm, K, r, lane, va); }); };
    auto load_b = [&](int it) __attribute__((always_inline)) { cvt_dispatch(a, W, l, it, [&](auto cm, int K, void*, auto, int r) __attribute__((always_inline)) { cvt_load(cm, K, r, lane, vb); }); };
    auto store_a = [&](int it) __attribute__((always_inline)) { cvt_dispatch(a, W, l, it, [&](auto cm, int K, void* dst, auto f8, int r) __attribute__((always_inline)) { cvt_store<(decltype(f8)::value != 0)>(cm, K, dst, scr, r, lane, va); }); };
    auto store_b = [&](int it) __attribute__((always_inline)) { cvt_dispatch(a, W, l, it, [&](auto cm, int K, void* dst, auto f8, int r) __attribute__((always_inline)) { cvt_store<(decltype(f8)::value != 0)>(cm, K, dst, scr, r, lane, vb); }); };
    if (gw < NITEMS) load_a(gw);
    for (int it = gw; it < NITEMS; it += 2 * NGW) {
        if (it + NGW < NITEMS) load_b(it + NGW);
        store_a(it);
        if (it + 2 * NGW < NITEMS) load_a(it + 2 * NGW);
        if (it + NGW < NITEMS) store_b(it + NGW);
    }
}

__constant__ float kInvFreq[32] = {1.000000000e+00f, 7.498942018e-01f, 5.623413324e-01f, 4.216965139e-01f, 3.162277639e-01f, 2.371373922e-01f, 1.778279394e-01f, 1.333521456e-01f, 1.000000015e-01f, 7.498941571e-02f, 5.623412877e-02f, 4.216964915e-02f, 3.162277862e-02f, 2.371373586e-02f, 1.778279431e-02f, 1.333521493e-02f, 9.999999776e-03f, 7.498942316e-03f, 5.623413250e-03f, 4.216964822e-03f, 3.162277862e-03f, 2.371373819e-03f, 1.778279431e-03f, 1.333521446e-03f, 1.000000047e-03f, 7.498941850e-04f, 5.623413017e-04f, 4.216965463e-04f, 3.162277862e-04f, 2.371373848e-04f, 1.778279402e-04f, 1.333521504e-04f};
__device__ __forceinline__ void p0_prologue(Frame& F) {
    F.refresh();
    ArgP a = argp();
    LAS float* cond = (LAS float*)(F.lds);
    for (int i = F.tid; i < 4096; i += NTHREADS) cond[i] = siluf_(GIN(a, I_C)[i]);
    __syncthreads();
    float* modp = (float*)(F.ws + WS_MODP);
    const int gw = F.bid * NWAVES + F.wave, NGW = F.G * NWAVES;
    for (int it = gw; it < 2 * 96 * 8; it += NGW) {
        const int l = it / 768, r = it % 768, g = r >> 3, p = r & 7, col = g * 64 + F.lane;
        const float* w = GIN(a, I_MODW) + (size_t)l * 1024 * 6144 + (size_t)(p * 128) * 6144 + col;
        float s0 = 0.f, s1 = 0.f, s2 = 0.f, s3 = 0.f;
#pragma unroll 32
        for (int k = 0; k < 128; ++k) { const float wv = w[(size_t)k * 6144]; const int kk = p * 128 + k; s0 += cond[kk] * wv; s1 += cond[1024 + kk] * wv; s2 += cond[2048 + kk] * wv; s3 += cond[3072 + kk] * wv; }
        float* o = modp + ((size_t)(l * 8 + p) * 4) * 6144 + col;
        o[0] = s0; o[6144] = s1; o[2 * 6144] = s2; o[3 * 6144] = s3;
    }
    float* rc = (float*)(F.ws + WS_ROPE); float* rs = rc + 8192 * 32;
    for (int i = F.bid * NTHREADS + F.tid; i < 8192 * 32; i += F.G * NTHREADS) {
        const int pos = i >> 5, j = i & 31;
        const float invf = kInvFreq[j];
        const float angf = (float)pos * invf;
        const double x = (double)angf;
        const double kq = rint(x * 0.63661977236758134308);
        const double r = (x - kq * 1.57079632679489655800e+00) - kq * 6.12323399573676603587e-17;
        const double r2 = r * r;
        double sp = r * (1.0 + r2 * (-1.0 / 6 + r2 * (1.0 / 120 + r2 * (-1.0 / 5040 + r2 * (1.0 / 362880 + r2 * (-1.0 / 39916800 + r2 * (1.0 / 6227020800.0)))))));
        double cp = 1.0 + r2 * (-0.5 + r2 * (1.0 / 24 + r2 * (-1.0 / 720 + r2 * (1.0 / 40320 + r2 * (-1.0 / 3628800 + r2 * (1.0 / 479001600.0 + r2 * (-1.0 / 87178291200.0)))))));
        const int q = ((int)kq) & 3;
        const double sn = (q == 0) ? sp : (q == 1) ? cp : (q == 2) ? -sp : -cp;
        const double cs = (q == 0) ? cp : (q == 1) ? -sp : (q == 2) ? -cp : sp;
        rc[i] = (float)cs; rs[i] = (float)sn;
    }
}
__device__ __forceinline__ float mod_from_partials(ArgP a, const unsigned char* ws, int l, int b, int idx) {
    const float* modp = (const float*)(ws + WS_MODP);
    float s = GIN(a, I_MODB)[l * 6144 + idx];
#pragma unroll
    for (int p = 0; p < 8; ++p) s += modp[((size_t)(l * 8 + p) * 4 + b) * 6144 + idx];
    return s;
}

__device__ __forceinline__ bf16_t* xres(ArgP a, unsigned char* ws, int l) { return (l == DEPTH - 1) ? (bf16_t*)(ws + WS_S(4)) : (bf16_t*)GOUT(a); }
template <int MODE>
__device__ __forceinline__ void row_phase_norm1(Frame& F, int l) {
    F.refresh();
    ArgP a = argp();
    LAS float* tab = (LAS float*)(F.lds + LDSX_OFF);
    const int row0 = F.bid * 128, b = row0 / SEQ;
    for (int i = F.tid; i < 1024; i += NTHREADS) {
        const int p = ((((i >> 9) * 2 + ((i >> 2) & 1)) * 64 + ((i >> 3) & 63)) << 2) + (i & 3);
        const float* mf = (const float*)(F.ws + WS_MODF);
        if (MODE == 2) { tab[p] = GIN(a, I_FNG)[i]; }
        else if (MODE == 0) { tab[p] = GIN(a, I_N1G)[l * 1024 + i]; tab[1024 + p] = 1.f + mod_from_partials(a, F.ws, l, b, 1024 + i); tab[2048 + p] = mod_from_partials(a, F.ws, l, b, i); }
        else { tab[p] = GIN(a, I_N1G)[l * 1024 + i]; tab[1024 + p] = 1.f + mf[((size_t)l * 4 + b) * 6144 + 1024 + i]; tab[2048 + p] = mf[((size_t)l * 4 + b) * 6144 + i]; }
        if (MODE >= 1) tab[3072 + p] = mf[((size_t)((MODE == 2) ? DEPTH - 1 : l - 1) * 4 + b) * 6144 + 5 * 1024 + i];
    }
    __syncthreads();
    const float* xin32 = GIN(a, I_X);
    bf16_t* xb = (MODE == 2) ? xres(a, F.ws, DEPTH - 1) : xres(a, F.ws, l - 1);
    unsigned char* h1 = F.ws + WS_S(0);
    const unsigned char* oa = F.ws + WS_S(2);
    f32x4 xn[2][4]; u32x4 xq[2][2]; u32x2 pn0[2][2], pn1[2][2];
#define ROW_LOAD(S, rrow) do { _Pragma("unroll") for (int j = 0; j < 2; ++j) { \
            if (MODE == 0) { const f32x4* xr_ = (const f32x4*)(xin32 + (size_t)(rrow) * D) + 2 * F.lane + 128 * j; xn[S][2 * j] = xr_[0]; xn[S][2 * j + 1] = xr_[1]; } \
            else { xq[S][j] = *((const u32x4*)(xb + (size_t)(rrow) * D) + F.lane + 64 * j); pn0[S][j] = *((const u32x2*)(oa + (size_t)(2 * (rrow)) * D) + F.lane + 64 * j); pn1[S][j] = *((const u32x2*)(oa + (size_t)(2 * (rrow) + 1) * D) + F.lane + 64 * j); } } } while (0)
    ROW_LOAD(0, row0 + F.wave); ROW_LOAD(1, row0 + F.wave + NWAVES);
    auto body = [&](auto sl, int rr) __attribute__((always_inline)) {
        constexpr int S = decltype(sl)::value;
        const int row = row0 + rr;
        f32x4 v[4]; float ss = 0.f;
        if (MODE == 0) {
#pragma unroll
            for (int q = 0; q < 4; ++q) v[q] = xn[S][q];
        } else {
#pragma unroll
            for (int j = 0; j < 2; ++j) {
                const u32x4 xw = xq[S][j]; const u32x2 p0 = pn0[S][j], p1 = pn1[S][j];
                const f32x4 g0 = *(const LAS f32x4*)(tab + 3072 + (((j * 2 + 0) * 64 + F.lane) << 2)), g1 = *(const LAS f32x4*)(tab + 3072 + (((j * 2 + 1) * 64 + F.lane) << 2));
                const f32x2 a0 = __builtin_amdgcn_cvt_pk_f32_fp8(p0.x, false), a1 = __builtin_amdgcn_cvt_pk_f32_fp8(p0.x, true), a2 = __builtin_amdgcn_cvt_pk_f32_fp8(p0.y, false), a3 = __builtin_amdgcn_cvt_pk_f32_fp8(p0.y, true);
                const f32x2 b0 = __builtin_amdgcn_cvt_pk_f32_fp8(p1.x, false), b1 = __builtin_amdgcn_cvt_pk_f32_fp8(p1.x, true), b2 = __builtin_amdgcn_cvt_pk_f32_fp8(p1.y, false), b3 = __builtin_amdgcn_cvt_pk_f32_fp8(p1.y, true);
                v[2 * j].x = bf_lo(xw.x) + g0.x * (a0.x + b0.x); v[2 * j].y = bf_hi(xw.x) + g0.y * (a0.y + b0.y); v[2 * j].z = bf_lo(xw.y) + g0.z * (a1.x + b1.x); v[2 * j].w = bf_hi(xw.y) + g0.w * (a1.y + b1.y);
                v[2 * j + 1].x = bf_lo(xw.z) + g1.x * (a2.x + b2.x); v[2 * j + 1].y = bf_hi(xw.z) + g1.y * (a2.y + b2.y); v[2 * j + 1].z = bf_lo(xw.w) + g1.z * (a3.x + b3.x); v[2 * j + 1].w = bf_hi(xw.w) + g1.w * (a3.y + b3.y);
            }
        }
        if (rr + 2 * NWAVES < 128) ROW_LOAD(S, row + 2 * NWAVES);
#pragma unroll
        for (int q = 0; q < 4; ++q) ss += (v[q].x * v[q].x + v[q].y * v[q].y) + (v[q].z * v[q].z + v[q].w * v[q].w);
        const float rstd = rsqrtf(wave_sum(ss) * (1.f / D) + EPS);
#pragma unroll
        for (int j = 0; j < 2; ++j) {
            const f32x4 ga = *(const LAS f32x4*)(tab + (((j * 2 + 0) * 64 + F.lane) << 2)), gb = *(const LAS f32x4*)(tab + (((j * 2 + 1) * 64 + F.lane) << 2));
            const f32x4 va = v[2 * j], vb = v[2 * j + 1];
            if (MODE == 2) {
                f32x4 o0, o1; o0.x = va.x * rstd * ga.x; o0.y = va.y * rstd * ga.y; o0.z = va.z * rstd * ga.z; o0.w = va.w * rstd * ga.w; o1.x = vb.x * rstd * gb.x; o1.y = vb.y * rstd * gb.y; o1.z = vb.z * rstd * gb.z; o1.w = vb.w * rstd * gb.w;
                f32x4* op = (f32x4*)(GOUT(a) + (size_t)row * D) + 2 * F.lane + 128 * j; op[0] = o0; op[1] = o1;
            } else {
                if (MODE == 1) { u32x4 w; w.x = cvt_pk_bf16(va.x, va.y); w.y = cvt_pk_bf16(va.z, va.w); w.z = cvt_pk_bf16(vb.x, vb.y); w.w = cvt_pk_bf16(vb.z, vb.w); *((u32x4*)(xb + (size_t)row * D) + F.lane + 64 * j) = w; }
                const f32x4 sca = *(const LAS f32x4*)(tab + 1024 + (((j * 2 + 0) * 64 + F.lane) << 2)), scb = *(const LAS f32x4*)(tab + 1024 + (((j * 2 + 1) * 64 + F.lane) << 2));
                const f32x4 sha = *(const LAS f32x4*)(tab + 2048 + (((j * 2 + 0) * 64 + F.lane) << 2)), shb = *(const LAS f32x4*)(tab + 2048 + (((j * 2 + 1) * 64 + F.lane) << 2));
                u32x2 w8; w8.x = pk4_fp8(va.x * rstd * ga.x * sca.x + sha.x, va.y * rstd * ga.y * sca.y + sha.y, va.z * rstd * ga.z * sca.z + sha.z, va.w * rstd * ga.w * sca.w + sha.w);
                w8.y = pk4_fp8(vb.x * rstd * gb.x * scb.x + shb.x, vb.y * rstd * gb.y * scb.y + shb.y, vb.z * rstd * gb.z * scb.z + shb.z, vb.w * rstd * gb.w * scb.w + shb.w);
                *((u32x2*)(h1 + (size_t)row * D) + F.lane + 64 * j) = w8;
            }
        }
    };
    for (int rr = F.wave; rr < 128; rr += 2 * NWAVES) { body(IC<0>{}, rr); body(IC<1>{}, rr + NWAVES); }
#undef ROW_LOAD
}

__device__ __forceinline__ void row_phase_norm2_route(Frame& F, int l, bool do_append) {
    F.refresh();
    ArgP a = argp();
    LAS bf16_t* wtr16 = (LAS bf16_t*)(F.lds);
    LAS bf16_t* wtg16 = (LAS bf16_t*)(F.lds + 131072);
    LAS float* tab = (LAS float*)(F.lds + 147456);
    LAS float* cstW = (LAS float*)(F.lds + 155648);
    LAS float* cst = cstW + 8 * 48;
    LAS unsigned* cntL = (LAS unsigned*)(cst + 48);
    LAS unsigned* baseL = cntL + 32;
    LAS float* rstdL = (LAS float*)(baseL + 32);
    LAS unsigned* rsel = (LAS unsigned*)(rstdL + 128);
    LAS float* rw = (LAS float*)(rsel + 128);
    LAS float* lg = (LAS float*)(F.lds);
    const int row0 = F.bid * 128, b = row0 / SEQ;
    const float* modf = (const float*)(F.ws + WS_MODF) + ((size_t)l * 4 + b) * 6144;
    for (int i = F.tid; i < 1024; i += NTHREADS) { tab[i] = GIN(a, I_N2G)[l * 1024 + i] * (1.f + modf[4 * 1024 + i]); tab[1024 + i] = modf[3 * 1024 + i]; }
    if (F.tid < 32) cntL[F.tid] = 0u;
    __syncthreads();
    {
        float cj = 0.f, cg = 0.f;
        const float* wrt = GIN(a, I_WRT) + (size_t)l * 32768; const float* wgp = GIN(a, I_WGRP) + (size_t)l * 4096;
#pragma unroll 1
        for (int i0 = F.tid; i0 < 32 * 1024; i0 += NTHREADS * 16) {
            float wv[16];
#pragma unroll
            for (int q = 0; q < 16; ++q) wv[q] = wrt[i0 + NTHREADS * q];
#pragma unroll
            for (int q = 0; q < 16; ++q) { const int i = i0 + NTHREADS * q, k = i >> 5, j = i & 31; const float w = wv[q];
                cj += tab[1024 + k] * w;
                const float wp = w * tab[k]; const unsigned hb = cvt_pk_bf16(wp, 0.f) & 0xffffu, lb = cvt_pk_bf16(wp - __uint_as_float(hb << 16), 0.f) & 0xffffu;
                const int p = ((((((j >> 4) * 32 + (k >> 5)) * 2) * 4 + ((k >> 3) & 3)) * 16 + (j & 15)) << 3) + (k & 7);
                wtr16[p] = (bf16_t)hb; wtr16[p + 512] = (bf16_t)lb; }
        }
        { float wv[8];
#pragma unroll
          for (int q = 0; q < 8; ++q) wv[q] = wgp[F.tid + NTHREADS * q];
#pragma unroll
          for (int q = 0; q < 8; ++q) { const int i = F.tid + NTHREADS * q, k = i >> 2, j = i & 3; const float w = wv[q];
              cg += tab[1024 + k] * w;
              const float wp = w * tab[k]; const unsigned hb = cvt_pk_bf16(wp, 0.f) & 0xffffu, lb = cvt_pk_bf16(wp - __uint_as_float(hb << 16), 0.f) & 0xffffu;
              const int p = (((((k >> 5) * 2) * 4 + ((k >> 3) & 3)) * 4 + j) << 3) + (k & 7);
              wtg16[p] = (bf16_t)hb; wtg16[p + 128] = (bf16_t)lb; } }
        cj += __int_as_float(__builtin_amdgcn_ds_bpermute((F.lane ^ 32) << 2, __float_as_int(cj)));
#pragma unroll
        for (int o = 4; o < 64; o <<= 1) cg += __int_as_float(__builtin_amdgcn_ds_bpermute((F.lane ^ o) << 2, __float_as_int(cg)));
        if (F.lane < 32) cstW[F.wave * 48 + F.lane] = cj;
        if (F.lane < 4) cstW[F.wave * 48 + 32 + F.lane] = cg;
    }
    __syncthreads();
    if (F.tid < 36) {
        float s = (F.tid < 32) ? GIN(a, I_BRT)[l * 32 + F.tid] : GIN(a, I_BGRP)[l * 4 + F.tid - 32];
#pragma unroll
        for (int w = 0; w < 8; ++w) s += cstW[w * 48 + F.tid];
        cst[F.tid] = s;
    }
    f32x4 acc0 = {0.f, 0.f, 0.f, 0.f}, acc1 = acc0, acc2 = acc0; float ss = 0.f;
    {
        const bf16_t* xrow = xres(a, F.ws, l) + (size_t)(row0 + 16 * F.wave + (F.lane & 15)) * D + 8 * (F.lane >> 4);
        LAS const unsigned char* br0 = F.lds + (((F.lane >> 4) * 16 + (F.lane & 15)) << 4);
        LAS const unsigned char* bg0 = F.lds + 131072 + (((F.lane >> 4) * 4 + (F.lane & 3)) << 4);
        u32x4 xw[8];
#pragma unroll
        for (int s = 0; s < 8; ++s) xw[s] = *(const u32x4*)(xrow + 32 * s);
#pragma unroll 1
        for (int o = 0; o < 4; ++o) {
#pragma unroll
            for (int s = 0; s < 8; ++s) {
                const u32x4 cw = xw[s];
                if (o < 3) xw[s] = *(const u32x4*)(xrow + 32 * (8 * o + 8 + s));
                const f32x4 ca = {bf_lo(cw.x), bf_hi(cw.x), bf_lo(cw.y), bf_hi(cw.y)}, cb = {bf_lo(cw.z), bf_hi(cw.z), bf_lo(cw.w), bf_hi(cw.w)};
                const int step = 8 * o + s;
                const bf16x8 r0h = *(const LAS bf16x8*)(br0 + (step * 2 + 0) * 1024), r0l = *(const LAS bf16x8*)(br0 + (step * 2 + 1) * 1024);
                const bf16x8 r1h = *(const LAS bf16x8*)(br0 + ((32 + step) * 2 + 0) * 1024), r1l = *(const LAS bf16x8*)(br0 + ((32 + step) * 2 + 1) * 1024);
                const bf16x8 gh = *(const LAS bf16x8*)(bg0 + (step * 2 + 0) * 256), gl = *(const LAS bf16x8*)(bg0 + (step * 2 + 1) * 256);
                ss += (ca.x * ca.x + ca.y * ca.y) + (ca.z * ca.z + ca.w * ca.w) + (cb.x * cb.x + cb.y * cb.y) + (cb.z * cb.z + cb.w * cb.w);
                const bf16x8 av = *reinterpret_cast<const bf16x8*>(&cw);
                acc0 = __builtin_amdgcn_mfma_f32_16x16x32_bf16(av, r0h, acc0, 0, 0, 0); acc1 = __builtin_amdgcn_mfma_f32_16x16x32_bf16(av, r1h, acc1, 0, 0, 0); acc2 = __builtin_amdgcn_mfma_f32_16x16x32_bf16(av, gh, acc2, 0, 0, 0);
                acc0 = __builtin_amdgcn_mfma_f32_16x16x32_bf16(av, r0l, acc0, 0, 0, 0); acc1 = __builtin_amdgcn_mfma_f32_16x16x32_bf16(av, r1l, acc1, 0, 0, 0); acc2 = __builtin_amdgcn_mfma_f32_16x16x32_bf16(av, gl, acc2, 0, 0, 0);
            }
        }
    }
    ss += __int_as_float(__builtin_amdgcn_ds_bpermute((F.lane ^ 16) << 2, __float_as_int(ss)));
    ss += __int_as_float(__builtin_amdgcn_ds_bpermute((F.lane ^ 32) << 2, __float_as_int(ss)));
    const float rstd = rsqrtf(ss * (1.f / D) + EPS);
    __syncthreads();
    {
        LAS float* lr = lg + (16 * F.wave + 4 * (F.lane >> 4)) * 49 + (F.lane & 15);
        lr[0] = acc0.x; lr[49] = acc0.y; lr[98] = acc0.z; lr[147] = acc0.w;
        lr[16] = acc1.x; lr[16 + 49] = acc1.y; lr[16 + 98] = acc1.z; lr[16 + 147] = acc1.w;
        if ((F.lane & 15) < 4) { lr[32] = acc2.x; lr[32 + 49] = acc2.y; lr[32 + 98] = acc2.z; lr[32 + 147] = acc2.w; }
    }
    if (F.lane < 16) {
        const int r = 16 * F.wave + F.lane;
        LAS const float* lr = lg + r * 49;
        const float g0 = rstd * lr[32] + cst[32], g1 = rstd * lr[33] + cst[33], g2 = rstd * lr[34] + cst[34], g3 = rstd * lr[35] + cst[35];
        int grp = 0; float gm = g0; if (g1 > gm) { gm = g1; grp = 1; } if (g2 > gm) { gm = g2; grp = 2; } if (g3 > gm) { gm = g3; grp = 3; }
        const float pg = 1.f / (__expf(g0 - gm) + __expf(g1 - gm) + __expf(g2 - gm) + __expf(g3 - gm));
        float el[8];
#pragma unroll
        for (int e = 0; e < 8; ++e) el[e] = rstd * lr[grp * 8 + e] + cst[grp * 8 + e];
        int e1 = 0; float m1 = el[0];
#pragma unroll
        for (int e = 1; e < 8; ++e) if (el[e] > m1) { m1 = el[e]; e1 = e; }
        int e2 = -1; float m2 = -3.0e38f;
#pragma unroll
        for (int e = 0; e < 8; ++e) if (e != e1 && el[e] > m2) { m2 = el[e]; e2 = e; }
        const float p2 = __expf(m2 - m1), w1 = pg / (1.f + p2), w2 = pg * p2 / (1.f + p2);
        const unsigned ex1 = (unsigned)(grp * 8 + e1), ex2 = (unsigned)(grp * 8 + e2);
        const unsigned q1 = __hip_atomic_fetch_add(cntL + ex1, 1u, __ATOMIC_RELAXED, __HIP_MEMORY_SCOPE_WORKGROUP);
        const unsigned q2 = __hip_atomic_fetch_add(cntL + ex2, 1u, __ATOMIC_RELAXED, __HIP_MEMORY_SCOPE_WORKGROUP);
        rsel[r] = ex1 | (ex2 << 8) | (q1 << 16) | (q2 << 24); rw[r] = w1; rw[128 + r] = w2; rstdL[r] = rstd;
    }
    __syncthreads();
    unsigned* cnt = ((unsigned*)F.ws) + CW_CNT + l * 32 * 64;
    if (F.tid < 32 && do_append) { const unsigned n = cntL[F.tid]; baseL[F.tid] = n ? atomicAdd(&cnt[F.tid * 64], n) : 0u; }
    __syncthreads();
    if (F.tid < 256 && do_append) {
        unsigned* ldest = (unsigned*)(F.ws + WS_LDEST); float* lw = (float*)(F.ws + WS_LW);
        const int r = F.tid >> 1, k = F.tid & 1; const unsigned sel = rsel[r];
        const unsigned ex = (sel >> (8 * k)) & 0xffu, pos = baseL[ex] + ((sel >> (16 + 8 * k)) & 0xffu);
        ldest[(size_t)ex * T + pos] = (unsigned)(2 * (row0 + r) + k); lw[(size_t)ex * T + pos] = rw[128 * k + r];
    }
    unsigned char* h2 = F.ws + WS_S(0);
    const bf16_t* xb = xres(a, F.ws, l);
    u32x4 xn[2][2];
#pragma unroll
    for (int j = 0; j < 2; ++j) { xn[0][j] = *((const u32x4*)(xb + (size_t)(row0 + F.wave) * D) + F.lane + 64 * j); xn[1][j] = *((const u32x4*)(xb + (size_t)(row0 + F.wave + NWAVES) * D) + F.lane + 64 * j); }
    auto body = [&](auto sl, int rr) __attribute__((always_inline)) {
        constexpr int S = decltype(sl)::value;
        const int row = row0 + rr;
        u32x4 v[2];
#pragma unroll
        for (int j = 0; j < 2; ++j) v[j] = xn[S][j];
        if (rr + 2 * NWAVES < 128) {
#pragma unroll
            for (int j = 0; j < 2; ++j) xn[S][j] = *((const u32x4*)(xb + (size_t)(row + 2 * NWAVES) * D) + F.lane + 64 * j); }
        const float rs = rstdL[rr];
#pragma unroll
        for (int j = 0; j < 2; ++j) {
            const f32x4 ga = *(const LAS f32x4*)(tab + 8 * F.lane + 512 * j), gb = *(const LAS f32x4*)(tab + 8 * F.lane + 512 * j + 4), sa = *(const LAS f32x4*)(tab + 1024 + 8 * F.lane + 512 * j), sb = *(const LAS f32x4*)(tab + 1024 + 8 * F.lane + 512 * j + 4);
            u32x2 o; o.x = pk4_fp8(bf_lo(v[j].x) * rs * ga.x + sa.x, bf_hi(v[j].x) * rs * ga.y + sa.y, bf_lo(v[j].y) * rs * ga.z + sa.z, bf_hi(v[j].y) * rs * ga.w + sa.w);
            o.y = pk4_fp8(bf_lo(v[j].z) * rs * gb.x + sb.x, bf_hi(v[j].z) * rs * gb.y + sb.y, bf_lo(v[j].w) * rs * gb.z + sb.z, bf_hi(v[j].w) * rs * gb.w + sb.w);
            *((u32x2*)(h2 + (size_t)row * D) + F.lane + 64 * j) = o;
        }
    };
    for (int rr = F.wave; rr < 128; rr += 2 * NWAVES) { body(IC<0>{}, rr); body(IC<1>{}, rr + NWAVES); }
}

struct MoeOrder {
    static constexpr bool F8 = false; static constexpr int scaleA = 127, scaleB = 127;
    const char* A; const char* B; int G, c, K, lda, ldb, npn; const LAS int* pfx;
    const unsigned* ldest;
    __device__ __forceinline__ bool next(int i, pg8::Unit& u) const {
        const int L = i * G + ((c & 7) * (G >> 3) + (c >> 3));
        const int ntl = __builtin_amdgcn_readfirstlane(pfx[32]); if (L >= ntl * npn) return false;
        const int tile = L / npn; u.pn = L % npn; u.pm = tile;
        int e = 0;
#pragma unroll
        for (int j = 1; j < 32; ++j) e += (tile >= __builtin_amdgcn_readfirstlane(pfx[j])) ? 1 : 0;
        u.e = e; u.r0 = (tile - __builtin_amdgcn_readfirstlane(pfx[e])) * 256; const int n = __builtin_amdgcn_readfirstlane(pfx[33 + e]) - u.r0; u.nv = n < 256 ? n : 256; u.aux = 0; return true;
    }
};
struct MoeOrderUp : MoeOrder {
    static constexpr bool GATHER = true, F8 = true; static constexpr int scaleA = 127, scaleB = W8_E8M0;
    __device__ __forceinline__ const char* abase(const pg8::Unit&) const { return A; }
    __device__ __forceinline__ const char* bbase(const pg8::Unit& u) const { return B + ((size_t)u.e * 512 + (size_t)u.pn * 256) * 1024; }
    __device__ __forceinline__ unsigned arow(const pg8::Unit& u, int r) const { const int rr = r < u.nv ? r : 0; return ldest[(size_t)u.e * T + u.r0 + rr] >> 1; }
};
struct MoeOrderDn : MoeOrder {
    static constexpr bool GATHER = false, F8 = true; static constexpr int scaleA = 127 - 4, scaleB = W8_E8M0;
    __device__ __forceinline__ const char* abase(const pg8::Unit& u) const { return A + (size_t)u.pm * 256 * 256; }
    __device__ __forceinline__ const char* bbase(const pg8::Unit& u) const { return B + ((size_t)u.e * 1024 + (size_t)u.pn * 256) * 256; }
    __device__ __forceinline__ unsigned arow(const pg8::Unit&, int r) const { return (unsigned)r; }
};
struct EpiMoeUp {
    static constexpr bool PERM = true, STATE = false;
    bf16_t* act;
    __device__ __forceinline__ void operator()(const f32x4 (&acc)[2][2][4][2], const pg8::Unit& u, int wr, int wc, int fr, int fq) const {
#pragma unroll
        for (int ai = 0; ai < 2; ++ai)
#pragma unroll
            for (int m = 0; m < 4; ++m) {
                const int rl = ai * 128 + wr * 64 + m * 16 + fr;
                const f32x4 g0 = acc[ai][0][m][0], g1 = acc[ai][0][m][1], u0 = acc[ai][1][m][0] * 16.f, u1 = acc[ai][1][m][1] * 16.f;
                u32x2 w; w.x = pk4_fp8(siluf_(g0.x) * u0.x, siluf_(g0.y) * u0.y, siluf_(g0.z) * u0.z, siluf_(g0.w) * u0.w);
                w.y = pk4_fp8(siluf_(g1.x) * u1.x, siluf_(g1.y) * u1.y, siluf_(g1.z) * u1.z, siluf_(g1.w) * u1.w);
                *(u32x2*)((unsigned char*)act + ((size_t)u.pm * 256 + rl) * 256 + u.pn * 128 + wc * 32 + 8 * fq) = w;
            }
    }
};
struct EpiMoeDn {
    static constexpr bool PERM = true, STATE = false;
    bf16_t* oa; const unsigned* ldest; const float* lw;
    __device__ __forceinline__ void operator()(const f32x4 (&acc)[2][2][4][2], const pg8::Unit& u, int wr, int wc, int fr, int fq) const {
        unsigned dv[8]; float wv[8];
#pragma unroll
        for (int k = 0; k < 8; ++k) { const int rl = (k >> 2) * 128 + wr * 64 + (k & 3) * 16 + fr; const int rc = rl < u.nv ? rl : 0; dv[k] = ldest[(size_t)u.e * T + u.r0 + rc]; wv[k] = lw[(size_t)u.e * T + u.r0 + rc]; }
#pragma unroll
        for (int ai = 0; ai < 2; ++ai)
#pragma unroll
            for (int m = 0; m < 4; ++m) {
                const int rl = ai * 128 + wr * 64 + m * 16 + fr;
                if (rl < u.nv) {
                    const unsigned dest = dv[ai * 4 + m]; const float w = wv[ai * 4 + m];
#pragma unroll
                    for (int bj = 0; bj < 2; ++bj) {
                        const f32x4 v0 = acc[ai][bj][m][0] * w, v1 = acc[ai][bj][m][1] * w;
                        u32x2 o; o.x = pk4_fp8(v0.x, v0.y, v0.z, v0.w); o.y = pk4_fp8(v1.x, v1.y, v1.z, v1.w);
                        *(u32x2*)((unsigned char*)oa + (size_t)dest * 1024 + u.pn * 256 + bj * 128 + wc * 32 + 8 * fq) = o;
                    }
                }
            }
    }
};
__device__ __forceinline__ void moe_prefix(Frame& F, int l) {
    F.refresh();
    LAS int* pfx = (LAS int*)(F.lds + LDSCTL_OFF + 64);
    if (F.wave == 0) {
        const int e = F.lane & 31;
        const int c = (int)__hip_atomic_load(((unsigned*)F.ws) + CW_CNT + (l * 32 + e) * 64, __ATOMIC_RELAXED, __HIP_MEMORY_SCOPE_AGENT);
        int incl = (F.lane < 32) ? ((c + 255) >> 8) : 0; const int mine = incl;
#pragma unroll
        for (int o = 1; o < 32; o <<= 1) { const int t = __builtin_amdgcn_ds_bpermute((F.lane - o) << 2, incl); if (F.lane >= o) incl += t; }
        if (F.lane < 32) { pfx[e] = incl - mine; pfx[33 + e] = c; if (F.lane == 31) pfx[32] = incl; }
    }
    __syncthreads();
}


template <bool ST, class V> __device__ __forceinline__ void st_or_keep(V* p, const V& w) { if (ST) *p = w; else asm volatile("" :: "v"(w)); }
template <bool ST>
struct EpiInProjT {
    static constexpr bool PERM = true, STATE = false;
    unsigned char* ws; const float* rope;
    __device__ __forceinline__ void operator()(const f32x4 (&acc)[2][2][4][2], const pg8::Unit& u, int wr, int wc, int fr, int fq) const {
        const unsigned r0 = (unsigned)(wr * 64 + fr);
        const size_t rowu = (size_t)u.pm * 256;
#pragma unroll
        for (int bj = 0; bj < 2; ++bj) {
            const int colw = u.pn * 256 + bj * 128 + wc * 32;
            if (colw < 2048) {
                unsigned char* base = ws + (colw < 1024 ? WS_S(1) : WS_S(2)) + (rowu * 1024 + (size_t)(colw & 1023)) * 2;
                const unsigned lo = (r0 * 1024u + 8u * fq) * 2u;
#pragma unroll
                for (int ai = 0; ai < 2; ++ai)
#pragma unroll
                    for (int m = 0; m < 4; ++m) { const f32x4 v0 = acc[ai][bj][m][0], v1 = acc[ai][bj][m][1];
                        u32x4 w; w.x = cvt_pk_bf16(v0.x, v0.y); w.y = cvt_pk_bf16(v0.z, v0.w); w.z = cvt_pk_bf16(v1.x, v1.y); w.w = cvt_pk_bf16(v1.z, v1.w);
                        st_or_keep<ST>((u32x4*)(base + (lo + (unsigned)(ai * 128 + m * 16) * 2048u)), w); }
            } else if (colw < 3072) {
                unsigned char* base = ws + WS_S(3) + (rowu * 1024 + (size_t)(colw - 2048)) * 2;
                const unsigned lo = (r0 * 1024u + 8u * fq) * 2u;
#pragma unroll
                for (int ai = 0; ai < 2; ++ai)
#pragma unroll
                    for (int m = 0; m < 4; ++m) { const f32x4 v0 = acc[ai][bj][m][0], v1 = acc[ai][bj][m][1];
                        u32x4 w; w.x = cvt_pk_bf16(sigmoidf_(v0.x), sigmoidf_(v0.y)); w.y = cvt_pk_bf16(sigmoidf_(v0.z), sigmoidf_(v0.w)); w.z = cvt_pk_bf16(sigmoidf_(v1.x), sigmoidf_(v1.y)); w.w = cvt_pk_bf16(sigmoidf_(v1.z), sigmoidf_(v1.w));
                        st_or_keep<ST>((u32x4*)(base + (lo + (unsigned)(ai * 128 + m * 16) * 2048u)), w); }
            } else if (colw >= 3456 && colw < 3712) {
                unsigned char* base = ws + WS_CKV + rowu * 256 + (size_t)(colw - 3456);
                const unsigned lo = r0 * 256u + 8u * fq;
#pragma unroll
                for (int ai = 0; ai < 2; ++ai)
#pragma unroll
                    for (int m = 0; m < 4; ++m) { const f32x4 v0 = acc[ai][bj][m][0], v1 = acc[ai][bj][m][1];
                        u32x2 w; w.x = pk4_fp8(v0.x, v0.y, v0.z, v0.w); w.y = pk4_fp8(v1.x, v1.y, v1.z, v1.w);
                        st_or_keep<ST>((u32x2*)(base + (lo + (unsigned)(ai * 128 + m * 16) * 256u)), w); }
            } else if (colw < 3456) {
                unsigned char* base = ws + WS_CQ + rowu * 512 + (size_t)(colw - 3072);
                const unsigned lo = r0 * 512u + 8u * fq;
#pragma unroll
                for (int ai = 0; ai < 2; ++ai)
#pragma unroll
                    for (int m = 0; m < 4; ++m) { const f32x4 v0 = acc[ai][bj][m][0], v1 = acc[ai][bj][m][1];
                        u32x2 w; w.x = pk4_fp8(v0.x, v0.y, v0.z, v0.w); w.y = pk4_fp8(v1.x, v1.y, v1.z, v1.w);
                        st_or_keep<ST>((u32x2*)(base + (lo + (unsigned)(ai * 128 + m * 16) * 512u)), w); }
            } else if (colw < 3776) {
                const int c = colw - 3712 + 8 * fq;
#pragma unroll
                for (int ai = 0; ai < 2; ++ai) {
                    f32x4 csv[4], snv[4];
#pragma unroll
                    for (int m = 0; m < 4; ++m) { const int pos = (u.pm * 256 + ai * 128 + m * 16 + (int)r0) & (SEQ - 1); csv[m] = *(const f32x4*)(rope + pos * 32 + (c >> 1)); snv[m] = *(const f32x4*)(rope + 8192 * 32 + pos * 32 + (c >> 1)); }
#pragma unroll
                    for (int m = 0; m < 4; ++m) { const f32x4 v0 = acc[ai][bj][m][0], v1 = acc[ai][bj][m][1];
                        const int row = u.pm * 256 + ai * 128 + m * 16 + (int)r0;
                        const f32x4 cs = csv[m], sn = snv[m];
                        u32x2 w; w.x = pk4_fp8(v0.x * cs.x - v0.y * sn.x, v0.x * sn.x + v0.y * cs.x, v0.z * cs.y - v0.w * sn.y, v0.z * sn.y + v0.w * cs.y);
                        w.y = pk4_fp8(v1.x * cs.z - v1.y * sn.z, v1.x * sn.z + v1.y * cs.z, v1.z * cs.w - v1.w * sn.w, v1.z * sn.w + v1.w * cs.w);
                        st_or_keep<ST>((u32x2*)(ws + WS_KR + (size_t)row * 64 + c), w); }
                }
            } else if (colw == 3776) {
                if (fq == 0) {
#pragma unroll
                    for (int ai = 0; ai < 2; ++ai)
#pragma unroll
                        for (int m = 0; m < 4; ++m) { const int row = u.pm * 256 + ai * 128 + m * 16 + (int)r0; float* ifg = (float*)(ws + WS_IFG) + (size_t)row * 8;
                            st_or_keep<ST>((f32x4*)ifg, acc[ai][bj][m][0]); st_or_keep<ST>((f32x4*)(ifg + 4), acc[ai][bj][m][1]); }
                }
            }
        }
    }
};
using EpiInProj = EpiInProjT<true>;
struct EpiNull { static constexpr bool PERM = true, STATE = false;
    __device__ __forceinline__ void operator()(const f32x4 (&acc)[2][2][4][2], const pg8::Unit& u, int wr, int wc, int fr, int fq) const {
#pragma unroll
        for (int ai = 0; ai < 2; ++ai)
#pragma unroll
            for (int bj = 0; bj < 2; ++bj)
#pragma unroll
                for (int m = 0; m < 4; ++m)
#pragma unroll
                    for (int n = 0; n < 2; ++n) asm volatile("" :: "v"(acc[ai][bj][m][n])); } };
struct EpiUq {
    static constexpr bool PERM = true, STATE = false;
    unsigned char* ws; const float* rope;
    __device__ __forceinline__ void operator()(const f32x4 (&acc)[2][2][4][2], const pg8::Unit& u, int wr, int wc, int fr, int fq) const {
        unsigned char* qn = ws + WS_S(1); unsigned char* qr = ws + WS_S(2); const float* rstd = (const float*)(ws + WS_RSTD);
        float rsv[8];
#pragma unroll
        for (int k = 0; k < 8; ++k) rsv[k] = rstd[u.pm * 256 + (k >> 2) * 128 + wr * 64 + (k & 3) * 16 + fr];
        if (u.pn < 4) {
            EPI8_LOOP({
                const float rs = rsv[ai * 4 + m];
                u32x2 w; w.x = pk4_fp8(v0.x * rs, v0.y * rs, v0.z * rs, v0.w * rs); w.y = pk4_fp8(v1.x * rs, v1.y * rs, v1.z * rs, v1.w * rs);
                *(u32x2*)(qn + (size_t)row * 1024 + col) = w;
            })
        } else {
#pragma unroll
            for (int ai = 0; ai < 2; ++ai) {
                f32x4 csv[4][2], snv[4][2];
#pragma unroll
                for (int m = 0; m < 4; ++m)
#pragma unroll
                    for (int bj = 0; bj < 2; ++bj) { const int row = u.pm * 256 + ai * 128 + wr * 64 + m * 16 + fr, p = (bj * 128 + wc * 32 + 8 * fq) & 63, pos = row & (SEQ - 1);
                        csv[m][bj] = *(const f32x4*)(rope + pos * 32 + (p >> 1)); snv[m][bj] = *(const f32x4*)(rope + 8192 * 32 + pos * 32 + (p >> 1)); }
#pragma unroll
                for (int m = 0; m < 4; ++m)
#pragma unroll
                    for (int bj = 0; bj < 2; ++bj) { const int row = u.pm * 256 + ai * 128 + wr * 64 + m * 16 + fr, c = (u.pn - 4) * 256 + bj * 128 + wc * 32 + 8 * fq; const float rs = rsv[ai * 4 + m];
                        const f32x4 v0 = acc[ai][bj][m][0], v1 = acc[ai][bj][m][1], cs = csv[m][bj] * rs, sn = snv[m][bj] * rs;
                        u32x2 w; w.x = pk4_fp8(v0.x * cs.x - v0.y * sn.x, v0.x * sn.x + v0.y * cs.x, v0.z * cs.y - v0.w * sn.y, v0.z * sn.y + v0.w * cs.y);
                        w.y = pk4_fp8(v1.x * cs.z - v1.y * sn.z, v1.x * sn.z + v1.y * cs.z, v1.z * cs.w - v1.w * sn.w, v1.z * sn.w + v1.w * cs.w);
                        *(u32x2*)(qr + (size_t)row * 512 + c) = w; }
            }
        }
    }
};
struct EpiUkv {
    static constexpr bool PERM = true, STATE = false;
    unsigned char* ws;
    __device__ __forceinline__ void operator()(const f32x4 (&acc)[2][2][4][2], const pg8::Unit& u, int wr, int wc, int fr, int fq) const {
        unsigned char* kn = ws + WS_S(4); unsigned char* va = ws + WS_S(5); const float* rstd = (const float*)(ws + WS_RSTD) + T;
        float rsv[8];
#pragma unroll
        for (int k = 0; k < 8; ++k) rsv[k] = rstd[u.pm * 256 + (k >> 2) * 128 + wr * 64 + (k & 3) * 16 + fr];
        EPI8_LOOP({
            const float rs = rsv[ai * 4 + m];
            if (col < 1024) { u32x2 w; w.x = pk4_fp8(v0.x * rs, v0.y * rs, v0.z * rs, v0.w * rs); w.y = pk4_fp8(v1.x * rs, v1.y * rs, v1.z * rs, v1.w * rs); *(u32x2*)(kn + (size_t)row * 1024 + col) = w; }
            else { u32x2 w; w.x = pk4_fp8(v0.x * rs, v0.y * rs, v0.z * rs, v0.w * rs); w.y = pk4_fp8(v1.x * rs, v1.y * rs, v1.z * rs, v1.w * rs); *(u32x2*)(va + (size_t)row * 1024 + (col - 1024)) = w; }
        })
    }
};
__device__ __forceinline__ void row_phase_stats(Frame& F) {
    F.refresh();
    unsigned char* cq = F.ws + WS_CQ; const unsigned char* ckv = F.ws + WS_CKV; float* rstd = (float*)(F.ws + WS_RSTD);
    const int row0 = F.bid * 128;
#pragma unroll 1
    for (int hb = 0; hb < 2; ++hb) {
        unsigned wq[8][2]; unsigned wk2[8];
#pragma unroll
        for (int i = 0; i < 8; ++i) { const int row = row0 + F.wave + NWAVES * (hb * 8 + i); unsigned* p = (unsigned*)(cq + (size_t)row * 512) + F.lane;
            wq[i][0] = p[0]; wq[i][1] = (F.lane < 32) ? p[64] : 0u;
            if (F.lane >= 32) p[64] = 0u;
            wk2[i] = *((const unsigned*)(ckv + (size_t)row * 256) + F.lane); }
#pragma unroll
        for (int i = 0; i < 8; ++i) { const int row = row0 + F.wave + NWAVES * (hb * 8 + i);
            float s = 0.f;
#pragma unroll
            for (int j = 0; j < 2; ++j) { const f32x2 a = __builtin_amdgcn_cvt_pk_f32_fp8(wq[i][j], false), b = __builtin_amdgcn_cvt_pk_f32_fp8(wq[i][j], true); s += (a.x * a.x + a.y * a.y) + (b.x * b.x + b.y * b.y); }
            const f32x2 k0 = __builtin_amdgcn_cvt_pk_f32_fp8(wk2[i], false), k1 = __builtin_amdgcn_cvt_pk_f32_fp8(wk2[i], true);
            float s2 = (k0.x * k0.x + k0.y * k0.y) + (k1.x * k1.x + k1.y * k1.y);
            s = wave_sum(s); s2 = wave_sum(s2);
            if (F.lane == 0) { rstd[row] = rsqrtf(s * (1.f / 384.f) + EPS); rstd[T + row] = rsqrtf(s2 * (1.f / 256.f) + EPS); } }
    }
}
struct MergeOrder {
    static constexpr bool GATHER = false, F8 = true; static constexpr int scaleA = 127, scaleB = W8_E8M0;
    const unsigned char* ws; int G, c, K, lda, ldb, pass0;
    __device__ __forceinline__ bool next(int i, pg8::Unit& u) const { const int npass = 4 - pass0, j = i / npass, L = j * G + c; if (L >= 512) return false; pg8::tile_of(L, 128, 4, u.pm, u.pn); u.aux = pass0 + i % npass; return true; }
    __device__ __forceinline__ const char* abase(const pg8::Unit& u) const { const size_t off = (u.aux == 1) ? WS_S(0) + 32 * MiB : (u.aux == 3) ? WS_S(3) : WS_S(0); return (const char*)ws + off + (size_t)u.pm * 256 * 1024; }
    __device__ __forceinline__ const char* bbase(const pg8::Unit& u) const { const size_t off = (u.aux == 0) ? W_GM : (u.aux == 1) ? W_M : (u.aux == 2) ? W_GA : W_A; return (const char*)ws + WS_W + off + (size_t)u.pn * 256 * 1024; }
    __device__ __forceinline__ unsigned arow(const pg8::Unit&, int r) const { return (unsigned)r; }
};
struct EpiMerge {
    static constexpr bool PERM = true, STATE = true;
    unsigned char* ws; int has_t;
    __device__ __forceinline__ void operator()(const f32x4 (&acc)[2][2][4][2], const pg8::Unit& u, int wr, int wc, int fr, int fq, unsigned (&st)[32]) const {
        bf16_t* t2 = (bf16_t*)(ws + WS_S(2));
        const int pass = u.aux;
#pragma unroll
        for (int ah = 0; ah < 4; ++ah) { const int ai = ah >> 1;
            u32x4 tv[4][2];
            if (pass == 3 && has_t) {
#pragma unroll
                for (int m = 2 * (ah & 1); m < 2 * (ah & 1) + 2; ++m)
#pragma unroll
                    for (int bj = 0; bj < 2; ++bj) tv[m][bj] = *(const u32x4*)(t2 + (size_t)(u.pm * 256 + ai * 128 + wr * 64 + m * 16 + fr) * 1024 + u.pn * 256 + bj * 128 + wc * 32 + 8 * fq);
            }
#pragma unroll
            for (int m = 2 * (ah & 1); m < 2 * (ah & 1) + 2; ++m) { asm volatile("" ::: "memory"); const int row = u.pm * 256 + ai * 128 + wr * 64 + m * 16 + fr;
#pragma unroll
                for (int bj = 0; bj < 2; ++bj) { const int col = u.pn * 256 + bj * 128 + wc * 32 + 8 * fq; const size_t o = (size_t)row * 1024 + col; const int si = ((ai * 4 + m) * 2 + bj) * 2;
                    f32x4 a0 = acc[ai][bj][m][0], a1 = acc[ai][bj][m][1];
                    if (pass == 0 || pass == 2) {
                        st[si] = pk4_fp8(sigmoidf_(a0.x), sigmoidf_(a0.y), sigmoidf_(a0.z), sigmoidf_(a0.w)); st[si + 1] = pk4_fp8(sigmoidf_(a1.x), sigmoidf_(a1.y), sigmoidf_(a1.z), sigmoidf_(a1.w));
                    } else {
                        const f32x2 g0 = __builtin_amdgcn_cvt_pk_f32_fp8(st[si], false), g1 = __builtin_amdgcn_cvt_pk_f32_fp8(st[si], true), g2 = __builtin_amdgcn_cvt_pk_f32_fp8(st[si + 1], false), g3 = __builtin_amdgcn_cvt_pk_f32_fp8(st[si + 1], true);
                        a0.x *= g0.x; a0.y *= g0.y; a0.z *= g1.x; a0.w *= g1.y; a1.x *= g2.x; a1.y *= g2.y; a1.z *= g3.x; a1.w *= g3.y;
                        if (pass == 1) { u32x4 w; w.x = cvt_pk_bf16(a0.x, a0.y); w.y = cvt_pk_bf16(a0.z, a0.w); w.z = cvt_pk_bf16(a1.x, a1.y); w.w = cvt_pk_bf16(a1.z, a1.w); *(u32x4*)(t2 + o) = w; }
                        else { if (has_t) { const u32x4 tt = tv[m][bj];
                                a0.x += bf_lo(tt.x); a0.y += bf_hi(tt.x); a0.z += bf_lo(tt.y); a0.w += bf_hi(tt.y); a1.x += bf_lo(tt.z); a1.y += bf_hi(tt.z); a1.z += bf_lo(tt.w); a1.w += bf_hi(tt.w); }
                            u32x2 w8; w8.x = pk4_fp8(a0.x, a0.y, a0.z, a0.w); w8.y = pk4_fp8(a1.x, a1.y, a1.z, a1.w); *(u32x2*)(ws + WS_S(5) + o) = w8; }
                    }
                } }
        }
    }
};
struct EpiOut {
    static constexpr bool PERM = true, STATE = false;
    const float* xin32; const bf16_t* xin16; bf16_t* xo; const float* gate; bool do_store;
    __device__ __forceinline__ void operator()(const f32x4 (&acc)[2][2][4][2], const pg8::Unit& u, int wr, int wc, int fr, int fq) const {
        const float* g = gate + (size_t)((u.pm * 256) / SEQ) * 6144;
        f32x4 gv[2][2];
#pragma unroll
        for (int bj = 0; bj < 2; ++bj) { const int col = u.pn * 256 + bj * 128 + wc * 32 + 8 * fq; gv[bj][0] = *(const f32x4*)(g + col); gv[bj][1] = *(const f32x4*)(g + col + 4); }
#pragma unroll
        for (int ai = 0; ai < 2; ++ai) {
            asm volatile("" ::: "memory");
            if (xin32) {
#pragma unroll
                for (int mp = 0; mp < 2; ++mp) {
                    f32x4 xr[2][2][2];
#pragma unroll
                    for (int mm = 0; mm < 2; ++mm)
#pragma unroll
                        for (int bj = 0; bj < 2; ++bj) { const int row = u.pm * 256 + ai * 128 + wr * 64 + (mp * 2 + mm) * 16 + fr, col = u.pn * 256 + bj * 128 + wc * 32 + 8 * fq; const size_t o = (size_t)row * 1024 + col;
                            xr[mm][bj][0] = *(const f32x4*)(xin32 + o); xr[mm][bj][1] = *(const f32x4*)(xin32 + o + 4); }
#pragma unroll
                    for (int mm = 0; mm < 2; ++mm)
#pragma unroll
                        for (int bj = 0; bj < 2; ++bj) { const int m = mp * 2 + mm; const int row = u.pm * 256 + ai * 128 + wr * 64 + m * 16 + fr, col = u.pn * 256 + bj * 128 + wc * 32 + 8 * fq; const size_t o = (size_t)row * 1024 + col;
                            const f32x4 x0 = xr[mm][bj][0] + gv[bj][0] * acc[ai][bj][m][0], x1 = xr[mm][bj][1] + gv[bj][1] * acc[ai][bj][m][1];
                            u32x4 w; w.x = cvt_pk_bf16(x0.x, x0.y); w.y = cvt_pk_bf16(x0.z, x0.w); w.z = cvt_pk_bf16(x1.x, x1.y); w.w = cvt_pk_bf16(x1.z, x1.w);
                            if (do_store) *(u32x4*)(xo + o) = w; else asm volatile("" :: "v"(w)); }
                    asm volatile("" ::: "memory");
                }
            } else {
                u32x4 xr[4][2];
#pragma unroll
                for (int m = 0; m < 4; ++m)
#pragma unroll
                    for (int bj = 0; bj < 2; ++bj) { const int row = u.pm * 256 + ai * 128 + wr * 64 + m * 16 + fr, col = u.pn * 256 + bj * 128 + wc * 32 + 8 * fq; xr[m][bj] = *(const u32x4*)(xin16 + (size_t)row * 1024 + col); }
#pragma unroll
                for (int m = 0; m < 4; ++m)
#pragma unroll
                    for (int bj = 0; bj < 2; ++bj) { const int row = u.pm * 256 + ai * 128 + wr * 64 + m * 16 + fr, col = u.pn * 256 + bj * 128 + wc * 32 + 8 * fq; const size_t o = (size_t)row * 1024 + col; const u32x4 t = xr[m][bj];
                        f32x4 x0 = {bf_lo(t.x), bf_hi(t.x), bf_lo(t.y), bf_hi(t.y)}, x1 = {bf_lo(t.z), bf_hi(t.z), bf_lo(t.w), bf_hi(t.w)};
                        x0 = x0 + gv[bj][0] * acc[ai][bj][m][0]; x1 = x1 + gv[bj][1] * acc[ai][bj][m][1];
                        u32x4 w; w.x = cvt_pk_bf16(x0.x, x0.y); w.y = cvt_pk_bf16(x0.z, x0.w); w.z = cvt_pk_bf16(x1.x, x1.y); w.w = cvt_pk_bf16(x1.z, x1.w);
                        if (do_store) *(u32x4*)(xo + o) = w; else asm volatile("" :: "v"(w)); }
            }
        }
    }
};


namespace att {
constexpr int KVBLK = 64;
constexpr float SCALE = 0.07216878364870322f;
constexpr float THR = 3.2f;
constexpr int P8_E8M0 = 127 - 4;
constexpr int SHM_V = 64 * 128, SHM_K = 64 * 192, OFF_K = 3 * SHM_V, OFF_WS = OFF_K + 3 * SHM_K;
static_assert(OFF_WS + 2048 <= 90112, "attention LDS layout");
#define KSWZ(row, colB) ((row) * 384 + ((colB) ^ (((row) & 7) << 4)))
#define SBAR() __builtin_amdgcn_sched_barrier(0)
__device__ __forceinline__ int crow(int r, int hi) { return (r & 3) + 8 * (r >> 2) + 4 * hi; }
__device__ __forceinline__ void partialSM(f32x16& p0, f32x16& p1, float& m_reg, float& mn, float& alpha, bool vis) {
  constexpr float C = SCALE * 1.4426950408889634f;
  float pmax = p0[0];
#pragma unroll
  for (int r = 1; r < 16; ++r) pmax = fmaxf(pmax, p0[r]);
#pragma unroll
  for (int r = 0; r < 16; ++r) pmax = fmaxf(pmax, p1[r]);
  { auto rr = __builtin_amdgcn_permlane32_swap(__float_as_uint(pmax), __float_as_uint(pmax), false, false);
    pmax = fmaxf(__uint_as_float(rr[0]), __uint_as_float(rr[1])); }
  pmax = vis ? pmax : -1e30f;
  if (__builtin_expect(__all(pmax - m_reg <= THR / SCALE), 1)) { mn = m_reg; alpha = 1.f; }
  else { mn = fmaxf(m_reg, pmax); alpha = __builtin_amdgcn_exp2f((m_reg - mn) * C); m_reg = mn; }
  const float mnC = vis ? 4.f - mn * C : -1e30f;
#pragma unroll
  for (int r = 0; r < 16; ++r) p0[r] = fmaf(p0[r], C, mnC);
#pragma unroll
  for (int r = 0; r < 16; ++r) p1[r] = fmaf(p1[r], C, mnC);
#pragma unroll
  for (int r = 0; r < 16; ++r) p0[r] = __builtin_amdgcn_exp2f(p0[r]);
}
__device__ __forceinline__ void finishSM(f32x16& p0, f32x16& p1, float alpha, float& l_reg, i32x8& P8) {
#pragma unroll
  for (int r = 0; r < 16; ++r) p1[r] = __builtin_amdgcn_exp2f(p1[r]);
  float ps = 0;
#pragma unroll
  for (int r = 0; r < 16; ++r) ps += p0[r];
#pragma unroll
  for (int r = 0; r < 16; ++r) ps += p1[r];
  { auto rr = __builtin_amdgcn_permlane32_swap(__float_as_uint(ps), __float_as_uint(ps), false, false);
    ps = __uint_as_float(rr[0]) + __uint_as_float(rr[1]); }
  l_reg = l_reg * alpha + ps * 0.0625f;
#pragma unroll
  for (int w = 0; w < 4; ++w) { P8[w] = (int)pk4_fp8(p0[4 * w], p0[4 * w + 1], p0[4 * w + 2], p0[4 * w + 3]); P8[4 + w] = (int)pk4_fp8(p1[4 * w], p1[4 * w + 1], p1[4 * w + 2], p1[4 * w + 3]); }
}
__device__ __forceinline__ void qkt(f32x16& p0, f32x16& p1, const char* Ks, const i32x8* qf, int kb0, int kb1) {
#pragma unroll
  for (int r = 0; r < 16; ++r) { p0[r] = 0.f; p1[r] = 0.f; }
#pragma unroll
  for (int st = 0; st < 3; ++st) {
    const u32x4 a0 = *reinterpret_cast<const u32x4*>(Ks + kb0 + st * 64), a1 = *reinterpret_cast<const u32x4*>(Ks + kb1 + st * 64);
    const u32x4 b0 = *reinterpret_cast<const u32x4*>(Ks + 6144 + kb0 + st * 64), b1 = *reinterpret_cast<const u32x4*>(Ks + 6144 + kb1 + st * 64);
    const i32x8 ka = {(int)a0.x, (int)a0.y, (int)a0.z, (int)a0.w, (int)a1.x, (int)a1.y, (int)a1.z, (int)a1.w}, kb = {(int)b0.x, (int)b0.y, (int)b0.z, (int)b0.w, (int)b1.x, (int)b1.y, (int)b1.z, (int)b1.w};
    p0 = __builtin_amdgcn_mfma_scale_f32_32x32x64_f8f6f4(ka, qf[st], p0, 0, 0, 0, 127, 0, 127);
    p1 = __builtin_amdgcn_mfma_scale_f32_32x32x64_f8f6f4(kb, qf[st], p1, 0, 0, 0, 127, 0, 127); }
}
__device__ __forceinline__ int v_st(int k, int c) { const int kk = (k & ~0xC) | ((k & 4) << 1) | ((k & 8) >> 1); return ((kk >> 3) * 4 + (c >> 5)) * 512 + ((kk & 7) * 32 + (c & 31)) * 2; }
__device__ __forceinline__ int v_rd_base(int lane) { return ((lane & 3) << 3) | (((lane >> 2) & 3) << 6) | (((lane >> 4) & 1) << 5) | (((lane >> 5) & 1) << 8); }
constexpr int v_rd_off(int d0, int ks, int half) { return d0 * 512 + ks * 4096 + half * 2048; }
template <int OFF> __device__ __forceinline__ s16x4 tr_read(int vb) {
  s16x4 r; asm volatile("ds_read_b64_tr_b16 %0, %1 offset:%2" : "=&v"(r) : "v"(vb), "i"(OFF) : "memory"); return r;
}
template <int D0> __device__ __forceinline__ void pv_one(f32x16& od, int vb, bf16x8 pa0, bf16x8 pa1, bf16x8 pa2, bf16x8 pa3) {
  const s16x4 l0 = tr_read<v_rd_off(D0, 0, 0)>(vb), h0 = tr_read<v_rd_off(D0, 0, 1)>(vb), l1 = tr_read<v_rd_off(D0, 1, 0)>(vb), h1 = tr_read<v_rd_off(D0, 1, 1)>(vb);
  const s16x4 l2 = tr_read<v_rd_off(D0, 2, 0)>(vb), h2 = tr_read<v_rd_off(D0, 2, 1)>(vb), l3 = tr_read<v_rd_off(D0, 3, 0)>(vb), h3 = tr_read<v_rd_off(D0, 3, 1)>(vb);
  asm volatile("s_waitcnt lgkmcnt(0)" ::: "memory"); SBAR();
#define PK(L, H) (bf16x8){L[0], L[1], L[2], L[3], H[0], H[1], H[2], H[3]}
  od = __builtin_amdgcn_mfma_f32_32x32x16_bf16(pa0, PK(l0, h0), od, 0, 0, 0);
  od = __builtin_amdgcn_mfma_f32_32x32x16_bf16(pa1, PK(l1, h1), od, 0, 0, 0);
  od = __builtin_amdgcn_mfma_f32_32x32x16_bf16(pa2, PK(l2, h2), od, 0, 0, 0);
  od = __builtin_amdgcn_mfma_f32_32x32x16_bf16(pa3, PK(l3, h3), od, 0, 0, 0);
#undef PK
}
template <int OFF> __device__ __forceinline__ u32x2 tr8_read(int vb) {
  u32x2 r; asm volatile("ds_read_b64_tr_b8 %0, %1 offset:%2" : "=&v"(r) : "v"(vb), "i"(OFF) : "memory"); return r;
}
__device__ __forceinline__ void pv8_one(f32x16& od, int vb, const i32x8& P8) {
  const u32x2 r0 = tr8_read<0>(vb), r1 = tr8_read<2048>(vb), r2 = tr8_read<4096>(vb), r3 = tr8_read<6144>(vb);
  asm volatile("s_waitcnt lgkmcnt(0)" ::: "memory"); SBAR();
  const i32x8 vf = {(int)r0.x, (int)r0.y, (int)r1.x, (int)r1.y, (int)r2.x, (int)r2.y, (int)r3.x, (int)r3.y};
  od = __builtin_amdgcn_mfma_scale_f32_32x32x64_f8f6f4(P8, vf, od, 0, 0, 0, P8_E8M0, 0, 127);
}
__device__ __forceinline__ void pv8(f32x16* o, const int (&vbd)[4], int soff, const i32x8& P8) {
  u32x2 r[4][4];
#pragma unroll
  for (int d = 0; d < 2; ++d) { const int vb = vbd[d] + soff; r[d][0] = tr8_read<0>(vb); r[d][1] = tr8_read<2048>(vb); r[d][2] = tr8_read<4096>(vb); r[d][3] = tr8_read<6144>(vb); }
#pragma unroll
  for (int d = 2; d < 4; ++d) { const int vb = vbd[d] + soff; r[d][0] = tr8_read<0>(vb); r[d][1] = tr8_read<2048>(vb); r[d][2] = tr8_read<4096>(vb); r[d][3] = tr8_read<6144>(vb); }
  asm volatile("s_waitcnt lgkmcnt(8)" ::: "memory"); SBAR();
#pragma unroll
  for (int d = 0; d < 2; ++d) { const i32x8 vf = {(int)r[d][0].x, (int)r[d][0].y, (int)r[d][1].x, (int)r[d][1].y, (int)r[d][2].x, (int)r[d][2].y, (int)r[d][3].x, (int)r[d][3].y};
    o[d] = __builtin_amdgcn_mfma_scale_f32_32x32x64_f8f6f4(P8, vf, o[d], 0, 0, 0, P8_E8M0, 0, 127); }
  asm volatile("s_waitcnt lgkmcnt(0)" ::: "memory"); SBAR();
#pragma unroll
  for (int d = 2; d < 4; ++d) { const i32x8 vf = {(int)r[d][0].x, (int)r[d][0].y, (int)r[d][1].x, (int)r[d][1].y, (int)r[d][2].x, (int)r[d][2].y, (int)r[d][3].x, (int)r[d][3].y};
    o[d] = __builtin_amdgcn_mfma_scale_f32_32x32x64_f8f6f4(P8, vf, o[d], 0, 0, 0, P8_E8M0, 0, 127); }
}
__device__ __forceinline__ void pv_d0(f32x16* o, int vb, bf16x8 pa0, bf16x8 pa1, bf16x8 pa2, bf16x8 pa3) {
  pv_one<0>(o[0], vb, pa0, pa1, pa2, pa3); pv_one<1>(o[1], vb, pa0, pa1, pa2, pa3); pv_one<2>(o[2], vb, pa0, pa1, pa2, pa3); pv_one<3>(o[3], vb, pa0, pa1, pa2, pa3);
}
__device__ __forceinline__ void attn_unit(const unsigned char* __restrict__ Qn, const unsigned char* __restrict__ Qr, const unsigned char* __restrict__ Kn, const unsigned char* __restrict__ Kr, const unsigned char* __restrict__ Vv,
                                          unsigned char* __restrict__ Ob, int qb, char* lds, bool do_store, int wave0) {
  const int tid = tid_opaque(wave0), wid = wave0, lane = tid & 63, r32 = lane & 31, hi = lane >> 5;
  char* V_lds = lds; char* K_lds = lds + OFF_K;
  float* wsf = (float*)(lds + OFF_WS) + wid * 64; float* li_l = wsf; float* al_l = wsf + 32;
  float m_reg = -1e30f, l_reg = 0; f32x16 o[4]; i32x8 qf[3];
#pragma unroll
  for (int d = 0; d < 4; ++d)
#pragma unroll
    for (int r = 0; r < 16; ++r) o[d][r] = 0.f;
  { const unsigned char* Qw = Qn + (size_t)(wid * 32 + r32) * 1024 + hi * 32; const unsigned char* Qw2 = Qr + (size_t)(wid * 32 + r32) * 512 + hi * 32;
#pragma unroll
    for (int st = 0; st < 3; ++st) { const unsigned char* p = (st < 2) ? Qw + st * 64 : Qw2; const u32x4 x0 = *reinterpret_cast<const u32x4*>(p), x1 = *reinterpret_cast<const u32x4*>(p + 16);
      qf[st] = (i32x8){(int)x0.x, (int)x0.y, (int)x0.z, (int)x0.w, (int)x1.x, (int)x1.y, (int)x1.z, (int)x1.w}; } }
  const int NT = 4 * qb + 4, myq = 4 * qb + (wid >> 1);
  const int krow = tid >> 3, kc = tid & 7, ksw = (krow >> 2) & 3;
  const int vst0 = krow * 128 + ((kc ^ (2 * (((krow >> 1) & 1) | (((krow >> 3) & 1) << 1)))) << 4);
  const int kst0 = krow * 192 + ((kc ^ ksw) * 16), kst2 = krow * 192 + ((8 + ((kc & 3) ^ ksw)) * 16);
  int vbd[4];
  { const int g = lane >> 4, ll = lane & 15, jj = ll >> 1, cc = ll & 1, kr_l = 4 * (g >> 1) + (jj < 4 ? jj : jj + 4), fl = ((kr_l >> 1) & 1) | (((kr_l >> 3) & 1) << 1);
#pragma unroll
    for (int d = 0; d < 4; ++d) vbd[d] = (int)(uintptr_t)V_lds + kr_l * 128 + ((2 * (d ^ fl) + (g & 1)) << 4) + 8 * cc; }
  const int qsw = (r32 >> 2) & 3, kb0 = r32 * 192 + (((2 * hi) ^ qsw) * 16), kb1 = r32 * 192 + (((2 * hi + 1) ^ qsw) * 16);
  u32x4 vs0, ks0, ks2;
  const unsigned voV = (unsigned)(krow * 1024 + kc * 16), voK = (unsigned)(krow * 1024 + kc * 16), voR = (unsigned)(krow * 64 + (kc & 3) * 16);
#define SLOAD(k0) do { const char* vb_ = (const char*)(Vv + (size_t)(k0) * 1024); const char* kb_ = (const char*)(Kn + (size_t)(k0) * 1024); const char* rb_ = (const char*)(Kr + (size_t)(k0) * 64); \
    vs0 = *reinterpret_cast<const u32x4*>(vb_ + voV); \
    ks0 = *reinterpret_cast<const u32x4*>(kb_ + voK); ks2 = *reinterpret_cast<const u32x4*>(rb_ + voR); } while (0)
#define SWRITE(b) do { *(u32x4*)(V_lds + (b) * SHM_V + vst0) = vs0; \
    *(u32x4*)(K_lds + (b) * SHM_K + kst0) = ks0; if (kc < 4) *(u32x4*)(K_lds + (b) * SHM_K + kst2) = ks2; } while (0)
#define RESC(a) do { if (__any((a) < 1.f)) { if (hi == 0) al_l[r32] = (a); asm volatile("s_waitcnt lgkmcnt(0)" ::: "memory"); \
    _Pragma("unroll") for (int d = 0; d < 4; ++d) _Pragma("unroll") for (int r = 0; r < 16; ++r) o[d][r] *= al_l[crow(r, hi)]; } } while (0)
  f32x16 pA0, pA1, pB0, pB1; float mnA, mnB, alA, alB; i32x8 P8;
  const int lastk = (NT - 1) * KVBLK;
#define TILE_K0(t) (((t) < NT ? (t) : NT - 1) * KVBLK)
  {
    u32x4 v1_, k1_, r1_;
    { const char* vb_ = (const char*)(Vv + (size_t)TILE_K0(1) * 1024); const char* kb_ = (const char*)(Kn + (size_t)TILE_K0(1) * 1024); const char* rb_ = (const char*)(Kr + (size_t)TILE_K0(1) * 64);
      v1_ = *reinterpret_cast<const u32x4*>(vb_ + voV); k1_ = *reinterpret_cast<const u32x4*>(kb_ + voK); r1_ = *reinterpret_cast<const u32x4*>(rb_ + voR); }
    SLOAD(0); SWRITE(0);
    *(u32x4*)(V_lds + 1 * SHM_V + vst0) = v1_; *(u32x4*)(K_lds + 1 * SHM_K + kst0) = k1_; if (kc < 4) *(u32x4*)(K_lds + 1 * SHM_K + kst2) = r1_;
    SLOAD(TILE_K0(2)); }
  __syncthreads();
  qkt(pA0, pA1, K_lds, qf, kb0, kb1); partialSM(pA0, pA1, m_reg, mnA, alA, true);
  int b0 = 0, b1 = 1, b2 = 2;
  for (int j = 1; j + 1 < NT; j += 2) {
    SBAR(); qkt(pB0, pB1, K_lds + b1 * SHM_K, qf, kb0, kb1);
    finishSM(pA0, pA1, alA, l_reg, P8); SBAR();
    pv8(o, vbd, b0 * SHM_V, P8);
    partialSM(pB0, pB1, m_reg, mnB, alB, j <= myq);
    SWRITE(b2); SLOAD(TILE_K0(j + 2));
    RESC(alB); __syncthreads();
    SBAR(); qkt(pA0, pA1, K_lds + b2 * SHM_K, qf, kb0, kb1);
    finishSM(pB0, pB1, alB, l_reg, P8); SBAR();
    pv8(o, vbd, b1 * SHM_V, P8);
    partialSM(pA0, pA1, m_reg, mnA, alA, j + 1 <= myq);
    SWRITE(b0); SLOAD(TILE_K0(j + 3));
    RESC(alA); __syncthreads();
    { const int t0 = b0; b0 = b2; b2 = b1; b1 = t0; }
  }
  (void)lastk;
  SBAR(); qkt(pB0, pB1, K_lds + b1 * SHM_K, qf, kb0, kb1);
  finishSM(pA0, pA1, alA, l_reg, P8); SBAR();
  pv8(o, vbd, b0 * SHM_V, P8);
  partialSM(pB0, pB1, m_reg, mnB, alB, NT - 1 <= myq);
  RESC(alB);
  finishSM(pB0, pB1, alB, l_reg, P8); SBAR();
  pv8(o, vbd, b1 * SHM_V, P8);
#undef TILE_K0
  if (hi == 0) li_l[r32] = l_reg; asm volatile("s_waitcnt lgkmcnt(0)" ::: "memory");
  { char* Os = lds + 90112 + wid * 4096;
#pragma unroll
    for (int r = 0; r < 16; ++r) { const int orow = crow(r, hi); const float rl = __builtin_amdgcn_rcpf(li_l[orow]);
#pragma unroll
      for (int d0 = 0; d0 < 4; ++d0) { const float x = o[d0][r] * rl; *(unsigned char*)(Os + orow * 128 + d0 * 32 + r32) = (unsigned char)(__builtin_amdgcn_cvt_pk_fp8_f32(x, x, 0, false) & 0xff); } }
    asm volatile("s_waitcnt lgkmcnt(0)" ::: "memory");
    unsigned char* Ow = Ob + (size_t)(wid * 32) * 1024;
#pragma unroll
    for (int k = 0; k < 4; ++k) { const int ch = lane + 64 * k, row = ch >> 3, c16 = ch & 7; const u32x4 v = *(const u32x4*)(Os + row * 128 + c16 * 16);
      if (do_store) *(u32x4*)(Ow + (size_t)row * 1024 + c16 * 16) = v; else asm volatile("" :: "v"(v)); } }
  __syncthreads();
#undef SLOAD
#undef SWRITE
#undef SWAIT
#undef RESC
}
}
constexpr int NBH = 16, NCH = 128;
__device__ __forceinline__ float wave_incl_sum(float v, int lane) {
#pragma unroll
    for (int o = 1; o < 64; o <<= 1) { const float t = __int_as_float(__builtin_amdgcn_ds_bpermute((lane - o) << 2, __float_as_int(v))); if (lane >= o) v += t; }
    return v;
}
__device__ __forceinline__ float wave_incl_max(float v, int lane) {
#pragma unroll
    for (int o = 1; o < 64; o <<= 1) { const float t = __int_as_float(__builtin_amdgcn_ds_bpermute((lane - o) << 2, __float_as_int(v))); if (lane >= o) v = fmaxf(v, t); }
    return v;
}
__device__ __forceinline__ void conv_table(LAS float* cwl, const float* cw, const float* cb, int tid) {
    float t[10];
#pragma unroll
    for (int q = 0; q < 8; ++q) t[q] = cw[tid + NTHREADS * q];
#pragma unroll
    for (int q = 0; q < 2; ++q) t[8 + q] = cb[tid + NTHREADS * q];
#pragma unroll
    for (int q = 0; q < 8; ++q) cwl[tid + NTHREADS * q] = t[q];
#pragma unroll
    for (int q = 0; q < 2; ++q) cwl[4096 + tid + NTHREADS * q] = t[8 + q];
}
__device__ __forceinline__ void conv8(const u32x4 (&x)[4], int s_abs, const LAS float* cwl, int ch, float scale, float (&out)[8]) {
    float acc[8];
    { const f32x4 b0 = *(const LAS f32x4*)(cwl + 4096 + ch), b1 = *(const LAS f32x4*)(cwl + 4096 + ch + 4); acc[0] = b0.x; acc[1] = b0.y; acc[2] = b0.z; acc[3] = b0.w; acc[4] = b1.x; acc[5] = b1.y; acc[6] = b1.z; acc[7] = b1.w; }
#pragma unroll
    for (int j = 0; j < 4; ++j) {
        const float m = (s_abs - 3 + j >= 0) ? 1.f : 0.f;
        const f32x4 w0 = *(const LAS f32x4*)(cwl + j * 1024 + ch) * m, w1 = *(const LAS f32x4*)(cwl + j * 1024 + ch + 4) * m;
        acc[0] += w0.x * bf_lo(x[j].x); acc[1] += w0.y * bf_hi(x[j].x); acc[2] += w0.z * bf_lo(x[j].y); acc[3] += w0.w * bf_hi(x[j].y);
        acc[4] += w1.x * bf_lo(x[j].z); acc[5] += w1.y * bf_hi(x[j].z); acc[6] += w1.z * bf_lo(x[j].w); acc[7] += w1.w * bf_hi(x[j].w);
    }
#pragma unroll
    for (int i = 0; i < 8; ++i) out[i] = siluf_(acc[i]) * scale;
}
__device__ __forceinline__ void conv_load(const bf16_t* raw, int s_abs, u32x4 (&x)[4]) {
#pragma unroll
    for (int j = 0; j < 4; ++j) x[j] = *(const u32x4*)(raw + (ptrdiff_t)((s_abs - 3 + j >= 0) ? (j - 3) : 0) * 1024);
}
#define KSW256(row, colB) ((row) * 256 + ((colB) ^ (((row) & 7) << 4)))
#define CSW256(row, colB) ((row) * 256 + ((colB) ^ (((row) & 15) << 4)))
__device__ __forceinline__ void attn_phase(Frame& F, bool do_store) {
    const unsigned char* qn = F.ws + WS_S(1); const unsigned char* qr = F.ws + WS_S(2); const unsigned char* kn = F.ws + WS_S(4); const unsigned char* va = F.ws + WS_S(5);
    const unsigned char* kr = F.ws + WS_KR;
    const int vcu = (F.G % 8 == 0) ? (F.bid % 8) * (F.G / 8) + F.bid / 8 : F.bid;
    for (int it = 0; it < 4; ++it) {
        const int P = vcu + (it >> 1) * F.G; if (P >= 512) break;
        const int bh = P >> 4, i = P & 15, qb = (it & 1) ? i : 31 - i, b = bh >> 3, h = bh & 7;
        const size_t row0 = (size_t)b * SEQ + (size_t)qb * 256, key0 = (size_t)b * SEQ;
        att::attn_unit(qn + row0 * 1024 + h * 128, qr + row0 * 512 + h * 64, kn + key0 * 1024 + h * 128, kr + key0 * 64, va + key0 * 1024 + h * 128, F.ws + WS_S(3) + row0 * 1024 + h * 128, qb, (char*)F.lds, do_store, F.wave);
    }
}


constexpr int NGRP = 16, GCH = 8;
__device__ __forceinline__ void mlstm_gates_local(Frame& F, int l) {
    F.refresh();
    ArgP a = argp();
    const float* ifg = (const float*)(F.ws + WS_IFG); float* GT = (float*)(F.ws + WS_GATE); float* CH = (float*)(F.ws + WS_CHK);
    for (int gw = F.bid * NWAVES + F.wave; gw < NBH * NCH; gw += F.G * NWAVES) {
        const int bh = gw >> 7, c = gw & 127, b = bh >> 2, h = bh & 3, s = c * 64 + F.lane; const size_t t = (size_t)b * SEQ + s;
        const float li = ifg[t * 8 + h] + GIN(a, I_IGB)[l * 4 + h], x = ifg[t * 8 + 4 + h] + GIN(a, I_FGB)[l * 4 + h];
        const float lf = fminf(x, 0.f) - log1pf(__expf(-fabsf(x)));
        const float bc = wave_incl_sum(lf, F.lane), ct = li - bc, pm = wave_incl_max(ct, F.lane);
        GT[(size_t)bh * SEQ + s] = bc; GT[(size_t)(NBH + bh) * SEQ + s] = ct; GT[(size_t)(2 * NBH + bh) * SEQ + s] = pm;
        if (F.lane == 63) { CH[bh * NCH + c] = bc; CH[2048 + bh * NCH + c] = bc + pm; }
    }
}
__device__ __forceinline__ void mlstm_mtab(LAS float* mt, const float* CH, int bh, int tid) {
    if (tid < 64) {
        const int lane = tid;
        const float a0 = CH[bh * NCH + 2 * lane], b0 = CH[2048 + bh * NCH + 2 * lane], a1 = CH[bh * NCH + 2 * lane + 1], b1 = CH[2048 + bh * NCH + 2 * lane + 1];
        float A = a0 + a1, B = fmaxf(b0 + a1, b1);
#pragma unroll
        for (int o = 1; o < 64; o <<= 1) {
            const float Ap = __int_as_float(__builtin_amdgcn_ds_bpermute((lane - o) << 2, __float_as_int(A))), Bp = __int_as_float(__builtin_amdgcn_ds_bpermute((lane - o) << 2, __float_as_int(B)));
            if (lane >= o) { B = fmaxf(Bp + A, B); A = Ap + A; }
        }
        const float Ae = __int_as_float(__builtin_amdgcn_ds_bpermute((lane - 1) << 2, __float_as_int(A))), Be = __int_as_float(__builtin_amdgcn_ds_bpermute((lane - 1) << 2, __float_as_int(B)));
        const float m0 = (lane == 0) ? 0.f : fmaxf(Ae, Be), m1 = fmaxf(a0 + m0, b0), m2 = fmaxf(a1 + m1, b1);
        mt[2 * lane] = m0; mt[128 + 2 * lane] = m1; mt[256 + 2 * lane] = __expf(a0 + m0 - m1);
        mt[2 * lane + 1] = m1; mt[128 + 2 * lane + 1] = m2; mt[256 + 2 * lane + 1] = __expf(a1 + m1 - m2);
    }
}
#define PK8(L, H) (bf16x8){L[0], L[1], L[2], L[3], H[0], H[1], H[2], H[3]}
__device__ __forceinline__ void mlstm_group_state(Frame& F, int l) {
    F.refresh();
    ArgP a = argp();
    char* lds = (char*)F.lds; char* Vimg = lds; char* KWimg = lds + 32768; char* Ut = lds + 49152;
    LAS float* gx = (LAS float*)(F.lds + LDSX_OFF); LAS float* mt = gx + 704; LAS float* cwl = (LAS float*)(F.lds + LDSX_OFF + 4608); LAS float* npart = (LAS float*)(F.lds + LDSX_OFF + 25088);
    const bf16_t* qk = (const bf16_t*)(F.ws + WS_S(1)); const bf16_t* vm = (const bf16_t*)(F.ws + WS_S(2)); bf16_t* Gs = (bf16_t*)(F.ws + WS_S(4));
    const float* GT = (const float*)(F.ws + WS_GATE); const float* CH = (const float*)(F.ws + WS_CHK); float* Dg = (float*)(F.ws + WS_CHK + 16384); float* gn = (float*)(F.ws + WS_CHK + 32768);
    const int tid = F.tid, lane = F.lane, wid = F.wave, r32 = lane & 31, hi = lane >> 5;
    bf16_t* kcv = (bf16_t*)GOUT(a) + (size_t)T * 1024;
    conv_table(cwl, GIN(a, I_CONVW) + (size_t)l * 4096, GIN(a, I_CONVB) + (size_t)l * 1024, tid);
    for (int u = F.bid; u < NBH * NGRP; u += F.G) {
        const int bh = u >> 4, g = u & 15, b = bh >> 2, h = bh & 3;
        bf16x8 xv[4]; u32x4 xk[2][4]; float gch, gct;
#define GA_LOADS(cidx) do { const int sr_ = tid >> 4, sc_ = (tid & 15) * 8, srow_ = tid >> 3; const size_t tk_ = (size_t)b * SEQ + (size_t)(cidx) * 64; \
            _Pragma("unroll") for (int img = 0; img < 2; ++img) _Pragma("unroll") for (int hf = 0; hf < 2; ++hf) xv[img * 2 + hf] = *(const bf16x8*)(vm + (tk_ + sr_ + 32 * hf) * 1024 + h * 256 + img * 128 + sc_); \
            _Pragma("unroll") for (int hf = 0; hf < 2; ++hf) conv_load(qk + (tk_ + srow_) * 1024 + 512 + h * 128 + (tid & 7) * 8 + 64 * hf, (cidx) * 64 + srow_, xk[hf]); \
            gch = CH[bh * NCH + (cidx)]; gct = GT[(size_t)(NBH + bh) * SEQ + (cidx) * 64 + srow_]; } while (0)
        GA_LOADS(g * GCH);
        __syncthreads();
        mlstm_mtab(mt, CH, bh, tid);
        __syncthreads();
        f32x16 acc[4]; float nacc = 0.f, dprod = 1.f;
#pragma unroll
        for (int j = 0; j < 4; ++j)
#pragma unroll
            for (int r = 0; r < 16; ++r) acc[j][r] = 0.f;
#pragma unroll 1
        for (int cc = 0; cc < GCH; ++cc) {
            const int c = g * GCH + cc;
            { const int sr = tid >> 4, sc = (tid & 15) * 8, srow = tid >> 3;
              const float wk = __expf(gch + gct - mt[128 + c]);
#pragma unroll
              for (int img = 0; img < 2; ++img)
#pragma unroll
                for (int hf = 0; hf < 2; ++hf) *(bf16x8*)(Vimg + img * 16384 + att::v_st(sr + 32 * hf, sc)) = xv[img * 2 + hf];
#pragma unroll
              for (int hf = 0; hf < 2; ++hf) { const int d = (tid & 7) * 8 + 64 * hf; float o[8];
                conv8(xk[hf], c * 64 + srow, cwl, 512 + h * 128 + d, 1.f, o);
                u32x4 w; w.x = cvt_pk_bf16(o[0], o[1]); w.y = cvt_pk_bf16(o[2], o[3]); w.z = cvt_pk_bf16(o[4], o[5]); w.w = cvt_pk_bf16(o[6], o[7]);
                *(u32x4*)(kcv + ((size_t)b * SEQ + (size_t)c * 64 + srow) * 512 + h * 128 + d) = w;
                w.x = cvt_pk_bf16(o[0] * wk, o[1] * wk); w.y = cvt_pk_bf16(o[2] * wk, o[3] * wk); w.z = cvt_pk_bf16(o[4] * wk, o[5] * wk); w.w = cvt_pk_bf16(o[6] * wk, o[7] * wk);
                *(u32x4*)(KWimg + att::v_st(srow, d)) = w; } }
            __syncthreads();
            { const int cn = (cc + 1 < GCH) ? c + 1 : c; GA_LOADS(cn); }
            const float dec = mt[256 + c];
#pragma unroll
            for (int j = 0; j < 4; ++j)
#pragma unroll
                for (int r = 0; r < 16; ++r) acc[j][r] *= dec;
            { const int vbV = (int)(uintptr_t)(Vimg + (wid >> 2) * 16384) + att::v_rd_base(lane) + (wid & 3) * 512, vbK = (int)(uintptr_t)KWimg + att::v_rd_base(lane);
#define GASTEP(KS) do { \
                const s16x4 al = att::tr_read<att::v_rd_off(0, KS, 0)>(vbV), ah = att::tr_read<att::v_rd_off(0, KS, 1)>(vbV); \
                const s16x4 l0 = att::tr_read<att::v_rd_off(0, KS, 0)>(vbK), h0 = att::tr_read<att::v_rd_off(0, KS, 1)>(vbK), l1 = att::tr_read<att::v_rd_off(1, KS, 0)>(vbK), h1 = att::tr_read<att::v_rd_off(1, KS, 1)>(vbK); \
                const s16x4 l2 = att::tr_read<att::v_rd_off(2, KS, 0)>(vbK), h2 = att::tr_read<att::v_rd_off(2, KS, 1)>(vbK), l3 = att::tr_read<att::v_rd_off(3, KS, 0)>(vbK), h3 = att::tr_read<att::v_rd_off(3, KS, 1)>(vbK); \
                asm volatile("s_waitcnt lgkmcnt(0)" ::: "memory"); SBAR(); \
                const bf16x8 af = PK8(al, ah); \
                acc[0] = __builtin_amdgcn_mfma_f32_32x32x16_bf16(af, PK8(l0, h0), acc[0], 0, 0, 0); acc[1] = __builtin_amdgcn_mfma_f32_32x32x16_bf16(af, PK8(l1, h1), acc[1], 0, 0, 0); \
                acc[2] = __builtin_amdgcn_mfma_f32_32x32x16_bf16(af, PK8(l2, h2), acc[2], 0, 0, 0); acc[3] = __builtin_amdgcn_mfma_f32_32x32x16_bf16(af, PK8(l3, h3), acc[3], 0, 0, 0); } while (0)
              GASTEP(0); GASTEP(1); GASTEP(2); GASTEP(3);
#undef GASTEP
            }
            { float sacc = 0.f; const int dq = tid & 127, kq = (tid >> 7) * 16;
#pragma unroll
              for (int k = 0; k < 16; ++k) sacc += bf1(*(const bf16_t*)(KWimg + att::v_st(kq + k, dq & ~7) + (dq & 7) * 2));
              npart[tid] = sacc; }
            dprod *= dec;
            __syncthreads();
            if (tid < 128) nacc = dec * nacc + ((npart[tid] + npart[128 + tid]) + (npart[256 + tid] + npart[384 + tid]));
        }
#pragma unroll
        for (int j = 0; j < 4; ++j)
#pragma unroll
            for (int r = 0; r < 16; ++r) *(bf16_t*)(Ut + (wid * 32 + att::crow(r, hi)) * 272 + (j * 32 + r32) * 2) = (bf16_t)(cvt_pk_bf16(acc[j][r], 0.f) & 0xffffu);
        if (tid < 128) gn[(size_t)(bh * NGRP + g) * 128 + tid] = nacc;
        if (tid == 0) Dg[bh * NGRP + g] = dprod;
        __syncthreads();
        { bf16_t* Go = Gs + (size_t)(bh * NGRP + g) * 32768;
#pragma unroll
          for (int k = 0; k < 8; ++k) { const int p = tid + 512 * k, row = p >> 4, ck = p & 15; *(u32x4*)(Go + (size_t)row * 128 + ck * 8) = *(const u32x4*)(Ut + row * 272 + ck * 16); } }
    }
}
__device__ __forceinline__ void mlstm_group_scan(Frame& F) {
    F.refresh();
    const float* Dg = (const float*)(F.ws + WS_CHK + 16384);
    for (int gid = F.bid * NTHREADS + F.tid; gid < NBH * 8192; gid += F.G * NTHREADS) {
        const int bh = gid >> 13, e4 = gid & 8191;
        bf16_t* Gs = (bf16_t*)(F.ws + WS_S(4)) + (size_t)bh * NGRP * 32768 + (size_t)e4 * 4;
        u32x2 uu[NGRP];
#pragma unroll
        for (int k = 0; k < NGRP; ++k) uu[k] = *(const u32x2*)(Gs + (size_t)k * 32768);
        float c0 = 0.f, c1 = 0.f, c2 = 0.f, c3 = 0.f; asm volatile("" : "+v"(c0), "+v"(c1), "+v"(c2), "+v"(c3));
#pragma unroll
        for (int k = 0; k < NGRP; ++k) { const float d = Dg[bh * NGRP + k];
            u32x2 o; o.x = cvt_pk_bf16(c0, c1); o.y = cvt_pk_bf16(c2, c3); *(u32x2*)(Gs + (size_t)k * 32768) = o;
            c0 = d * c0 + bf_lo(uu[k].x); c1 = d * c1 + bf_hi(uu[k].x); c2 = d * c2 + bf_lo(uu[k].y); c3 = d * c3 + bf_hi(uu[k].y); }
    }
    { const int gid = F.bid * NTHREADS + F.tid;
      if (gid < NBH * 128) { const int b2 = gid >> 7, d = gid & 127; float* gn = (float*)(F.ws + WS_CHK + 32768) + (size_t)b2 * NGRP * 128 + d;
        float n = 0.f; for (int k = 0; k < NGRP; ++k) { const float uv = gn[k * 128]; gn[k * 128] = n; n = Dg[b2 * NGRP + k] * n + uv; } } }
}
__device__ __forceinline__ void mlstm_group_output(Frame& F, int l) {
    F.refresh();
    ArgP a = argp();
    char* lds = (char*)F.lds; char* Qs = lds; char* Ks = lds + 16384; char* Vimg = lds + 32768; char* Cs = lds + 65536; char* Yt = lds;
    LAS float* gx = (LAS float*)(F.lds + LDSX_OFF);
    LAS float* mt = gx + 704; LAS float* cwl = (LAS float*)(F.lds + LDSX_OFF + 4608); LAS float* npart = (LAS float*)(F.lds + LDSX_OFF + 25088);
    const bf16_t* qk = (const bf16_t*)(F.ws + WS_S(1)); const bf16_t* vm = (const bf16_t*)(F.ws + WS_S(2)); const bf16_t* Gs = (const bf16_t*)(F.ws + WS_S(4)); const bf16_t* so = (const bf16_t*)(F.ws + WS_S(3)); unsigned char* ym8 = F.ws + WS_S(0) + 32 * MiB;
    const float* GT = (const float*)(F.ws + WS_GATE); const float* CH = (const float*)(F.ws + WS_CHK); const float* gn = (const float*)(F.ws + WS_CHK + 32768);
    const int tid0 = F.tid, wid = F.wave;
    const bf16_t* kcv = (const bf16_t*)GOUT(a) + (size_t)T * 1024;
    conv_table(cwl, GIN(a, I_CONVW) + (size_t)l * 4096, GIN(a, I_CONVB) + (size_t)l * 1024, tid0);
    for (int u = F.bid; u < NBH * NGRP; u += F.G) {
        const int bh = u >> 4, g = u & 15, b = bh >> 2, h = bh & 3;
        bf16x8 xv[4]; u32x4 xq[2][4], xk[2]; float gbc, gct, gpm, gch;
#define GB_LOAD_G(cidx) do { int tid_ = tid0; asm volatile("" : "+v"(tid_)); const int t64_ = tid_ & 63; gbc = GT[(size_t)bh * SEQ + (cidx) * 64 + t64_]; gct = GT[(size_t)(NBH + bh) * SEQ + (cidx) * 64 + t64_]; \
            gpm = GT[(size_t)(2 * NBH + bh) * SEQ + (cidx) * 64 + t64_]; gch = CH[bh * NCH + (cidx)]; } while (0)
#define GB_LOAD_V(cidx) do { int tid_ = tid0; asm volatile("" : "+v"(tid_)); const int sr_ = tid_ >> 4, sc_ = (tid_ & 15) * 8; const size_t tk_ = (size_t)b * SEQ + (size_t)(cidx) * 64; \
            _Pragma("unroll") for (int img = 0; img < 2; ++img) _Pragma("unroll") for (int hf = 0; hf < 2; ++hf) xv[img * 2 + hf] = *(const bf16x8*)(vm + (tk_ + sr_ + 32 * hf) * 1024 + h * 256 + img * 128 + sc_); } while (0)
#define GB_LOAD_QK(cidx, dst, off, hf) do { int tid_ = tid0; asm volatile("" : "+v"(tid_)); const int srow_ = tid_ >> 3; const size_t tk_ = (size_t)b * SEQ + (size_t)(cidx) * 64; \
            conv_load(qk + (tk_ + srow_) * 1024 + (off) + h * 128 + (tid_ & 7) * 8 + 64 * (hf), (cidx) * 64 + srow_, dst[hf]); } while (0)
#define GB_LOAD_K(cidx) do { int tid_ = tid0; asm volatile("" : "+v"(tid_)); const int srow_ = tid_ >> 3; const bf16_t* kp_ = kcv + ((size_t)b * SEQ + (size_t)(cidx) * 64 + srow_) * 512 + h * 128 + (tid_ & 7) * 8; \
            xk[0] = *(const u32x4*)kp_; xk[1] = *(const u32x4*)(kp_ + 64); } while (0)
#define GB_LOADS(cidx) do { GB_LOAD_G(cidx); GB_LOAD_V(cidx); GB_LOAD_QK(cidx, xq, 0, 0); GB_LOAD_QK(cidx, xq, 0, 1); GB_LOAD_K(cidx); } while (0)
        GB_LOADS(g * GCH);
        __syncthreads();
        { const int tid = tid0; const bf16_t* Gc = Gs + (size_t)(bh * NGRP + g) * 32768;
          u32x4 cv[8];
#pragma unroll
          for (int k = 0; k < 8; ++k) { const int p = tid + 512 * k; cv[k] = *(const u32x4*)(Gc + (size_t)(p >> 4) * 128 + (p & 15) * 8); }
          mlstm_mtab(mt, CH, bh, tid0);
#pragma unroll
          for (int k = 0; k < 8; ++k) { const int p = tid + 512 * k; *(u32x4*)(Cs + CSW256(p >> 4, (p & 15) * 16)) = cv[k]; }
          if (tid < 128) gx[256 + tid] = gn[(size_t)(bh * NGRP + g) * 128 + tid]; }
#pragma unroll 1
        for (int cc = 0; cc < GCH; ++cc) {
            const int c = g * GCH + cc; const size_t tok0 = (size_t)b * SEQ + c * 64;
            __syncthreads();
            { int tid = tid0; asm volatile("" : "+v"(tid));
              const int sr = tid >> 4, sc = (tid & 15) * 8, srow = tid >> 3;
              if (tid < 64) { const float bc = gbc, ct = gct, pm = gpm;
                  const float mc = mt[c], mm = fmaxf(pm, mc);
                  gx[tid] = ct; gx[64 + tid] = -mm; gx[128 + tid] = __expf(mc - mm); gx[192 + tid] = __expf(-(bc + mm)); gx[640 + tid] = __expf(gch + ct - mt[128 + c]); }
#pragma unroll
              for (int img = 0; img < 2; ++img)
#pragma unroll
                for (int hf = 0; hf < 2; ++hf) *(bf16x8*)(Vimg + img * 16384 + att::v_st(sr + 32 * hf, sc)) = xv[img * 2 + hf];
#pragma unroll
              for (int hf = 0; hf < 2; ++hf) { const int d = (tid & 7) * 8 + 64 * hf; float o[8]; u32x4 w;
                conv8(xq[hf], c * 64 + srow, cwl, h * 128 + d, 0.08838834764831845f, o);
                w.x = cvt_pk_bf16(o[0], o[1]); w.y = cvt_pk_bf16(o[2], o[3]); w.z = cvt_pk_bf16(o[4], o[5]); w.w = cvt_pk_bf16(o[6], o[7]); *(u32x4*)(Qs + KSW256(srow, d * 2)) = w;
                *(u32x4*)(Ks + KSW256(srow, d * 2)) = xk[hf]; } }
            __syncthreads();
            const float dec = mt[256 + c];
            float yv[2][16]; f32x16 ua[4];
            {
                int tid = tid0; asm volatile("" : "+v"(tid)); const int lane = tid & 63, r32 = lane & 31, hi = lane >> 5;
                const int rb = wid & 1, vq = wid >> 1, t = 32 * rb + r32;
                bf16x8 qr[8];
#pragma unroll
                for (int d0 = 0; d0 < 8; ++d0) qr[d0] = *(const bf16x8*)(Qs + KSW256(t, (d0 * 16 + hi * 8) * 2));
                f32x16 p0, p1;
#pragma unroll
                for (int r = 0; r < 16; ++r) { p0[r] = 0.f; p1[r] = 0.f; }
#pragma unroll
                for (int d0 = 0; d0 < 8; ++d0) { const int cbb = (d0 * 16 + hi * 8) * 2;
                    const bf16x8 k0 = *(const bf16x8*)(Ks + KSW256(r32, cbb));
                    p0 = __builtin_amdgcn_mfma_f32_32x32x16_bf16(k0, qr[d0], p0, 0, 0, 0);
                    if (rb) { const bf16x8 k1 = *(const bf16x8*)(Ks + KSW256(32 + r32, cbb)); p1 = __builtin_amdgcn_mfma_f32_32x32x16_bf16(k1, qr[d0], p1, 0, 0, 0); } }
                const float rowt = gx[64 + t];
                float ps = 0.f;
#pragma unroll
                for (int a4 = 0; a4 < 4; ++a4) { const f32x4 c0 = *(const LAS f32x4*)(gx + 8 * a4 + 4 * hi), c1 = *(const LAS f32x4*)(gx + 32 + 8 * a4 + 4 * hi);
#pragma unroll
                    for (int b4 = 0; b4 < 4; ++b4) { const int r = 4 * a4 + b4, s0 = att::crow(r, hi), s1 = 32 + s0;
                        p0[r] = (s0 <= t) ? p0[r] * __expf(rowt + c0[b4]) : 0.f; p1[r] = (s1 <= t) ? p1[r] * __expf(rowt + c1[b4]) : 0.f; ps += p0[r] + p1[r]; } }
                { auto rr = __builtin_amdgcn_permlane32_swap(__float_as_uint(ps), __float_as_uint(ps), false, false); ps = __uint_as_float(rr[0]) + __uint_as_float(rr[1]); }
                bf16x8 pa0, pa1, pa2, pa3;
#define PK4(P, BASE, OUT) do { unsigned a0_ = cvt_pk_bf16(P[BASE + 0], P[BASE + 1]), a1_ = cvt_pk_bf16(P[BASE + 2], P[BASE + 3]); unsigned b0_ = cvt_pk_bf16(P[BASE + 4], P[BASE + 5]), b1_ = cvt_pk_bf16(P[BASE + 6], P[BASE + 7]); \
    auto r0_ = __builtin_amdgcn_permlane32_swap(a0_, b0_, false, false); auto r1_ = __builtin_amdgcn_permlane32_swap(a1_, b1_, false, false); u32x4 w_ = {r0_[0], r1_[0], r0_[1], r1_[1]}; OUT = *reinterpret_cast<bf16x8*>(&w_); } while (0)
                PK4(p0, 0, pa0); PK4(p0, 8, pa1); PK4(p1, 0, pa2); PK4(p1, 8, pa3);
#undef PK4
                float qn = 0.f;
#pragma unroll
                for (int d0 = 0; d0 < 8; ++d0) { const u32x4 qq = *reinterpret_cast<const u32x4*>(&qr[d0]); const f32x4 n0 = *(const LAS f32x4*)(gx + 256 + d0 * 16 + hi * 8), n1 = *(const LAS f32x4*)(gx + 256 + d0 * 16 + hi * 8 + 4);
                    qn += bf_lo(qq.x) * n0.x + bf_hi(qq.x) * n0.y + bf_lo(qq.y) * n0.z + bf_hi(qq.y) * n0.w + bf_lo(qq.z) * n1.x + bf_hi(qq.z) * n1.y + bf_lo(qq.w) * n1.z + bf_hi(qq.w) * n1.w; }
                { auto rr = __builtin_amdgcn_permlane32_swap(__float_as_uint(qn), __float_as_uint(qn), false, false); qn = __uint_as_float(rr[0]) + __uint_as_float(rr[1]); }
                const float wint = gx[128 + t];
                const float den = ps + wint * qn;
                const float ivr = __builtin_amdgcn_rcpf(fmaxf(fabsf(den), gx[192 + t]));
                f32x16 o[2], oi[2];
#pragma unroll
                for (int j = 0; j < 2; ++j)
#pragma unroll
                    for (int r = 0; r < 16; ++r) { o[j][r] = 0.f; oi[j][r] = 0.f; }
                const int vb = (int)(uintptr_t)(Vimg + (vq >> 1) * 16384) + att::v_rd_base(lane) + (vq & 1) * 1024;
#define GB_PV(D0, OD) do { \
                    const s16x4 l0_ = att::tr_read<att::v_rd_off(D0, 0, 0)>(vb), h0_ = att::tr_read<att::v_rd_off(D0, 0, 1)>(vb), l1_ = att::tr_read<att::v_rd_off(D0, 1, 0)>(vb), h1_ = att::tr_read<att::v_rd_off(D0, 1, 1)>(vb); \
                    const s16x4 l2_ = att::tr_read<att::v_rd_off(D0, 2, 0)>(vb), h2_ = att::tr_read<att::v_rd_off(D0, 2, 1)>(vb), l3_ = att::tr_read<att::v_rd_off(D0, 3, 0)>(vb), h3_ = att::tr_read<att::v_rd_off(D0, 3, 1)>(vb); \
                    asm volatile("s_waitcnt lgkmcnt(0)" ::: "memory"); SBAR(); \
                    OD = __builtin_amdgcn_mfma_f32_32x32x16_bf16(PK8(l0_, h0_), pa0, OD, 0, 0, 0); OD = __builtin_amdgcn_mfma_f32_32x32x16_bf16(PK8(l1_, h1_), pa1, OD, 0, 0, 0); \
                    OD = __builtin_amdgcn_mfma_f32_32x32x16_bf16(PK8(l2_, h2_), pa2, OD, 0, 0, 0); OD = __builtin_amdgcn_mfma_f32_32x32x16_bf16(PK8(l3_, h3_), pa3, OD, 0, 0, 0); } while (0)
                GB_PV(0, o[0]); GB_PV(1, o[1]);
#undef GB_PV
#pragma unroll
                for (int j = 0; j < 2; ++j)
#pragma unroll
                    for (int d0 = 0; d0 < 8; ++d0) { const bf16x8 cf = *(const bf16x8*)(Cs + CSW256(vq * 64 + j * 32 + r32, (d0 * 16 + hi * 8) * 2)); oi[j] = __builtin_amdgcn_mfma_f32_32x32x16_bf16(cf, qr[d0], oi[j], 0, 0, 0); }
#pragma unroll
                for (int r = 0; r < 16; ++r)
#pragma unroll
                    for (int j = 0; j < 2; ++j) yv[j][r] = (o[j][r] + wint * oi[j][r]) * ivr;
            }
            __builtin_amdgcn_sched_barrier(0);
            {
                int tid = tid0; asm volatile("" : "+v"(tid)); const int lane = tid & 63, hi = lane >> 5;
#pragma unroll
                for (int j = 0; j < 4; ++j)
#pragma unroll
                    for (int r = 0; r < 16; ++r) ua[j][r] = 0.f;
                const int vbV = (int)(uintptr_t)(Vimg + (wid >> 2) * 16384) + att::v_rd_base(lane) + (wid & 3) * 512;
                const int q4 = (lane >> 2) & 3, p4 = lane & 3, g1 = (lane >> 4) & 1;
                int kb[2][4];
#pragma unroll
                for (int hf = 0; hf < 2; ++hf)
#pragma unroll
                    for (int j = 0; j < 4; ++j) kb[hf][j] = (int)(uintptr_t)Ks + (8 * hi + 4 * hf + q4) * 256 + ((64 * j + 32 * g1 + 8 * p4) ^ ((4 * hf + q4) << 4));
#define GBSTEP(KS) do { \
                    const s16x4 al = att::tr_read<att::v_rd_off(0, KS, 0)>(vbV), ah = att::tr_read<att::v_rd_off(0, KS, 1)>(vbV); \
                    const s16x4 l0 = att::tr_read<KS * 4096>(kb[0][0]), h0 = att::tr_read<KS * 4096>(kb[1][0]), l1 = att::tr_read<KS * 4096>(kb[0][1]), h1 = att::tr_read<KS * 4096>(kb[1][1]); \
                    const s16x4 l2 = att::tr_read<KS * 4096>(kb[0][2]), h2 = att::tr_read<KS * 4096>(kb[1][2]), l3 = att::tr_read<KS * 4096>(kb[0][3]), h3 = att::tr_read<KS * 4096>(kb[1][3]); \
                    const f32x4 w0 = *(const LAS f32x4*)(gx + 640 + 16 * KS + 8 * hi), w1 = *(const LAS f32x4*)(gx + 640 + 16 * KS + 8 * hi + 4); \
                    asm volatile("s_waitcnt lgkmcnt(0)" ::: "memory"); SBAR(); \
                    u32x4 af_; af_.x = cvt_pk_bf16(bf1((bf16_t)al[0]) * w0.x, bf1((bf16_t)al[1]) * w0.y); af_.y = cvt_pk_bf16(bf1((bf16_t)al[2]) * w0.z, bf1((bf16_t)al[3]) * w0.w); \
                    af_.z = cvt_pk_bf16(bf1((bf16_t)ah[0]) * w1.x, bf1((bf16_t)ah[1]) * w1.y); af_.w = cvt_pk_bf16(bf1((bf16_t)ah[2]) * w1.z, bf1((bf16_t)ah[3]) * w1.w); \
                    const bf16x8 af = *reinterpret_cast<const bf16x8*>(&af_); \
                    ua[0] = __builtin_amdgcn_mfma_f32_32x32x16_bf16(PK8(l0, h0), af, ua[0], 0, 0, 0); ua[1] = __builtin_amdgcn_mfma_f32_32x32x16_bf16(PK8(l1, h1), af, ua[1], 0, 0, 0); \
                    ua[2] = __builtin_amdgcn_mfma_f32_32x32x16_bf16(PK8(l2, h2), af, ua[2], 0, 0, 0); ua[3] = __builtin_amdgcn_mfma_f32_32x32x16_bf16(PK8(l3, h3), af, ua[3], 0, 0, 0); } while (0)
                GBSTEP(0); GBSTEP(1); GBSTEP(2); GBSTEP(3);
#undef GBSTEP
                { float sacc = 0.f; const int dq = tid & 127, kq = (tid >> 7) * 16;
#pragma unroll
                  for (int k = 0; k < 16; ++k) sacc += gx[640 + kq + k] * bf1(*(const bf16_t*)(Ks + KSW256(kq + k, (dq & ~7) * 2) + (dq & 7) * 2));
                  npart[tid] = sacc; }
            }
            __syncthreads();
            u32x4 sv[4];
            { int tid = tid0; asm volatile("" : "+v"(tid));
#pragma unroll
              for (int k = 0; k < 4; ++k) { const int p = tid + 512 * k, row = p >> 5, ck = p & 31; sv[k] = *(const u32x4*)(so + (tok0 + row) * 1024 + h * 256 + ck * 8); } }
            { int tid = tid0; asm volatile("" : "+v"(tid)); const int lane = tid & 63, r32 = lane & 31, hi = lane >> 5;
              const int rb = wid & 1, vq = wid >> 1;
#pragma unroll
              for (int j = 0; j < 2; ++j)
#pragma unroll
                for (int a4 = 0; a4 < 4; ++a4) { u32x2 w; w.x = cvt_pk_bf16(yv[j][4 * a4 + 0], yv[j][4 * a4 + 1]); w.y = cvt_pk_bf16(yv[j][4 * a4 + 2], yv[j][4 * a4 + 3]);
                  *(u32x2*)(Yt + (32 * rb + r32) * 528 + (vq * 64 + j * 32 + 8 * a4 + 4 * hi) * 2) = w; }
              const int cn = (cc + 1 < GCH) ? c + 1 : c;
              GB_LOAD_G(cn); GB_LOAD_V(cn);
              {
                u32x2 cv[4][4];
#pragma unroll
                for (int j = 0; j < 4; ++j)
#pragma unroll
                  for (int a4 = 0; a4 < 4; ++a4) cv[j][a4] = *(const u32x2*)(Cs + CSW256(wid * 32 + r32, (32 * j + 8 * a4 + 4 * hi) * 2));
#pragma unroll
                for (int j = 0; j < 4; ++j) {
#pragma unroll
                  for (int a4 = 0; a4 < 4; ++a4) { u32x2 nv;
                    nv.x = cvt_pk_bf16(dec * bf_lo(cv[j][a4].x) + ua[j][4 * a4 + 0], dec * bf_hi(cv[j][a4].x) + ua[j][4 * a4 + 1]); nv.y = cvt_pk_bf16(dec * bf_lo(cv[j][a4].y) + ua[j][4 * a4 + 2], dec * bf_hi(cv[j][a4].y) + ua[j][4 * a4 + 3]);
                    *(u32x2*)(Cs + CSW256(wid * 32 + r32, (32 * j + 8 * a4 + 4 * hi) * 2)) = nv; }
                  if (j == 0) GB_LOAD_QK(cn, xq, 0, 0); else if (j == 1) GB_LOAD_QK(cn, xq, 0, 1); else if (j == 2) GB_LOAD_K(cn);
                } }
              if (tid < 128) gx[256 + tid] = dec * gx[256 + tid] + ((npart[tid] + npart[128 + tid]) + (npart[256 + tid] + npart[384 + tid])); }
            __syncthreads();
            { int tid = tid0; asm volatile("" : "+v"(tid));
#pragma unroll
              for (int k = 0; k < 4; ++k) { const int p = tid + 512 * k, row = p >> 5, ck = p & 31; const u32x4 y = *(const u32x4*)(Yt + row * 528 + ck * 16); u32x2 w;
                w.x = pk4_fp8(bf_lo(y.x) * bf_lo(sv[k].x), bf_hi(y.x) * bf_hi(sv[k].x), bf_lo(y.y) * bf_lo(sv[k].y), bf_hi(y.y) * bf_hi(sv[k].y));
                w.y = pk4_fp8(bf_lo(y.z) * bf_lo(sv[k].z), bf_hi(y.z) * bf_hi(sv[k].z), bf_lo(y.w) * bf_lo(sv[k].w), bf_hi(y.w) * bf_hi(sv[k].w));
                *(u32x2*)(ym8 + (tok0 + row) * 1024 + h * 256 + ck * 8) = w; } }
        }
    }
}

__global__ void __launch_bounds__(NTHREADS, 2) fwd_kernel(Args args) {
    __shared__ __attribute__((aligned(16))) unsigned char lds_raw[LDS_BYTES];
    Frame F;
    F.lds = (LAS unsigned char*)lds_raw;
    F.wave0 = wave_sgpr(); F.tid = threadIdx.x; F.lane = F.tid & 63; F.wave = F.wave0;
    F.ws = (unsigned char*)(GAS unsigned char*)argp()->ws;
    for (int u = F.tid; u < (LDS_BYTES - LDSCTL_OFF) / 4; u += NTHREADS) ((LAS unsigned*)(F.lds + LDSCTL_OFF))[u] = 0u;
    __syncthreads();
    XcdBarrier bar = xcd_barrier_post(((unsigned*)F.ws) + CW_BAR, (volatile LAS unsigned*)(F.lds + LDSCTL_OFF));
#define GRID_BAR() xcd_barrier(bar)
#define PH(k) ((PHASE_MASK >> (k)) & 1u)
#ifndef PROBE
#define PROBE -1
#endif
#define REPS(k) for (int rep_ = 0; rep_ < ((PROBE == (k)) ? 2 : 1); ++rep_)

    p0_prologue(F);
    GRID_BAR();
    if (F.bid * NTHREADS + F.tid < 2 * 4 * 6144) {
        const int i = F.bid * NTHREADS + F.tid, l = i / (4 * 6144), r = i % (4 * 6144), b = r / 6144, idx = r % 6144;
        ((float*)(F.ws + WS_MODF))[i] = mod_from_partials(argp(), F.ws, l, b, idx);
    }
    for (int l = 0; l < DEPTH; ++l) {
        REPS(1) convert_weights(F, l);
        __syncthreads();
        if (l == 0) { REPS(11) { row_phase_norm1<0>(F, l); __syncthreads(); } } else row_phase_norm1<1>(F, l);
        GRID_BAR();
        F.refresh();
#if PROBE == 41
        { pg8::DenseOrder8 S; S.init(F.ws + WS_S(0), F.ws + WS_W + W_IN, T, NIN, 1024, 1024, 1024, F.G, F.bid, W8_E8M0); EpiInProjT<false> E{F.ws, (const float*)(F.ws + WS_ROPE)}; pg8::gemm_phase(F.lds, S, E, F.wave); }
#endif
#if PROBE == 30
        { pg8::DenseOrder8 S; S.init(F.ws + WS_S(0), F.ws + WS_W + W_IN, T, NIN, 1024, 1024, 1024, F.G, F.bid, W8_E8M0); EpiNull E; pg8::gemm_phase(F.lds, S, E, F.wave); }
#endif
        REPS(2) if (PH(2)) {
            pg8::DenseOrder8 S; S.init(F.ws + WS_S(0), F.ws + WS_W + W_IN, T, NIN, 1024, 1024, 1024, F.G, F.bid, W8_E8M0);
            EpiInProj E{F.ws, (const float*)(F.ws + WS_ROPE)};
            pg8::gemm_phase(F.lds, S, E, F.wave);
        }
        GRID_BAR();
        REPS(3) { if (PH(3)) row_phase_stats(F);
        if (PH(6)) mlstm_gates_local(F, l); __syncthreads(); }
        GRID_BAR();
        REPS(4) if (PH(6)) mlstm_group_state(F, l);
        GRID_BAR();
        if (PH(6)) mlstm_group_scan(F);
        GRID_BAR();
        REPS(6) if (PH(6)) mlstm_group_output(F, l);
        GRID_BAR();
        F.refresh();
        REPS(7) if (PH(7)) {
            { pg8::DenseOrder8 S; S.init(F.ws + WS_CQ, F.ws + WS_W + W_UQ, T, 1536, 512, 512, 512, F.G, F.bid, W8_E8M0); EpiUq E{F.ws, (const float*)(F.ws + WS_ROPE)}; pg8::gemm_phase(F.lds, S, E, F.wave); }
            { pg8::DenseOrder8 S; S.init(F.ws + WS_CKV, F.ws + WS_W + W_UKV, T, 2048, 256, 256, 256, F.G, F.bid, W8_E8M0); EpiUkv E{F.ws}; pg8::gemm_phase(F.lds, S, E, F.wave); }
        }
#if PROBE == 71
        { pg8::DenseOrder8 S; S.init(F.ws + WS_CQ, F.ws + WS_W + W_UQ, T, 1536, 512, 512, 512, F.G, F.bid, W8_E8M0); EpiUq E{F.ws, (const float*)(F.ws + WS_ROPE)}; pg8::gemm_phase(F.lds, S, E, F.wave); }
#endif
#if PROBE == 72
        { pg8::DenseOrder8 S; S.init(F.ws + WS_CKV, F.ws + WS_W + W_UKV, T, 2048, 256, 256, 256, F.G, F.bid, W8_E8M0); EpiUkv E{F.ws}; pg8::gemm_phase(F.lds, S, E, F.wave); }
#endif
#if PROBE == 73
        { pg8::DenseOrder8 S; S.init(F.ws + WS_CQ, F.ws + WS_W + W_UQ, T, 1536, 512, 512, 512, F.G, F.bid, W8_E8M0); EpiNull E; pg8::gemm_phase(F.lds, S, E, F.wave); }
        { pg8::DenseOrder8 S; S.init(F.ws + WS_CKV, F.ws + WS_W + W_UKV, T, 2048, 256, 256, 256, F.G, F.bid, W8_E8M0); EpiNull E; pg8::gemm_phase(F.lds, S, E, F.wave); }
#endif
        GRID_BAR();
        F.refresh();
        REPS(8) if (PH(8)) attn_phase(F, (PROBE != 8) || rep_ == 1);
        GRID_BAR();
        F.refresh();
        REPS(9) if (PH(9)) {
            MergeOrder S; S.ws = F.ws; S.G = F.G; S.c = F.bid; S.K = 1024; S.lda = 1024; S.ldb = 1024; S.pass0 = PH(6) ? 0 : 2;
            EpiMerge E{F.ws, PH(6) ? 1 : 0};
            pg8::gemm_phase(F.lds, S, E, F.wave);
        }
        GRID_BAR();
        F.refresh();
        REPS(10) if (PH(10)) {
            pg8::DenseOrder8 S; S.init(F.ws + WS_S(5), F.ws + WS_W + W_OUT, T, 1024, 1024, 1024, 1024, F.G, F.bid, W8_E8M0);
            EpiOut E{(l == 0) ? GIN(argp(), I_X) : (const float*)nullptr, (const bf16_t*)GOUT(argp()), xres(argp(), F.ws, l), (const float*)(F.ws + WS_MODF) + (size_t)l * 4 * 6144 + 2 * 1024, (PROBE != 10) || rep_ == 1};
            pg8::gemm_phase(F.lds, S, E, F.wave);
        }
        GRID_BAR();
#if PROBE == 20
        for (int xb = 0; xb < 10; ++xb) GRID_BAR();
#endif
        REPS(12) { if (PH(12)) row_phase_norm2_route(F, l, (PROBE != 12) || rep_ == 1); __syncthreads(); }
        GRID_BAR();
        moe_prefix(F, l);
        F.refresh();
        if (PH(13)) {
            MoeOrderUp S; S.A = (const char*)(F.ws + WS_S(0)); S.B = (const char*)(F.ws + WS_W + W_GU); S.G = F.G; S.c = F.bid; S.K = 1024; S.lda = 1024; S.ldb = 1024; S.npn = 2;
            S.pfx = (const LAS int*)(F.lds + LDSCTL_OFF + 64); S.ldest = (const unsigned*)(F.ws + WS_LDEST);
            EpiMoeUp E{(bf16_t*)(F.ws + WS_S(1))};
            pg8::gemm_phase(F.lds, S, E, F.wave);
        }
#if PROBE == 13
        if (PH(13)) {
            MoeOrderUp S; S.A = (const char*)(F.ws + WS_S(0)); S.B = (const char*)(F.ws + WS_W + W_GU); S.G = F.G; S.c = F.bid; S.K = 1024; S.lda = 1024; S.ldb = 1024; S.npn = 2;
            S.pfx = (const LAS int*)(F.lds + LDSCTL_OFF + 64); S.ldest = (const unsigned*)(F.ws + WS_LDEST);
            EpiMoeUp E{(bf16_t*)(F.ws + WS_S(1))};
            pg8::gemm_phase(F.lds, S, E, F.wave);
        }
#endif
        GRID_BAR();
        F.refresh();
        if (PH(14)) {
            MoeOrderDn S; S.A = (const char*)(F.ws + WS_S(1)); S.B = (const char*)(F.ws + WS_W + W_DN); S.G = F.G; S.c = F.bid; S.K = 256; S.lda = 256; S.ldb = 256; S.npn = 4;
            S.pfx = (const LAS int*)(F.lds + LDSCTL_OFF + 64); S.ldest = (const unsigned*)(F.ws + WS_LDEST);
            EpiMoeDn E{(bf16_t*)(F.ws + WS_S(2)), (const unsigned*)(F.ws + WS_LDEST), (const float*)(F.ws + WS_LW)};
            pg8::gemm_phase(F.lds, S, E, F.wave);
        }
#if PROBE == 14
        if (PH(14)) {
            MoeOrderDn S; S.A = (const char*)(F.ws + WS_S(1)); S.B = (const char*)(F.ws + WS_W + W_DN); S.G = F.G; S.c = F.bid; S.K = 256; S.lda = 256; S.ldb = 256; S.npn = 4;
            S.pfx = (const LAS int*)(F.lds + LDSCTL_OFF + 64); S.ldest = (const unsigned*)(F.ws + WS_LDEST);
            EpiMoeDn E{(bf16_t*)(F.ws + WS_S(2)), (const unsigned*)(F.ws + WS_LDEST), (const float*)(F.ws + WS_LW)};
            pg8::gemm_phase(F.lds, S, E, F.wave);
        }
#endif
        GRID_BAR();
    }
    row_phase_norm1<2>(F, 0);
}

extern "C" void kernel_launch(void* const* d_in, const int* in_sizes, int n_in, void* d_out, int out_size, void* d_ws, size_t ws_size, hipStream_t stream) {
    static int grid = 0;
    if (grid == 0) {
        if (n_in != 26 || out_size != T * D || ws_size < WS_END) { fprintf(stderr, "kernel_launch: unexpected shapes n_in %d out %d ws %zu (need %zu)\n", n_in, out_size, ws_size, (size_t)WS_END); grid = -1; return; }
        int dev = 0, cus = 0, per_cu = 0;
        if (hipGetDevice(&dev) != hipSuccess || hipDeviceGetAttribute(&cus, hipDeviceAttributeMultiprocessorCount, dev) != hipSuccess) { grid = -1; return; }
        if (hipOccupancyMaxActiveBlocksPerMultiprocessor(&per_cu, (const void*)fwd_kernel, NTHREADS, 0) != hipSuccess || per_cu < 1) fprintf(stderr, "kernel_launch: occupancy query says %d\n", per_cu);
        (void)hipGetLastError();
        if (cus < 256) { fprintf(stderr, "kernel_launch: built for a 256-CU device (one workgroup per CU), found %d CUs\n", cus); grid = -1; return; }
        grid = 256;
    }
    if (grid < 0) return;
    if (hipMemsetAsync((char*)d_ws + WS_CTL, 0, CTL_ZERO_BYTES, stream) != hipSuccess) return;
    Args a{};
    for (int i = 0; i < 26; ++i) a.in[i] = (const float*)d_in[i];
    a.out = (float*)d_out; a.ws = (unsigned char*)d_ws;
    hipLaunchKernelGGL(fwd_kernel, dim3(grid), dim3(NTHREADS), 0, stream, a);
}
```
